# Optimizing an MI355X kernel written in HIP

```python
import math
import jax, jax.numpy as jnp
from jax import lax
import numpy as np

D_MODEL = 1024
BATCH = 1
SEQ = 16384
DEPTH = 2

GRID_W = 64
CTX_LEN = 256
HEAD_DIM = 64
BLOCK = 128
WINDOW = 128
ATTN_SCALE = HEAD_DIM ** -0.5
ROPE_THETA = 10000.0
AXIS_FREQS = HEAD_DIM // 4
A_HEADS = 4
A_KV_HEADS = 2
B_HEADS = 4
B_KV_HEADS = 2
C_HEADS = 8
C_HEAD_DIM = 64
C_INNER = C_HEADS * C_HEAD_DIM
C_GROUPS = 2
C_STATE = 128
C_CONV = 5
C_CHUNK = 128
C_CONV_CH = C_INNER + 2 * C_GROUPS * C_STATE
MIX_WIDTH = (A_HEADS + B_HEADS) * HEAD_DIM + C_INNER
PROJ_SIZES = (A_HEADS * HEAD_DIM, A_KV_HEADS * HEAD_DIM, A_KV_HEADS * HEAD_DIM,
              B_HEADS * HEAD_DIM, B_KV_HEADS * HEAD_DIM, B_KV_HEADS * HEAD_DIM,
              C_INNER, C_CONV_CH, 2 * C_HEADS)
IN_COLS = sum(PROJ_SIZES)
D_FF = -(-8 * D_MODEL // (3 * 256)) * 256
DEEPNORM_ALPHA = (2 * DEPTH) ** 0.25
DEEPNORM_BETA = (8 * DEPTH) ** -0.25
LN_EPS = 1e-5
RMS_EPS = 1e-6
F32 = jnp.float32

kernel_name = 'hybrid_hymba_dit_prefix_block'


def layer_norm(u, g, b):
    uf = u.astype(F32)
    mu = jnp.mean(uf, -1, keepdims=True)
    var = jnp.mean(jnp.square(uf - mu), -1, keepdims=True)
    return ((uf - mu) * lax.rsqrt(var + LN_EPS) * g + b).astype(u.dtype)


def rms_norm(u, g):
    uf = u.astype(F32)
    return (uf * lax.rsqrt(jnp.mean(uf * uf, -1, keepdims=True) + RMS_EPS) * g).astype(u.dtype)


def axial_rope_tables(n):
    rows = n // GRID_W
    row = jnp.repeat(jnp.arange(rows), GRID_W)
    col = jnp.tile(jnp.arange(GRID_W), rows)
    inv = ROPE_THETA ** (-jnp.arange(AXIS_FREQS, dtype=F32) / AXIS_FREQS)
    ang = jnp.stack([row, col], -1).astype(F32)[..., None] * inv
    return jnp.cos(ang), jnp.sin(ang)


def apply_axial_rope(u, cos, sin):
    bsz, n, nh, hd = u.shape
    ur = u.astype(F32).reshape(bsz, n, nh, 2, 2, AXIS_FREQS)
    u1, u2 = ur[..., 0, :], ur[..., 1, :]
    cs, sn = cos[None, :, None], sin[None, :, None]
    out = jnp.stack([u1 * cs - u2 * sn, u1 * sn + u2 * cs], axis=-2)
    return out.reshape(bsz, n, nh, hd).astype(u.dtype)


def split_projection(p):
    offsets = []
    acc = 0
    for s in PROJ_SIZES[:-1]:
        acc += s
        offsets.append(acc)
    return jnp.split(p, offsets, axis=-1)


def to_heads(t):
    return t.reshape(t.shape[0], t.shape[1], -1, HEAD_DIM)


def window_sink_attention(q, k, v, kc, vc, sink):
    bsz, n, nh, hd = q.shape
    nkv = k.shape[2]
    grp = nh // nkv
    nb = n // BLOCK
    lc = kc.shape[1]

    def windows(t):
        tp = jnp.pad(t, ((0, 0), (BLOCK, BLOCK), (0, 0), (0, 0))).reshape(bsz, nb + 2, BLOCK, nkv, hd)
        return jnp.concatenate([tp[:, :-2], tp[:, 1:-1], tp[:, 2:]], axis=2)

    kw, vw = windows(k), windows(v)
    qb = (q * ATTN_SCALE).reshape(bsz, nb, BLOCK, nkv, grp, hd)
    s_loc = jnp.einsum('bnqkgd,bnskd->bnkgqs', qb, kw).astype(F32)
    s_ctx = jnp.einsum('bnqkgd,bckd->bnkgqc', qb, kc).astype(F32)
    qi = jnp.arange(BLOCK)[:, None]
    si = jnp.arange(3 * BLOCK)[None, :]
    kpos = (jnp.arange(nb) * BLOCK)[:, None, None] - BLOCK + si[None]
    mask = (jnp.abs(si - BLOCK - qi) <= WINDOW)[None] & (kpos >= 0) & (kpos < n)
    s_loc = jnp.where(mask[None, :, None, None], s_loc, -jnp.inf)
    s_sink = jnp.broadcast_to(sink.astype(F32).reshape(nkv, grp)[:, :, None, None], (bsz, nb, nkv, grp, BLOCK, 1))
    p = jax.nn.softmax(jnp.concatenate([s_loc, s_ctx, s_sink], -1), -1).astype(v.dtype)
    w = 3 * BLOCK
    out = (jnp.einsum('bnkgqs,bnskd->bnqkgd', p[..., :w], vw)
           + jnp.einsum('bnkgqc,bckd->bnqkgd', p[..., w:w + lc], vc))
    return out.reshape(bsz, n, nh * hd)


def global_block_attention(q, k, v, kc, vc):
    bsz, n, nh, hd = q.shape
    nkv = k.shape[2]
    grp = nh // nkv
    k_all = jnp.concatenate([k, kc], axis=1)
    v_all = jnp.concatenate([v, vc], axis=1)
    qb = jnp.moveaxis((q * ATTN_SCALE).reshape(bsz, n // BLOCK, BLOCK, nkv, grp, hd), 1, 0)

    def one_block(qblk):
        s = jnp.einsum('bqkgd,bskd->bkgqs', qblk, k_all).astype(F32)
        p = jax.nn.softmax(s, -1).astype(v_all.dtype)
        return jnp.einsum('bkgqs,bskd->bqkgd', p, v_all)

    out = lax.map(one_block, qb)
    return jnp.moveaxis(out, 0, 1).reshape(bsz, n, nh * hd)


def ctx_attention(q, k, v, sink):
    bsz, lc, nh, hd = q.shape
    nkv = k.shape[2]
    grp = nh // nkv
    s = jnp.einsum('bqkgd,bskd->bkgqs', (q * ATTN_SCALE).reshape(bsz, lc, nkv, grp, hd), k).astype(F32)
    if sink is not None:
        s_sink = jnp.broadcast_to(sink.astype(F32).reshape(nkv, grp)[:, :, None, None], (bsz, nkv, grp, lc, 1))
        s = jnp.concatenate([s, s_sink], -1)
    p = jax.nn.softmax(s, -1)[..., :lc].astype(v.dtype)
    return jnp.einsum('bkgqs,bskd->bqkgd', p, v).reshape(bsz, lc, nh * hd)


def centred_dwconv(u, w, b):
    out = lax.conv_general_dilated(u, w[:, None, :].astype(u.dtype), window_strides=(1,),
                                   padding=((C_CONV // 2, C_CONV // 2),),
                                   dimension_numbers=('NWC', 'WIO', 'NWC'),
                                   feature_group_count=u.shape[-1])
    return out + b


def ssd_inputs(xbc, dt_raw, conv_w, conv_b, dt_bias):
    bsz, n, _ = xbc.shape
    u = jax.nn.silu(centred_dwconv(xbc, conv_w, conv_b))
    xs, bm, cm = jnp.split(u, [C_INNER, C_INNER + C_GROUPS * C_STATE], axis=-1)
    xs = xs.reshape(bsz, n, C_HEADS, C_HEAD_DIM)
    bm = bm.reshape(bsz, n, C_GROUPS, C_STATE)
    cm = cm.reshape(bsz, n, C_GROUPS, C_STATE)
    dt = jax.nn.softplus(dt_raw.astype(F32).reshape(bsz, n, 2, C_HEADS) + dt_bias.astype(F32))
    return xs, bm, cm, dt[:, :, 0], dt[:, :, 1]


def ssd_scan(xs, dt, a, bm, cm, h0, with_y):
    bsz, n, nh, hp = xs.shape
    nc = n // C_CHUNK
    rep = nh // C_GROUPS
    xd = (xs.astype(F32) * dt[..., None]).reshape(bsz, nc, C_CHUNK, nh, hp)
    bh = jnp.repeat(bm.astype(F32), rep, axis=2).reshape(bsz, nc, C_CHUNK, nh, C_STATE)
    acum = jnp.cumsum((dt * a).reshape(bsz, nc, C_CHUNK, nh), axis=2)
    decay_to_end = jnp.exp(acum[:, :, -1:] - acum)
    chunk_states = jnp.einsum('bclhn,bclhp->bchpn', bh * decay_to_end[..., None], xd)
    chunk_decay = jnp.exp(acum[:, :, -1])

    def step(state, inp):
        st, dec = inp
        return state * dec[:, :, None, None] + st, state

    h_final, h_start = lax.scan(step, h0, (jnp.moveaxis(chunk_states, 1, 0), jnp.moveaxis(chunk_decay, 1, 0)))
    if not with_y:
        return None, h_final
    ch = jnp.repeat(cm.astype(F32), rep, axis=2).reshape(bsz, nc, C_CHUNK, nh, C_STATE)
    h_start = jnp.moveaxis(h_start, 0, 1)
    li = jnp.arange(C_CHUNK)
    causal = li[:, None] >= li[None, :]
    seg = acum[:, :, :, None, :] - acum[:, :, None, :, :]
    lmat = jnp.exp(jnp.where(causal[None, None, :, :, None], seg, -jnp.inf))
    scores = jnp.einsum('bclhn,bcshn->bclsh', ch, bh) * lmat
    y_diag = jnp.einsum('bclsh,bcshp->bclhp', scores, xd)
    y_off = jnp.einsum('bclhn,bchpn->bclhp', ch, h_start) * jnp.exp(acum)[..., None]
    return (y_diag + y_off).reshape(bsz, n, nh, hp), h_final


def bidir_ssd(xs, bm, cm, dt_f, dt_b, a_f, a_b, h0_f, h0_b, with_y):
    rev = lambda t: jnp.flip(t, axis=1)
    y_f, hf = ssd_scan(xs, dt_f, a_f, bm, cm, h0_f, with_y)
    y_b, hb = ssd_scan(rev(xs), rev(dt_b), a_b, rev(bm), rev(cm), h0_b, with_y)
    y = y_f + rev(y_b) if with_y else None
    return y, hf, hb


def ssd_output(y, xs, z, d_skip, gnorm_w):
    bsz, n = z.shape[:2]
    y = y + xs.astype(F32) * d_skip.astype(F32)[:, None]
    g = (y.reshape(bsz, n, C_INNER) * jax.nn.silu(z.astype(F32))).reshape(bsz, n, C_GROUPS, C_INNER // C_GROUPS)
    g = g * lax.rsqrt(jnp.mean(g * g, -1, keepdims=True) + RMS_EPS)
    return (g.reshape(bsz, n, C_INNER) * gnorm_w).astype(z.dtype)


def hybrid_mixer(h, hc, cos, sin, w_in, sink, q_gain, k_gain, conv_w, conv_b, a_log, dt_bias, d_skip,
                 gnorm_w, w_out, with_ctx_out):
    bsz = h.shape[0]
    aq, ak, av, bq, bk, bv, z, xbc, dt = split_projection(h @ w_in)
    caq, cak, cav, cbq, cbk, cbv, cz, cxbc, cdt = split_projection(hc @ w_in)
    cak, cav = to_heads(cak), to_heads(cav)
    out_a = window_sink_attention(apply_axial_rope(to_heads(aq), cos, sin), apply_axial_rope(to_heads(ak), cos, sin),
                                  to_heads(av), cak, cav, sink)
    cbk, cbv = rms_norm(to_heads(cbk), k_gain), to_heads(cbv)
    out_b = global_block_attention(apply_axial_rope(rms_norm(to_heads(bq), q_gain), cos, sin),
                                   apply_axial_rope(rms_norm(to_heads(bk), k_gain), cos, sin),
                                   to_heads(bv), cbk, cbv)
    a_f = -jnp.exp(a_log[0].astype(F32))
    a_b = -jnp.exp(a_log[1].astype(F32))
    cxs, cbm, ccm, cdt_f, cdt_b = ssd_inputs(cxbc, cdt, conv_w, conv_b, dt_bias)
    zeros = jnp.zeros((bsz, C_HEADS, C_HEAD_DIM, C_STATE), F32)
    cy, st_f, st_b = bidir_ssd(cxs, cbm, ccm, cdt_f, cdt_b, a_f, a_b, zeros, zeros, with_ctx_out)
    xs, bm, cm, dt_f, dt_b = ssd_inputs(xbc, dt, conv_w, conv_b, dt_bias)
    y_c, _, _ = bidir_ssd(xs, bm, cm, dt_f, dt_b, a_f, a_b, st_f, st_b, True)
    out_c = ssd_output(y_c, xs, z, d_skip, gnorm_w)
    y = jnp.concatenate([out_a, out_b, out_c], -1) @ w_out
    if not with_ctx_out:
        return y, None
    ca = ctx_attention(to_heads(caq), cak, cav, sink)
    cb = ctx_attention(rms_norm(to_heads(cbq), q_gain), cbk, cbv, None)
    cc = ssd_output(cy, cxs, cz, d_skip, gnorm_w)
    yc = jnp.concatenate([ca, cb, cc], -1) @ w_out
    return y, yc


def swiglu(h, w_gu, w_down):
    gate, up = jnp.split(h @ w_gu, 2, axis=-1)
    return (jax.nn.silu(gate) * up) @ w_down


def setup_inputs(seed: int = 0) -> dict:
    key = jax.random.key(seed)
    ks = jax.random.split(key, 23)
    nrm = lambda k, shape, scale: jax.random.normal(k, shape, F32) * scale
    dt0 = jnp.exp(jax.random.uniform(ks[13], (DEPTH, 2, C_HEADS), F32, math.log(1e-3), math.log(1e-1)))
    return {
        'x': nrm(ks[0], (BATCH, SEQ, D_MODEL), 1.0),
        'c': nrm(ks[1], (BATCH, D_MODEL), 1.0),
        'ctx': nrm(ks[2], (BATCH, CTX_LEN, D_MODEL), 1.0),
        'c_ctx': nrm(ks[3], (D_MODEL,), 1.0),
        'w_ada': nrm(ks[4], (DEPTH, D_MODEL, 6 * D_MODEL), 0.5 * D_MODEL ** -0.5),
        'b_ada': nrm(ks[5], (DEPTH, 6 * D_MODEL), 0.01),
        'w_in': nrm(ks[6], (DEPTH, D_MODEL, IN_COLS), D_MODEL ** -0.5),
        'sink': nrm(ks[7], (DEPTH, A_HEADS), 0.5),
        'q_gain': 1.0 + nrm(ks[8], (DEPTH, HEAD_DIM), 0.02),
        'k_gain': 1.0 + nrm(ks[9], (DEPTH, HEAD_DIM), 0.02),
        'conv_w': nrm(ks[10], (DEPTH, C_CONV, C_CONV_CH), C_CONV ** -0.5),
        'conv_b': nrm(ks[11], (DEPTH, C_CONV_CH), 0.01),
        'a_log': jnp.log(jax.random.uniform(ks[12], (DEPTH, 2, C_HEADS), F32, 1.0, 16.0)),
        'dt_bias': dt0 + jnp.log(-jnp.expm1(-dt0)),
        'd_skip': 1.0 + nrm(ks[14], (DEPTH, C_HEADS), 0.02),
        'gnorm_w': 1.0 + nrm(ks[15], (DEPTH, C_INNER), 0.02),
        'w_out': nrm(ks[16], (DEPTH, MIX_WIDTH, D_MODEL), DEEPNORM_BETA * MIX_WIDTH ** -0.5),
        'ln1_g': 1.0 + nrm(ks[17], (DEPTH, D_MODEL), 0.02),
        'ln1_b': nrm(ks[18], (DEPTH, D_MODEL), 0.01),
        'ln2_g': 1.0 + nrm(ks[19], (DEPTH, D_MODEL), 0.02),
        'ln2_b': nrm(ks[20], (DEPTH, D_MODEL), 0.01),
        'w_gu': nrm(ks[21], (DEPTH, D_MODEL, 2 * D_FF), D_MODEL ** -0.5),
        'w_down': nrm(ks[22], (DEPTH, D_FF, D_MODEL), DEEPNORM_BETA * D_FF ** -0.5),
    }


def reference(x, c, ctx, c_ctx, w_ada, b_ada, w_in, sink, q_gain, k_gain, conv_w, conv_b, a_log, dt_bias,
              d_skip, gnorm_w, w_out, ln1_g, ln1_b, ln2_g, ln2_b, w_gu, w_down):
    cos, sin = axial_rope_tables(x.shape[1])
    for l in range(DEPTH):
        last = l == DEPTH - 1
        mod = jax.nn.silu(c) @ w_ada[l] + b_ada[l]
        mod_c = jax.nn.silu(c_ctx) @ w_ada[l] + b_ada[l]
        sh1, sc1, g1, sh2, sc2, g2 = jnp.split(mod[:, None, :], 6, axis=-1)
        csh1, csc1, cg1, csh2, csc2, cg2 = jnp.split(mod_c, 6)
        y, yc = hybrid_mixer(x * (1 + sc1) + sh1, ctx * (1 + csc1) + csh1, cos, sin, w_in[l], sink[l],
                             q_gain[l], k_gain[l], conv_w[l], conv_b[l], a_log[l], dt_bias[l], d_skip[l],
                             gnorm_w[l], w_out[l], not last)
        x = layer_norm(DEEPNORM_ALPHA * x + g1 * y, ln1_g[l], ln1_b[l])
        x = layer_norm(DEEPNORM_ALPHA * x + g2 * swiglu(x * (1 + sc2) + sh2, w_gu[l], w_down[l]), ln2_g[l], ln2_b[l])
        if not last:
            ctx = layer_norm(DEEPNORM_ALPHA * ctx + cg1 * yc, ln1_g[l], ln1_b[l])
            ctx = layer_norm(DEEPNORM_ALPHA * ctx + cg2 * swiglu(ctx * (1 + csc2) + csh2, w_gu[l], w_down[l]),
                             ln2_g[l], ln2_b[l])
    return x
```

```cpp
#include <hip/hip_runtime.h>
#include <hip/hip_cooperative_groups.h>
#include <cstdio>
#include <cstdint>
namespace cg = cooperative_groups;

#ifndef MULTI_LAUNCH
#define MULTI_LAUNCH 0
#endif

typedef _Float16 hf;
typedef hf h2 __attribute__((ext_vector_type(2)));
typedef hf h4 __attribute__((ext_vector_type(4)));
typedef hf h8 __attribute__((ext_vector_type(8)));
typedef float f4 __attribute__((ext_vector_type(4)));
typedef float fx16 __attribute__((ext_vector_type(16)));
typedef unsigned u4 __attribute__((ext_vector_type(4)));
typedef unsigned u2 __attribute__((ext_vector_type(2)));

constexpr int NL = 16384, NCX = 256, NT = 16640, D = 1024, INC = 2576, INP = 2816, DFF = 2816, NGU = 5632;
constexpr int NCHK = 130;
constexpr size_t HT = (size_t)NT * 64;
constexpr float LOG2E = 1.4426950408889634f;
constexpr float ALPHA = 1.4142135623730951f;

constexpr size_t OFF_WIN = 0;
constexpr size_t OFF_WOUT = OFF_WIN + (size_t)2 * INP * D * 2;
constexpr size_t OFF_WGU = OFF_WOUT + (size_t)2 * D * D * 2;
constexpr size_t OFF_WDN = OFF_WGU + (size_t)2 * NGU * D * 2;
constexpr size_t OFF_H16 = OFF_WDN + (size_t)2 * D * DFF * 2;
constexpr size_t OFF_SMALL = OFF_H16 + (size_t)NT * D * 2;
constexpr size_t OFF_MODP = OFF_SMALL;
constexpr size_t OFF_MOD = OFF_MODP + (size_t)8 * 2 * 2 * 6144 * 4;
constexpr size_t OFF_ROPE = OFF_MOD + (size_t)2 * 2 * 6144 * 4;
constexpr size_t OFF_XRC = OFF_ROPE + (size_t)256 * 16 * 2 * 4;
constexpr size_t OFF_DTR = OFF_XRC + (size_t)NCX * D * 4;
constexpr size_t OFF_DTP = OFF_DTR + (size_t)NT * 16 * 4;
constexpr size_t OFF_DEC = OFF_DTP + (size_t)NT * 16 * 4;
constexpr size_t OFF_BAR = OFF_DEC + 16384;
constexpr size_t OFF_CNT = OFF_BAR + 13824;
constexpr size_t OFF_STATS = OFF_BAR + 16384;
constexpr size_t OFF_BIG = OFF_SMALL + (size_t)4 * 1024 * 1024 + 262144;
constexpr size_t OFF_QKV = OFF_BIG;
constexpr size_t OFF_Z = OFF_QKV + 16 * HT * 2;
constexpr size_t OFF_XBC = OFF_Z + (size_t)NT * 512 * 2;
constexpr size_t OFF_HS = OFF_XBC;
constexpr size_t OFF_U = OFF_XBC + (size_t)NT * 1024 * 2;
constexpr size_t OFF_UT = OFF_U + (size_t)NT * 1024 * 2;
constexpr size_t OFF_XSL = OFF_UT;
constexpr size_t OFF_CS = OFF_UT + (size_t)768 * NT * 2;
constexpr size_t OFF_MIX = OFF_CS;
constexpr size_t OFF_G16 = OFF_BIG;
constexpr size_t OFF_END = OFF_CS + (size_t)NCHK * 2 * 8 * 64 * 128 * 2;
constexpr int XRB_SPLIT = 12288;
constexpr size_t OFF_XRB_A = ((OFF_G16 + (size_t)NT * DFF * 2 + 4095) / 4096) * 4096;
constexpr size_t OFF_XRB_B = OFF_UT + (size_t)1024 * 1024;
static_assert(OFF_XRB_A + (size_t)XRB_SPLIT * D * 2 <= OFF_UT && (size_t)NT * 32 <= (size_t)1024 * 1024 && OFF_XRB_B + (size_t)(NL - XRB_SPLIT) * D * 2 <= OFF_CS, "XRB overflow");
static_assert(NCHK * 2 * 8 * 4 <= 16384 && 3456 * 4 <= 16384 && OFF_STATS + (size_t)NT * 8 <= OFF_BIG, "small region overflow");
static_assert(OFF_G16 + (size_t)NT * DFF * 2 <= OFF_END, "G16 overflow");
static_assert(OFF_END <= (size_t)256 * 1024 * 1024, "workspace too large");

struct Params {
    const float* x; const float* c; const float* ctx; const float* c_ctx; const float* w_ada; const float* b_ada; const float* w_in;
    const float* sink; const float* q_gain; const float* k_gain; const float* conv_w; const float* conv_b; const float* a_log;
    const float* dt_bias; const float* d_skip; const float* gnorm_w; const float* w_out; const float* ln1_g; const float* ln1_b;
    const float* ln2_g; const float* ln2_b; const float* w_gu; const float* w_down;
    float* out; unsigned char* ws; int ph_lo, ph_hi; int wv;
};

__device__ __forceinline__ float silu_f(float x) { return x * __builtin_amdgcn_rcpf(1.0f + __builtin_amdgcn_exp2f(-x * LOG2E)); }
__device__ __forceinline__ hf* xr16_row(const Params& P, int row, bool in_ws) {
    if (row >= NL) return (hf*)(P.ws + OFF_XRC) + (size_t)(row - NL) * D;
    if (in_ws) return row < XRB_SPLIT ? (hf*)(P.ws + OFF_XRB_A) + (size_t)row * D : (hf*)(P.ws + OFF_XRB_B) + (size_t)(row - XRB_SPLIT) * D;
    return (hf*)P.out + (size_t)row * D;
}
__device__ __forceinline__ float* xr_row(const Params& P, int row) { return row < NL ? P.out + (size_t)row * D : (float*)(P.ws + OFF_XRC) + (size_t)(row - NL) * D; }
__device__ __forceinline__ const float* modv(const Params& P, int layer, int set, int which) { return (const float*)(P.ws + OFF_MOD) + (size_t)((layer * 2 + set) * 6 + which) * 1024; }
__device__ __forceinline__ u4 pair16(h4 a_, h4 b_) {
    const u2 a = __builtin_bit_cast(u2, a_), b = __builtin_bit_cast(u2, b_);
    const auto r0 = __builtin_amdgcn_permlane16_swap(a.x, b.x, false, false);
    const auto r1 = __builtin_amdgcn_permlane16_swap(a.y, b.y, false, false);
    u4 w; w.x = r0[0]; w.y = r1[0]; w.z = r0[1]; w.w = r1[1]; return w;
}
__device__ __forceinline__ int pair_off(int fq) { return (fq & 1) ? 16 + (fq - 1) * 4 : fq * 4; }
__device__ __forceinline__ fx16 mfma16(h8 a, h8 b, fx16 c) { return __builtin_amdgcn_mfma_f32_32x32x16_f16(a, b, c, 0, 0, 0); }
__device__ __forceinline__ int opaque_tid_w(int wv) { int z = 0; asm volatile("" : "+v"(z)); const int lane = __builtin_amdgcn_mbcnt_hi(-1, __builtin_amdgcn_mbcnt_lo(-1, z)); return (wv << 6) | lane; }
#define opaque_tid() opaque_tid_w(P.wv)
__device__ __forceinline__ float shflx(float v, int mask, int lane) { return __builtin_bit_cast(float, __builtin_amdgcn_ds_bpermute((lane ^ mask) << 2, __builtin_bit_cast(int, v))); }
__device__ __forceinline__ float rdlane(float v, int l) { return __builtin_bit_cast(float, __builtin_amdgcn_readlane(__builtin_bit_cast(int, v), l)); }
__device__ __forceinline__ fx16 zero16() { fx16 z; for (int i = 0; i < 16; ++i) z[i] = 0.f; return z; }


#define XB_TMO      128
#define XB_XCNT(j)  (256  + 64 * (j))
#define XB_XSUB(j)  (1280 + 64 * (j))
#define XB_XGEN(j)  (2304 + 64 * (j))
#define XB_TOP      3328
#define XB_TOPGEN   3392
#define XCD_BAR_WORDS 3456
#define XB_SPIN_CAP (1u << 22)
#define LAS __attribute__((address_space(3)))
__device__ __forceinline__ unsigned xb_ld(unsigned* p)              { return __hip_atomic_load(p, __ATOMIC_RELAXED, __HIP_MEMORY_SCOPE_AGENT); }
__device__ __forceinline__ unsigned xb_add(unsigned* p, unsigned v) { return __hip_atomic_fetch_add(p, v, __ATOMIC_RELAXED, __HIP_MEMORY_SCOPE_AGENT); }
__device__ __forceinline__ unsigned xb_xcc_id() { return (unsigned)__builtin_amdgcn_s_getreg((3 << 11) | 20) & 0xFu; }
#define XB_SPIN(cond, bar) do { unsigned _sp = 0; while (cond) { __builtin_amdgcn_s_sleep(1); \
    if ((++_sp & 255u) == 0u) { if (xb_ld(&(bar)[XB_TMO])) break; if (_sp > XB_SPIN_CAP) { atomicAdd(&(bar)[XB_TMO], 1u); break; } } } } while (0)
struct XcdBarrier { unsigned* bar; unsigned x; volatile LAS unsigned* st; };
__device__ __forceinline__ XcdBarrier xcd_barrier_post(unsigned* bar, volatile LAS unsigned* st) {
    XcdBarrier b; b.bar = bar; b.x = xb_xcc_id(); b.st = st;
    if (threadIdx.x == 0) (void)xb_add(&bar[XB_XCNT(b.x)], 1u);
    return b;
}
__device__ __forceinline__ void xcd_barrier_complete(unsigned* bar, unsigned x, unsigned& nloc, unsigned& nx) {
    const unsigned G = gridDim.x * gridDim.y * gridDim.z;
    unsigned sum, cnt, mine, sp = 0u;
    for (;;) {
        sum = 0u; cnt = 0u; mine = 0u;
#pragma unroll
        for (unsigned j = 0; j < 16; ++j) { const unsigned c = xb_ld(&bar[XB_XCNT(j)]); sum += c; cnt += (c > 0u) ? 1u : 0u; mine = (j == x) ? c : mine; }
        if (sum == G) break;
        __builtin_amdgcn_s_sleep(1);
        if ((++sp & 255u) == 0u) { if (xb_ld(&bar[XB_TMO])) break; if (sp > XB_SPIN_CAP) { atomicAdd(&bar[XB_TMO], 1u); break; } }
    }
    nloc = mine > 0u ? mine : 1u; nx = cnt > 0u ? cnt : 1u;
}
__device__ __forceinline__ void xcd_barrier(const XcdBarrier& b) {
    asm volatile("s_waitcnt vmcnt(0)" ::: "memory");
    __syncthreads();
    if (threadIdx.x == 0) {
        unsigned* bar = b.bar;
        __builtin_amdgcn_s_waitcnt(0);
        unsigned nloc = b.st[0], nx = b.st[1];
        if (nloc == 0u) { xcd_barrier_complete(bar, b.x, nloc, nx); b.st[0] = nloc; b.st[1] = nx; }
        const unsigned old = xb_add(&bar[XB_XSUB(b.x)], 1u);
        const unsigned gen = old / nloc;
        if (old + 1u == (gen + 1u) * nloc) {
            __builtin_amdgcn_fence(__ATOMIC_RELEASE, "agent");
            asm volatile("s_waitcnt vmcnt(0)" ::: "memory");
            const unsigned og = xb_add(&bar[XB_TOP], 1u);
            const unsigned tg = og / nx;
            if (og + 1u == (tg + 1u) * nx) xb_add(&bar[XB_TOPGEN], 1u);
            else XB_SPIN(xb_ld(&bar[XB_TOPGEN]) == tg, bar);
            __builtin_amdgcn_fence(__ATOMIC_ACQUIRE, "agent");
            xb_add(&bar[XB_XGEN(b.x)], 1u);
            asm volatile("s_waitcnt vmcnt(0)" ::: "memory");
        } else {
            XB_SPIN(xb_ld(&bar[XB_XGEN(b.x)]) == gen, bar);
            __builtin_amdgcn_fence(__ATOMIC_ACQUIRE, "agent");
            asm volatile("s_waitcnt vmcnt(0)" ::: "memory");
        }
    }
    __syncthreads();
}

__device__ __forceinline__ void phase_p0(const Params& P, char* lds, int which) {
    const int tid = opaque_tid();
    float* tile = (float*)lds;
    int q0 = blockIdx.x, qstride = gridDim.x, qend = 768 + 352 + 192 + 8;
    {
        const int xcd = blockIdx.x & 7, j = blockIdx.x >> 3;
        if (which == 1) { const bool slack = (xcd >= 5 || (xcd == 4 && j >= 22)) && !(xcd == 5 && j < 4);
            q0 = xcd == 4 ? j - 22 : xcd == 5 ? 10 + j - 4 : xcd == 6 ? 38 + j : 70 + j; qstride = 102; qend = slack ? 240 : 0; }
        if (which == 2) { q0 = (xcd - 4) * 32 + j; qstride = 128; qend = xcd >= 4 ? 176 : 0; }
    }
    for (int q = q0; q < qend; q += qstride) {
        int u;
        if (which == 0) u = q < 176 ? q : q < 240 ? 352 + (q - 176) : q < 592 ? 480 + (q - 240) : q < 768 ? 1184 + (q - 592) : q < 1120 ? 832 + (q - 768) : 1536 + (q - 1120);
        else if (which == 1) u = q < 176 ? 176 + q : 416 + (q - 176);
        else u = 1360 + q;
        if (u < 1536) {
            const float* src; hf* dst; int ld, K, r0, k0, kind;
            if (u < 352) { const int l = u / 176, rem = u % 176; r0 = (rem / 16) * 256; k0 = (rem % 16) * 64; ld = INC; K = D; kind = 0; src = P.w_in + (size_t)l * D * INC; dst = (hf*)(P.ws + OFF_WIN) + (size_t)l * INP * D; }
            else if (u < 480) { const int i = u - 352, l = i / 64, rem = i % 64; r0 = (rem / 16) * 256; k0 = (rem % 16) * 64; ld = D; K = D; kind = 1; src = P.w_out + (size_t)l * D * D; dst = (hf*)(P.ws + OFF_WOUT) + (size_t)l * D * D; }
            else if (u < 1184) { const int i = u - 480, l = i / 352, rem = i % 352; r0 = (rem / 16) * 256; k0 = (rem % 16) * 64; ld = NGU; K = D; kind = 2; src = P.w_gu + (size_t)l * D * NGU; dst = (hf*)(P.ws + OFF_WGU) + (size_t)l * NGU * D; }
            else { const int i = u - 1184, l = i / 176, rem = i % 176; r0 = (rem / 44) * 256; k0 = (rem % 44) * 64; ld = D; K = DFF; kind = 3; src = P.w_down + (size_t)l * DFF * D; dst = (hf*)(P.ws + OFF_WDN) + (size_t)l * D * DFF; }
            const int c4 = (tid & 63) * 4, kq = tid >> 6;
            int scol = r0 + c4; bool valid = true;
            if (kind == 2) scol = c4 < 128 ? (r0 >> 1) + c4 : DFF + (r0 >> 1) + (c4 - 128);
            else if (kind == 0 && scol >= INC) valid = false;
            f4 v[8];
#pragma unroll
            for (int i = 0; i < 8; ++i) v[i] = valid ? *(const f4*)(src + (size_t)(k0 + kq + 8 * i) * ld + scol) : (f4){0.f, 0.f, 0.f, 0.f};
#pragma unroll
            for (int i = 0; i < 8; ++i) { float* tp = tile + (kq + 8 * i) * 257 + c4; tp[0] = v[i][0]; tp[1] = v[i][1]; tp[2] = v[i][2]; tp[3] = v[i][3]; }
            __syncthreads();
            const int kc = tid & 7;
#pragma unroll
            for (int p = 0; p < 4; ++p) {
                const int rr = (tid >> 3) + 64 * p;
                const int c = kind == 2 ? ((rr >> 5) & 1) * 128 + (rr >> 6) * 32 + (rr & 31) : rr;
                h8 o;
#pragma unroll
                for (int j = 0; j < 8; ++j) o[j] = (hf)tile[(kc * 8 + j) * 257 + c];
                *(h8*)(dst + (size_t)(r0 + rr) * K + k0 + kc * 8) = o;
            }
            __syncthreads();
        } else if (u < 1536 + 192) {
            const int i = u - 1536, l = i / 96, rem = i % 96, cc = rem / 8, ks = rem % 8;
            float* sv = (float*)lds;
            if (tid < 256) { const int set = tid >> 7, k = tid & 127; const float v = set ? P.c_ctx[ks * 128 + k] : P.c[ks * 128 + k]; sv[tid] = v / (1.0f + expf(-v)); }
            __syncthreads();
            const int n = cc * 512 + tid;
            const float* w = P.w_ada + (size_t)l * D * 6144 + (size_t)(ks * 128) * 6144 + n;
            float a0 = 0.f, a1 = 0.f;
#pragma unroll 16
            for (int k = 0; k < 128; ++k) { const float wv = w[(size_t)k * 6144]; a0 += sv[k] * wv; a1 += sv[128 + k] * wv; }
            float* mp = (float*)(P.ws + OFF_MODP);
            mp[(size_t)((ks * 2 + l) * 2 + 0) * 6144 + n] = a0;
            mp[(size_t)((ks * 2 + l) * 2 + 1) * 6144 + n] = a1;
            __syncthreads();
        } else {
            const int e = (u - 1728) * 512 + tid, pos = e >> 4, f = e & 15;
            const float inv = exp2f(-(float)f * (13.287712379549449f / 16.0f));
            const float ang = (float)pos * inv;
            float sn, cs; sincosf(ang, &sn, &cs);
            float2* rt = (float2*)(P.ws + OFF_ROPE);
            rt[e] = make_float2(cs, sn);
        }
    }
}

__device__ __forceinline__ void phase_modfin(const Params& P) {
    const float* mp = (const float*)(P.ws + OFF_MODP);
    float* mo = (float*)(P.ws + OFF_MOD);
    for (int e = blockIdx.x * 512 + opaque_tid(); e < 2 * 2 * 6144; e += gridDim.x * 512) {
        const int l = e / 12288, rem = e % 12288, set = rem / 6144, n = rem % 6144;
        float s = P.b_ada[l * 6144 + n];
#pragma unroll
        for (int ks = 0; ks < 8; ++ks) s += mp[(size_t)((ks * 2 + l) * 2 + set) * 6144 + n];
        mo[e] = s;
    }
}

__device__ __forceinline__ void phase_rows(const Params& P, int mode, int nrows, const float* lg, const float* lb, int modlayer, int which_sh, int which_sc) {
    const int tid = opaque_tid(), lane = tid & 63, w = tid >> 6;
    hf* H = (hf*)(P.ws + OFF_H16);
    float2* stats = (float2*)(P.ws + OFF_STATS);
    const int half = nrows >> 1;
    for (int r0 = blockIdx.x * 8 + w; r0 < half; r0 += gridDim.x * 8) {
        f4 v[2][4];
#pragma unroll
        for (int k = 0; k < 2; ++k) {
            const int row = r0 + k * half;
            const float* src = mode == 0 ? (row < NL ? P.x + (size_t)row * D : P.ctx + (size_t)(row - NL) * D) : xr_row(P, row);
#pragma unroll
            for (int i = 0; i < 4; ++i) v[k][i] = *(const f4*)(src + (lane + 64 * i) * 4);
        }
#pragma unroll
        for (int k = 0; k < 2; ++k) {
            const int row = r0 + k * half;
            const int set = row >= NL ? 1 : 0;
            if (mode != 0) {
                float s = 0.f;
#pragma unroll
                for (int i = 0; i < 4; ++i) s += (v[k][i][0] + v[k][i][1]) + (v[k][i][2] + v[k][i][3]);
#pragma unroll
                for (int d = 32; d >= 1; d >>= 1) s += shflx(s, d, lane);
                const float mean = s * (1.0f / 1024.0f);
                float q = 0.f;
#pragma unroll
                for (int i = 0; i < 4; ++i) { const f4 dd = v[k][i] - mean; q += (dd[0] * dd[0] + dd[1] * dd[1]) + (dd[2] * dd[2] + dd[3] * dd[3]); }
#pragma unroll
                for (int d = 32; d >= 1; d >>= 1) q += shflx(q, d, lane);
                const float rstd = 1.0f / sqrtf(q * (1.0f / 1024.0f) + 1e-5f);
                if (lane == 0) stats[row] = make_float2(mean, rstd);
#pragma unroll
                for (int i = 0; i < 4; ++i) { const int col = (lane + 64 * i) * 4; const f4 g = *(const f4*)(lg + col), b = *(const f4*)(lb + col); v[k][i] = (v[k][i] - mean) * rstd * g + b; }
            }
            if (mode == 2) {
                float* dst = xr_row(P, row);
#pragma unroll
                for (int i = 0; i < 4; ++i) *(f4*)(dst + (lane + 64 * i) * 4) = v[k][i];
            } else {
                const float* sh = modv(P, modlayer, set, which_sh); const float* sc = modv(P, modlayer, set, which_sc);
#pragma unroll
                for (int i = 0; i < 4; ++i) { const int col = (lane + 64 * i) * 4; const f4 a = *(const f4*)(sc + col), b = *(const f4*)(sh + col); const f4 y = v[k][i] * (1.0f + a) + b;
                    h4 o; o[0] = (hf)y[0]; o[1] = (hf)y[1]; o[2] = (hf)y[2]; o[3] = (hf)y[3]; *(h4*)(H + (size_t)row * D + col) = o; }
            }
        }
    }
}

__device__ __forceinline__ int lds_byte(int r, int c) { const int st = (r >> 4) * 2 + (c >> 5), rr = r & 15, cc = c & 31, ob = rr * 64 + cc * 2; return st * 1024 + (ob ^ (((ob >> 9) & 1) << 5)); }
__device__ __forceinline__ void stage_rc(int b, int& R, int& C) { const int st = b / 1024, sb = b % 1024, swz = sb ^ (((sb >> 9) & 1) << 5); R = (st >> 1) * 16 + swz / 64; C = (st & 1) * 32 + (swz % 64) / 2; }

template <class Epi>
__device__ __forceinline__ void gemm_phase(const hf* X, const hf* Wt, int Mtiles, int Ntiles, int K, const Epi& epi, char* lds, int mode) {
    constexpr int BK = 64, HALF = 128, HTB = HALF * BK * 2;
    const int tid = opaque_tid_w(epi.P.wv), lane = tid & 63, wid = tid >> 6, wr = wid >> 2, wc = wid & 3, fr = lane & 15, fq = lane >> 4;
#define SA(b, h) (lds + ((b) * 2 + (h)) * HTB)
#define SB(b, h) (lds + (4 + (b) * 2 + (h)) * HTB)
#define STAGE(Pp, BASE, br, kt) do { const hf* _g = (BASE) + (long)(br) * K + (long)(kt) * BK; \
      __builtin_amdgcn_global_load_lds((const unsigned*)((const char*)_g + soff), (LAS unsigned*)((Pp) + wbase), 16, 0, 0); \
      __builtin_amdgcn_global_load_lds((const unsigned*)((const char*)(_g + (long)64 * K) + soff), (LAS unsigned*)((Pp) + wbase + 8192), 16, 0, 0); } while (0)
#define LDA(dst, b, h) _Pragma("unroll") for (int m = 0; m < 4; ++m) _Pragma("unroll") for (int k = 0; k < 2; ++k) \
    dst[m][k] = *reinterpret_cast<const h8*>(SA(b, h) + lds_byte(wr * 64 + m * 16 + fr, k * 32 + fq * 8))
#define LDB(dst, b, h) _Pragma("unroll") for (int n = 0; n < 2; ++n) _Pragma("unroll") for (int k = 0; k < 2; ++k) \
    dst[n][k] = *reinterpret_cast<const h8*>(SB(b, h) + lds_byte(wc * 32 + n * 16 + fr, k * 32 + fq * 8))
#define MMA(ai, bj, At_, Bt_) do { __builtin_amdgcn_s_setprio(1); \
    _Pragma("unroll") for (int m = 0; m < 4; ++m) _Pragma("unroll") for (int n = 0; n < 2; ++n) _Pragma("unroll") for (int k = 0; k < 2; ++k) \
      acc[ai][bj][m][n] = __builtin_amdgcn_mfma_f32_16x16x32_f16(At_[m][k], Bt_[n][k], acc[ai][bj][m][n], 0, 0, 0); \
    __builtin_amdgcn_s_setprio(0); } while (0)
#define WAIT_V(n) asm volatile("s_waitcnt vmcnt(" #n ")" ::: "memory")
#define WAIT_L(n) asm volatile("s_waitcnt lgkmcnt(" #n ")" ::: "memory")
#define BAR __builtin_amdgcn_s_barrier()
#define SCHED __builtin_amdgcn_sched_barrier(0)
    const int nt = K / BK;
    const int wbase = __builtin_amdgcn_readfirstlane(wid) * 1024;
    unsigned soff; { int r0, c0; stage_rc(tid * 16, r0, c0); soff = (unsigned)(r0 * K + c0) * 2u; }
    const int G = gridDim.x, per = (G & 7) == 0 ? G >> 3 : 0, total = Mtiles * Ntiles;
#pragma unroll 1
    for (int it = 0;; ++it) {
        int v = per ? (it * 8 + (blockIdx.x & 7)) * per + (blockIdx.x >> 3) : it * G + blockIdx.x;
        if (mode == 1 || mode == 3) v = (it == 0 && (int)(blockIdx.x & 7) == (mode == 1 ? 5 : 7) && (blockIdx.x >> 3) < 4) ? (int)(blockIdx.x >> 3) : total;
        if (mode == 4 && (blockIdx.x & 7) == 7) {
            const int j = blockIdx.x >> 3;
            if (j < 4 && it >= 1) v = total; else if (j >= 4 && j < 8 && it == 2) v = 480 + (j - 4);
        }
        if (v >= total) break;
        const int grp = v / (4 * Ntiles), rem = v - grp * 4 * Ntiles, rows = Mtiles - 4 * grp < 4 ? Mtiles - 4 * grp : 4;
        int pn = rem / rows, pm = 4 * grp + rem % rows;
        if (mode == 1 || mode == 3) { pn = v; pm = 64; }
        unsigned* ctxready = (unsigned*)(epi.P.ws + OFF_CNT) + (mode >= 3 ? 301 : 300);
        if ((mode == 2 || mode == 4) && pm == 64) {
            if (opaque_tid_w(epi.P.wv) == 0) {
                unsigned spins = 0;
                while (__hip_atomic_load(ctxready, __ATOMIC_RELAXED, __HIP_MEMORY_SCOPE_AGENT) < 4u) { __builtin_amdgcn_s_sleep(2); if (++spins > (1u << 22)) break; }
                __builtin_amdgcn_fence(__ATOMIC_ACQUIRE, "agent");
                asm volatile("s_waitcnt vmcnt(0)" ::: "memory");
            }
            __syncthreads();
        }
        const int brow = pn * 256, bcol = pm * 256;
        f4 acc[2][2][4][2];
#pragma unroll
        for (int a = 0; a < 2; ++a)
#pragma unroll
            for (int b = 0; b < 2; ++b)
#pragma unroll
                for (int m = 0; m < 4; ++m)
#pragma unroll
                    for (int n = 0; n < 2; ++n) acc[a][b][m][n] = (f4){0.f, 0.f, 0.f, 0.f};
        h8 At[4][2], B0[2][2], B1[2][2];
        STAGE(SB(0, 0), X, bcol, 0); STAGE(SA(0, 0), Wt, brow, 0);
        STAGE(SB(0, 1), X, bcol + HALF, 0); STAGE(SA(0, 1), Wt, brow + HALF, 0);
        if (wr == 1) BAR;
        WAIT_V(4); BAR;
        STAGE(SB(1, 0), X, bcol, 1); STAGE(SA(1, 0), Wt, brow, 1); STAGE(SB(1, 1), X, bcol + HALF, 1);
        WAIT_V(6); BAR;
#pragma unroll 1
        for (int t = 0; t < nt - 2; t += 2) {
            LDB(B0, 0, 0); SCHED; LDA(At, 0, 0); STAGE(SA(1, 1), Wt, brow + HALF, t + 1);
            WAIT_L(8); BAR; WAIT_L(0); MMA(0, 0, At, B0); BAR; SCHED;
            LDB(B1, 0, 1); STAGE(SB(0, 0), X, bcol, t + 2);
            BAR; WAIT_L(0); MMA(0, 1, At, B1); BAR;
            LDA(At, 0, 1); STAGE(SA(0, 0), Wt, brow, t + 2);
            BAR; WAIT_L(0); MMA(1, 0, At, B0); BAR; SCHED;
            STAGE(SB(0, 1), X, bcol + HALF, t + 2);
            WAIT_V(6); BAR; MMA(1, 1, At, B1); BAR;
            LDB(B0, 1, 0); SCHED; LDA(At, 1, 0); STAGE(SA(0, 1), Wt, brow + HALF, t + 2);
            WAIT_L(8); BAR; WAIT_L(0); MMA(0, 0, At, B0); BAR; SCHED;
            LDB(B1, 1, 1); STAGE(SB(1, 0), X, bcol, t + 3);
            BAR; WAIT_L(0); MMA(0, 1, At, B1); BAR;
            LDA(At, 1, 1); STAGE(SA(1, 0), Wt, brow, t + 3);
            BAR; WAIT_L(0); MMA(1, 0, At, B0); BAR; SCHED;
            STAGE(SB(1, 1), X, bcol + HALF, t + 3);
            WAIT_V(6); BAR; MMA(1, 1, At, B1); BAR;
        }
        { LDB(B0, 0, 0); LDA(At, 0, 0); STAGE(SA(1, 1), Wt, brow + HALF, nt - 1);
          BAR; WAIT_L(0); MMA(0, 0, At, B0); BAR;
          LDB(B1, 0, 1); BAR; WAIT_L(0); MMA(0, 1, At, B1); BAR;
          LDA(At, 0, 1); WAIT_V(4); BAR; WAIT_L(0); MMA(1, 0, At, B0); MMA(1, 1, At, B1); BAR; }
        { LDB(B0, 1, 0); LDA(At, 1, 0); WAIT_V(2); BAR; WAIT_L(0); MMA(0, 0, At, B0); BAR;
          LDB(B1, 1, 1); WAIT_V(0); BAR; WAIT_L(0); MMA(0, 1, At, B1); BAR;
          LDA(At, 1, 1); BAR; WAIT_L(0); MMA(1, 0, At, B0); MMA(1, 1, At, B1); BAR; }
        if (wr == 0) BAR;
        epi(acc, pm, pn, wr, wc, fr, fq, lds);
        if (mode == 1 || mode == 3) {
            asm volatile("s_waitcnt vmcnt(0)" ::: "memory");
            __syncthreads();
            if (opaque_tid_w(epi.P.wv) == 0) {
                __builtin_amdgcn_fence(__ATOMIC_RELEASE, "agent");
                asm volatile("s_waitcnt vmcnt(0)" ::: "memory");
                __hip_atomic_fetch_add(ctxready, 1u, __ATOMIC_RELAXED, __HIP_MEMORY_SCOPE_AGENT);
            }
        }
    }
#undef SA
#undef SB
#undef STAGE
#undef LDA
#undef LDB
#undef MMA
#undef WAIT_V
#undef WAIT_L
#undef BAR
#undef SCHED
}

__device__ __forceinline__ unsigned pk2h(float lo, float hi) { h2 v; v[0] = (hf)lo; v[1] = (hf)hi; return __builtin_bit_cast(unsigned, v); }
struct EpiIn {
    Params P; int layer;
    __device__ __forceinline__ void operator()(f4 (&acc)[2][2][4][2], int pm, int pn, int, int, int, int, char*) const {
        hf* qkv = (hf*)(P.ws + OFF_QKV);
        const float2* rope = (const float2*)(P.ws + OFF_ROPE);
        const int tq_ = opaque_tid_w(P.wv), lane = tq_ & 63, wr = tq_ >> 8, wc = (tq_ >> 6) & 3, fr = lane & 15, fq = lane >> 4;
#pragma unroll
        for (int ai = 0; ai < 2; ++ai) {
            const int fb = pn * 4 + ai * 2 + wr;
            if (fb > 40) continue;
#pragma unroll
            for (int bj = 0; bj < 2; ++bj)
#pragma unroll
                for (int n = 0; n < 2; ++n) {
                    const int t = pm * 256 + bj * 128 + wc * 32 + n * 16 + fr;
                    f4 v[4];
#pragma unroll
                    for (int m = 0; m < 4; ++m) v[m] = acc[ai][bj][m][n];
                    if (fb < 16) {
                        const int sub = fb & 7;
                        if (sub < 6) {
                            if (fb >= 8) {
                                float ss = 0.f;
#pragma unroll
                                for (int m = 0; m < 4; ++m) ss += (v[m][0] * v[m][0] + v[m][1] * v[m][1]) + (v[m][2] * v[m][2] + v[m][3] * v[m][3]);
                                ss += shflx(ss, 16, lane); ss += shflx(ss, 32, lane);
                                const float rs = 1.0f / sqrtf(ss * (1.0f / 64.0f) + 1e-6f);
                                const float* gn = (sub < 4 ? P.q_gain : P.k_gain) + layer * 64;
#pragma unroll
                                for (int m = 0; m < 4; ++m) { const f4 g = *(const f4*)(gn + m * 16 + fq * 4); v[m] = v[m] * rs * g; }
                            }
                            if (t < NL) {
#pragma unroll
                                for (int ax = 0; ax < 2; ++ax) {
                                    const int pos = ax == 0 ? (t >> 6) : (t & 63);
                                    const f4* rp4 = (const f4*)(rope + pos * 16 + fq * 4);
                                    const f4 c01 = rp4[0], c23 = rp4[1];
#pragma unroll
                                    for (int j = 0; j < 4; ++j) { float2 cs; cs.x = (j < 2 ? c01 : c23)[(j & 1) * 2]; cs.y = (j < 2 ? c01 : c23)[(j & 1) * 2 + 1]; const float u1 = v[2 * ax][j], u2 = v[2 * ax + 1][j];
                                        v[2 * ax][j] = u1 * cs.x - u2 * cs.y; v[2 * ax + 1][j] = u1 * cs.y + u2 * cs.x; }
                                }
                            }
                            const float sc = sub < 4 ? 0.125f * LOG2E : 1.0f;
                            hf* dst = qkv + (size_t)fb * HT + (size_t)t * 64 + pair_off(fq);
#pragma unroll
                            for (int mp = 0; mp < 2; ++mp) { h4 o0, o1;
#pragma unroll
                                for (int e = 0; e < 4; ++e) { o0[e] = (hf)(v[2 * mp][e] * sc); o1[e] = (hf)(v[2 * mp + 1][e] * sc); }
                                *(u4*)(dst + mp * 32) = pair16(o0, o1); }
                        } else {
                            const int tp = (t & ~12) | (((t >> 2) & 1) << 3) | (((t >> 3) & 1) << 2);
                            const int q4 = fr & 3; const bool b0 = q4 & 1, b1 = (q4 & 2) != 0;
                            const int qd = fr >> 2, qpos = ((qd & 1) << 1) | (qd >> 1);
                            __attribute__((address_space(1))) hf* dst = (__attribute__((address_space(1))) hf*)(qkv + (size_t)fb * HT + (t & ~15) + 4 * qpos + (size_t)(4 * fq + q4) * NT);
#pragma unroll
                            for (int m = 0; m < 4; ++m) {
                                const float x0 = v[m][0], x1 = v[m][1], x2 = v[m][2], x3 = v[m][3];
                                const float r01 = __builtin_bit_cast(float, __builtin_amdgcn_update_dpp(0, __builtin_bit_cast(int, b0 ? x0 : x1), 0xB1, 0xf, 0xf, false));
                                const float r23 = __builtin_bit_cast(float, __builtin_amdgcn_update_dpp(0, __builtin_bit_cast(int, b0 ? x2 : x3), 0xB1, 0xf, 0xf, false));
                                const unsigned A0 = b0 ? pk2h(r01, x1) : pk2h(x0, r01), A1 = b0 ? pk2h(r23, x3) : pk2h(x2, r23);
                                const unsigned rB = (unsigned)__builtin_amdgcn_update_dpp(0, (int)(b1 ? A0 : A1), 0x4E, 0xf, 0xf, false);
                                u2 w2; w2.x = b1 ? rB : A0; w2.y = b1 ? A1 : rB;
                                *(__attribute__((address_space(1))) u2*)(dst + (size_t)(m * 16) * NT) = w2;
                            }
                        }
                    } else if (fb < 40) {
                        hf* dst = (fb < 24 ? (hf*)(P.ws + OFF_Z) + (size_t)t * 512 + (fb - 16) * 64 : (hf*)(P.ws + OFF_XBC) + (size_t)t * 1024 + (fb - 24) * 64) + pair_off(fq);
#pragma unroll
                        for (int mp = 0; mp < 2; ++mp) { h4 o0, o1;
#pragma unroll
                            for (int e = 0; e < 4; ++e) { o0[e] = (hf)v[2 * mp][e]; o1[e] = (hf)v[2 * mp + 1][e]; }
                            *(u4*)(dst + mp * 32) = pair16(o0, o1); }
                    } else {
                        *(f4*)((float*)(P.ws + OFF_DTR) + (size_t)t * 16 + fq * 4) = v[0];
                    }
                }
        }
    }
};

struct EpiRes {
    Params P; int layer; int which_g; const float* lng; const float* lnb;
    __device__ __forceinline__ void operator()(f4 (&acc)[2][2][4][2], int pm, int pn, int wr, int wc, int fr, int fq, char*) const {
        const float2* stats = (const float2*)(P.ws + OFF_STATS);
#pragma unroll
        for (int bj = 0; bj < 2; ++bj)
#pragma unroll
            for (int n = 0; n < 2; ++n) {
                const int t = pm * 256 + bj * 128 + wc * 32 + n * 16 + fr;
                float* xr = xr_row(P, t);
                const float* xin = lng ? xr : (t < NL ? P.x + (size_t)t * D : P.ctx + (size_t)(t - NL) * D);
                float2 st = make_float2(0.f, 1.f);
                if (lng) st = stats[t];
                const float* g = modv(P, layer, t >= NL ? 1 : 0, which_g);
#pragma unroll
                for (int ai = 0; ai < 2; ++ai)
#pragma unroll
                    for (int m = 0; m < 4; ++m) {
                        const int f = pn * 256 + ai * 128 + wr * 64 + m * 16 + fq * 4;
                        f4 xv = *(const f4*)(xin + f); const f4 gv = *(const f4*)(g + f);
                        if (lng) { const f4 lg4 = *(const f4*)(lng + f), lb4 = *(const f4*)(lnb + f); xv = (xv - st.x) * st.y * lg4 + lb4; }
                        *(f4*)(xr + f) = ALPHA * xv + gv * acc[ai][bj][m][n];
                    }
            }
    }
};

struct EpiResLN {
    Params P; int layer; int which_g; const float* lng_in; const float* lnb_in;
    const float* lng; const float* lnb; int modlayer, which_sh, which_sc; int final_out; int inst;
    __device__ __forceinline__ void operator()(f4 (&acc)[2][2][4][2], int pm, int pn, int wr, int wc, int fr, int fq, char* lds) const {
        const int tid = opaque_tid(), lane = tid & 63, wid = tid >> 6;
        float2* stats = (float2*)(P.ws + OFF_STATS);
        float2* part = (float2*)lds;
        float2* mr = (float2*)(lds + 4096);
        volatile LAS unsigned* flag = (volatile LAS unsigned*)(lds + 8192);
        unsigned long long* slots = (unsigned long long*)(P.ws + OFF_XSL);
        unsigned* cnt = (unsigned*)(P.ws + OFF_CNT) + inst * 65 + pm;
        const int wr1 = wid >> 2, wc1 = wid & 3, fr1 = lane & 15, fq1 = lane >> 4;
        const float* g = modv(P, layer, pm == 64 ? 1 : 0, which_g);
        float sa[2][2], qa[2][2];
#pragma unroll
        for (int bj = 0; bj < 2; ++bj)
#pragma unroll
            for (int n = 0; n < 2; ++n) { sa[bj][n] = 0.f; qa[bj][n] = 0.f; }
#pragma unroll
        for (int ai = 0; ai < 2; ++ai)
#pragma unroll
            for (int mp = 0; mp < 2; ++mp) {
                const int fp = pn * 256 + ai * 128 + wr1 * 64 + mp * 32;
                f4 gv[2], lg4[2], lb4[2];
#pragma unroll
                for (int mm = 0; mm < 2; ++mm) { const int f = fp + mm * 16 + fq1 * 4; gv[mm] = *(const f4*)(g + f);
                    if (lng_in) { lg4[mm] = *(const f4*)(lng_in + f); lb4[mm] = *(const f4*)(lnb_in + f); } }
#pragma unroll
                for (int bj = 0; bj < 2; ++bj)
#pragma unroll
                    for (int n = 0; n < 2; ++n) {
                        const int t = pm * 256 + bj * 128 + wc1 * 32 + n * 16 + fr1;
                        float2 st = make_float2(0.f, 1.f); if (lng_in) st = stats[t];
                        h4 x16[2];
                        if (lng_in) { const u4 wv = *(const u4*)(xr16_row(P, t, inst == 3) + fp + pair_off(fq1));
                            const auto r0 = __builtin_amdgcn_permlane16_swap(wv.x, wv.z, false, false); const auto r1 = __builtin_amdgcn_permlane16_swap(wv.y, wv.w, false, false);
                            u2 a2; a2.x = r0[0]; a2.y = r1[0]; u2 b2; b2.x = r0[1]; b2.y = r1[1];
                            x16[0] = __builtin_bit_cast(h4, a2); x16[1] = __builtin_bit_cast(h4, b2); }
                        h4 v16[2];
#pragma unroll
                        for (int mm = 0; mm < 2; ++mm) {
                            const int m = 2 * mp + mm;
                            const int f = fp + mm * 16 + fq1 * 4;
                            f4 xv;
                            if (lng_in) { xv[0] = (float)x16[mm][0]; xv[1] = (float)x16[mm][1]; xv[2] = (float)x16[mm][2]; xv[3] = (float)x16[mm][3];
                                xv = (xv - st.x) * st.y * lg4[mm] + lb4[mm]; }
                            else xv = *(const f4*)((t < NL ? P.x + (size_t)t * D : P.ctx + (size_t)(t - NL) * D) + f);
                            const f4 v = ALPHA * xv + gv[mm] * acc[ai][bj][m][n];
                            acc[ai][bj][m][n] = v;
                            v16[mm][0] = (hf)v[0]; v16[mm][1] = (hf)v[1]; v16[mm][2] = (hf)v[2]; v16[mm][3] = (hf)v[3];
                            sa[bj][n] += (v[0] + v[1]) + (v[2] + v[3]); qa[bj][n] += (v[0] * v[0] + v[1] * v[1]) + (v[2] * v[2] + v[3] * v[3]);
                        }
                        if (!final_out) *(u4*)(xr16_row(P, t, inst == 2) + fp + pair_off(fq1)) = pair16(v16[0], v16[1]);
                    }
            }
#pragma unroll
        for (int bj = 0; bj < 2; ++bj)
#pragma unroll
            for (int n = 0; n < 2; ++n) {
                float s = sa[bj][n], q = qa[bj][n];
                s += shflx(s, 16, lane); s += shflx(s, 32, lane); q += shflx(q, 16, lane); q += shflx(q, 32, lane);
                if (fq1 == 0) { const int t2 = opaque_tid();
                    part[(bj * 128 + ((t2 >> 6) & 3) * 32 + n * 16 + (t2 & 15)) * 2 + (t2 >> 8)] = make_float2(s, q); }
            }
        __syncthreads();
        if (tid < 256) { const float2 a = part[tid * 2], b = part[tid * 2 + 1];
            const unsigned long long wv = ((unsigned long long)__float_as_uint(a.y + b.y) << 32) | __float_as_uint(a.x + b.x);
            __hip_atomic_store(slots + (size_t)(pm * 256 + tid) * 4 + pn, wv, __ATOMIC_RELAXED, __HIP_MEMORY_SCOPE_AGENT); }
        asm volatile("s_waitcnt vmcnt(0)" ::: "memory");
        __syncthreads();
        if (wid == 0) {
            if (lane == 0) __hip_atomic_fetch_add(cnt, 1u, __ATOMIC_RELAXED, __HIP_MEMORY_SCOPE_AGENT);
            unsigned spins = 0; bool dead = false;
            while ((unsigned)__builtin_amdgcn_readfirstlane((int)__hip_atomic_load(cnt, __ATOMIC_RELAXED, __HIP_MEMORY_SCOPE_AGENT)) < 4u) {
                __builtin_amdgcn_s_sleep(2);
                if (++spins > (1u << 22)) { dead = true; break; }
            }
            __builtin_amdgcn_fence(__ATOMIC_ACQUIRE, "agent");
            asm volatile("s_waitcnt vmcnt(0)" ::: "memory");
            if (lane == 0) flag[0] = dead ? 1u : 0u;
        }
        __syncthreads();
        if (tid < 256) { const unsigned long long* sl = slots + (size_t)(pm * 256 + tid) * 4; float s = 0.f, q = 0.f;
#pragma unroll
            for (int k = 0; k < 4; ++k) { const unsigned long long wv = __hip_atomic_load(sl + k, __ATOMIC_RELAXED, __HIP_MEMORY_SCOPE_AGENT); s += __uint_as_float((unsigned)wv); q += __uint_as_float((unsigned)(wv >> 32)); }
            const float mean = s * (1.0f / 1024.0f);
            float var = q * (1.0f / 1024.0f) - mean * mean; var = var < 0.f ? 0.f : var;
            float2 o = make_float2(mean, 1.0f / sqrtf(var + 1e-5f));
            if (flag[0]) o = make_float2(__builtin_nanf(""), __builtin_nanf(""));
            mr[tid] = o;
            if (pn == 0) stats[pm * 256 + tid] = o; }
        __syncthreads();
        hf* H = (hf*)(P.ws + OFF_H16);
        const int t4 = opaque_tid(), wr4 = t4 >> 8, wc4 = (t4 >> 6) & 3, fr4 = t4 & 15, fq4 = (t4 >> 4) & 3;
        const float* sh = modv(P, modlayer, pm == 64 ? 1 : 0, which_sh); const float* sc = modv(P, modlayer, pm == 64 ? 1 : 0, which_sc);
#pragma unroll
        for (int ai = 0; ai < 2; ++ai)
#pragma unroll
            for (int mp = 0; mp < 2; ++mp) {
                const int fp = pn * 256 + ai * 128 + wr4 * 64 + mp * 32;
                f4 lg4[2], lb4[2], sc4[2], sh4[2];
#pragma unroll
                for (int mm = 0; mm < 2; ++mm) { const int f = fp + mm * 16 + fq4 * 4; lg4[mm] = *(const f4*)(lng + f); lb4[mm] = *(const f4*)(lnb + f);
                    if (!final_out) { sc4[mm] = *(const f4*)(sc + f); sh4[mm] = *(const f4*)(sh + f); } }
#pragma unroll
                for (int bj = 0; bj < 2; ++bj)
#pragma unroll
                    for (int n = 0; n < 2; ++n) {
                        const int tl = bj * 128 + wc4 * 32 + n * 16 + fr4, t = pm * 256 + tl;
                        const float2 st = mr[tl];
                        h4 o16[2];
#pragma unroll
                        for (int mm = 0; mm < 2; ++mm) {
                            const int m = 2 * mp + mm;
                            const f4 xn = (acc[ai][bj][m][n] - st.x) * st.y * lg4[mm] + lb4[mm];
                            if (final_out) { if (t < NL) *(f4*)(P.out + (size_t)t * D + fp + mm * 16 + fq4 * 4) = xn; }
                            else { const f4 y = xn * (1.0f + sc4[mm]) + sh4[mm];
                                o16[mm][0] = (hf)y[0]; o16[mm][1] = (hf)y[1]; o16[mm][2] = (hf)y[2]; o16[mm][3] = (hf)y[3]; }
                        }
                        if (!final_out) *(u4*)(H + (size_t)t * D + fp + pair_off(fq4)) = pair16(o16[0], o16[1]);
                    }
            }
        __syncthreads();
    }
};

struct EpiGU {
    Params P;
    __device__ __forceinline__ void operator()(f4 (&acc)[2][2][4][2], int pm, int pn, int, int, int, int, char*) const {
        hf* G = (hf*)(P.ws + OFF_G16);
        const int tq_ = opaque_tid_w(P.wv), wr = tq_ >> 8, wc = (tq_ >> 6) & 3, fr = tq_ & 15, fq = (tq_ >> 4) & 3;
        const int offe = pair_off(fq);
#pragma unroll
        for (int bj = 0; bj < 2; ++bj)
#pragma unroll
            for (int n = 0; n < 2; ++n) {
                const int t = pm * 256 + bj * 128 + wc * 32 + n * 16 + fr;
#pragma unroll
                for (int ai = 0; ai < 2; ++ai) {
                    u2 pk[2];
#pragma unroll
                    for (int mm = 0; mm < 2; ++mm) {
                        const f4 gt = acc[ai][bj][mm][n], up = acc[ai][bj][mm + 2][n];
                        h4 o;
#pragma unroll
                        for (int e = 0; e < 4; ++e) o[e] = (hf)(silu_f(gt[e]) * up[e]);
                        pk[mm] = __builtin_bit_cast(u2, o);
                    }
                    const auto r0 = __builtin_amdgcn_permlane16_swap(pk[0].x, pk[1].x, false, false);
                    const auto r1 = __builtin_amdgcn_permlane16_swap(pk[0].y, pk[1].y, false, false);
                    u4 w4; w4.x = r0[0]; w4.y = r1[0]; w4.z = r0[1]; w4.w = r1[1];
                    *(u4*)(G + (size_t)t * DFF + pn * 128 + (ai * 2 + wr) * 32 + offe) = w4;
                }
            }
    }
};

__device__ __forceinline__ void phase_prep(const Params& P, int layer, char* lds) {
    const int tid = opaque_tid();
    hf* raw = (hf*)lds;
    hf* outt = (hf*)(lds + 32768);
    const hf* XBC = (const hf*)(P.ws + OFF_XBC);
    hf* U = (hf*)(P.ws + OFF_U); hf* UT = (hf*)(P.ws + OFF_UT);
    u4 pre[3];
#define PREP_FETCH(uu) do { const int tb_ = (uu) >> 3, cb_ = (uu) & 7, t0_ = tb_ * 64, c0_ = cb_ * 128; const int s0_ = t0_ < NL ? 0 : NL, s1_ = t0_ < NL ? NL : NT; \
    _Pragma("unroll") for (int i_ = 0; i_ < 3; ++i_) { const int e_ = tid + i_ * 512, r_ = e_ >> 4, ch_ = e_ & 15, t_ = t0_ - 2 + r_; u4 v_ = {0u, 0u, 0u, 0u}; \
        if (e_ < 68 * 16 && t_ >= s0_ && t_ < s1_) v_ = *(const u4*)(XBC + (size_t)t_ * 1024 + c0_ + ch_ * 8); pre[i_] = v_; } } while (0)
    if (blockIdx.x < 260 * 8) PREP_FETCH(blockIdx.x);
    float wv[5] = {0.f, 0.f, 0.f, 0.f, 0.f}, bb = 0.f; int cbw = -1;
    for (int u = blockIdx.x; u < 260 * 8; u += gridDim.x) {
        const int tb = u >> 3, cb = u & 7, t0 = tb * 64, c0 = cb * 128;
#pragma unroll
        for (int i = 0; i < 3; ++i) { const int e = tid + i * 512; if (e < 68 * 16) *(u4*)(raw + (e >> 4) * 128 + (e & 15) * 8) = pre[i]; }
        __syncthreads();
        if (u + (int)gridDim.x < 260 * 8) PREP_FETCH(u + gridDim.x);
        {
            const int ch = tid & 127, tq = tid >> 7, gc = c0 + ch;
            if (cb != cbw) {
                cbw = cb;
#pragma unroll
                for (int k = 0; k < 5; ++k) wv[k] = P.conv_w[(size_t)layer * 5 * 1024 + k * 1024 + gc];
                bb = P.conv_b[layer * 1024 + gc];
            }
            float xin[20];
#pragma unroll
            for (int i = 0; i < 20; ++i) xin[i] = (float)raw[(tq * 16 + i) * 128 + ch];
            h8 o0, o1;
#pragma unroll
            for (int i = 0; i < 16; ++i) {
                float s = bb;
#pragma unroll
                for (int k = 0; k < 5; ++k) s += wv[k] * xin[i + k];
                const hf ov = (hf)silu_f(s);
                outt[(tq * 16 + i) * 128 + ch] = ov;
                if (i < 8) o0[i] = ov; else o1[i - 8] = ov;
            }
            if (gc < 768) { hf* d = UT + (size_t)gc * NT + t0 + tq * 16; *(h8*)d = o0; *(h8*)(d + 8) = o1; }
        }
        __syncthreads();
        for (int e = tid; e < 64 * 16; e += 512) { const int r = e >> 4, ch = e & 15; *(u4*)(U + (size_t)(t0 + r) * 1024 + c0 + ch * 8) = *(const u4*)(outt + r * 128 + ch * 8); }
        if (cb == 0) {
            const float* dr = (const float*)(P.ws + OFF_DTR); float* dp = (float*)(P.ws + OFF_DTP);
            for (int e = tid; e < 1024; e += 512) { const int j = e & 15; const float xv = dr[(size_t)t0 * 16 + e] + P.dt_bias[layer * 16 + j]; dp[(size_t)t0 * 16 + e] = xv > 20.f ? xv : log1pf(expf(xv)); }
        }
    }
#undef PREP_FETCH
    __syncthreads();
}

template <int NROWS>
__device__ __forceinline__ void stage_rows16(const hf* src, size_t ld, char* dst, int tid) {
#pragma unroll
    for (int i = 0; i < NROWS * 16 / 512; ++i) { const int e = tid + i * 512, r = e >> 4, c = e & 15;
        *(u4*)(dst + r * 256 + ((c ^ (r & 15)) << 4)) = *(const u4*)(src + (size_t)r * ld + c * 8); }
}
template <int NROWS>
__device__ __forceinline__ void stage_rows8(const hf* src, size_t ld, char* dst, int tid) {
    typedef unsigned u2 __attribute__((ext_vector_type(2)));
#pragma unroll
    for (int i = 0; i < NROWS * 16 / 512; ++i) { const int e = tid + i * 512, r = e >> 4, c = e & 15;
        const u4 v = *(const u4*)(src + (size_t)r * ld + c * 8);
        u2 lo; lo.x = v.x; lo.y = v.y; u2 hi; hi.x = v.z; hi.y = v.w;
        *(u2*)(dst + r * 256 + (((2 * c) ^ (r & 31)) << 3)) = lo; *(u2*)(dst + r * 256 + (((2 * c + 1) ^ (r & 31)) << 3)) = hi; }
}

__device__ __forceinline__ float wave_incl_scan(float v, int lane) {
#pragma unroll
    for (int d = 1; d < 64; d <<= 1) { const float t = __builtin_bit_cast(float, __builtin_amdgcn_ds_bpermute((lane - d) << 2, __builtin_bit_cast(int, v))); if (lane >= d) v += t; }
    return v;
}

__device__ __forceinline__ void phase_ssd_states(const Params& P, int layer, char* lds) {
    const int tid = opaque_tid(), lane = tid & 63, w = tid >> 6, hh = w & 3, dir = w >> 2, r31 = lane & 31, h = lane >> 5;
    float* wtab = (float*)lds + w * 128;
    char* XT = lds + 16384;
    char* BT = lds + 16384 + 65536;
    const hf* UT = (const hf*)(P.ws + OFF_UT); const float* DTP = (const float*)(P.ws + OFF_DTP);
    hf* CS = (hf*)(P.ws + OFF_CS); float* DEC = (float*)(P.ws + OFF_DEC);
    const int sw16 = r31 & 15;
    u4 pre[8]; float pdt0 = 0.f, pdt1 = 0.f;
#define ST_FETCH(uu) do { const int cid_ = (uu) >> 2, g_ = ((uu) >> 1) & 1, ph_ = (uu) & 1, t0_ = cid_ * 128; \
        _Pragma("unroll") for (int i_ = 0; i_ < 4; ++i_) { const int e_ = tid + i_ * 512, r_ = e_ >> 4, c_ = e_ & 15; \
            pre[i_] = *(const u4*)(UT + (size_t)(g_ * 256 + (r_ >> 5) * 64 + ph_ * 32 + (r_ & 31)) * NT + t0_ + c_ * 8); \
            pre[4 + i_] = *(const u4*)(UT + (size_t)(512 + g_ * 128 + r_) * NT + t0_ + c_ * 8); } \
        pdt0 = DTP[(size_t)(t0_ + 2 * lane) * 16 + dir * 8 + g_ * 4 + hh]; pdt1 = DTP[(size_t)(t0_ + 2 * lane + 1) * 16 + dir * 8 + g_ * 4 + hh]; } while (0)
    if ((int)blockIdx.x < NCHK * 4) ST_FETCH((int)blockIdx.x);
    for (int u = blockIdx.x; u < NCHK * 4; u += gridDim.x) {
        const int cid = u >> 2, g = (u >> 1) & 1, ph = u & 1, t0 = cid * 128, head = g * 4 + hh;
#pragma unroll
        for (int i = 0; i < 4; ++i) { const int e = tid + i * 512, r = e >> 4, c = e & 15;
            *(u4*)(XT + r * 256 + ((c ^ (r & 15)) << 4)) = pre[i]; *(u4*)(BT + r * 256 + ((c ^ (r & 15)) << 4)) = pre[4 + i]; }
        const float a = -expf(P.a_log[layer * 16 + dir * 8 + head]);
        const float dt0 = pdt0, dt1 = pdt1;
        if (u + (int)gridDim.x < NCHK * 4) ST_FETCH(u + (int)gridDim.x);
        const float d0 = dt0 * a, d1 = dt1 * a;
        const float inc1 = wave_incl_scan(d0 + d1, lane), inc0 = inc1 - d1;
        const float total = rdlane(inc1, 63);
        float w0, w1;
        if (dir == 0) { w0 = expf(total - inc0) * dt0; w1 = expf(total - inc1) * dt1; }
        else { w0 = expf(inc0 - d0) * dt0; w1 = expf(inc1 - d1) * dt1; }
        wtab[2 * lane] = w0; wtab[2 * lane + 1] = w1;
        if (lane == 0) DEC[(cid * 2 + dir) * 8 + head] = expf(total);
        __syncthreads();
        fx16 S[4];
#pragma unroll
        for (int b = 0; b < 4; ++b) S[b] = zero16();
#pragma unroll 4
        for (int kk = 0; kk < 8; ++kk) {
            const f4 wa = *(const f4*)(wtab + kk * 16 + 8 * h), wb = *(const f4*)(wtab + kk * 16 + 8 * h + 4);
            h8 w8; w8[0] = (hf)wa[0]; w8[1] = (hf)wa[1]; w8[2] = (hf)wa[2]; w8[3] = (hf)wa[3]; w8[4] = (hf)wb[0]; w8[5] = (hf)wb[1]; w8[6] = (hf)wb[2]; w8[7] = (hf)wb[3];
            const int co = ((2 * kk + h) ^ sw16) << 4;
            h8 bf[4];
            const h8 xf = *(const h8*)(XT + (hh * 32 + r31) * 256 + co) * w8;
#pragma unroll
            for (int nt = 0; nt < 4; ++nt) bf[nt] = *(const h8*)(BT + (nt * 32 + r31) * 256 + co);
#pragma unroll
            for (int nt = 0; nt < 4; ++nt) S[nt] = mfma16(bf[nt], xf, S[nt]);
        }
        hf* cs = CS + (size_t)((cid * 2 + dir) * 8 + head) * 8192 + (size_t)(ph * 32 + r31) * 128 + (h ? 8 : 0);
#pragma unroll
        for (int nt = 0; nt < 4; ++nt)
#pragma unroll
            for (int gp = 0; gp < 2; ++gp) {
                h4 a4, b4;
#pragma unroll
                for (int e = 0; e < 4; ++e) { a4[e] = (hf)S[nt][8 * gp + e]; b4[e] = (hf)S[nt][8 * gp + 4 + e]; }
                const u2 a = __builtin_bit_cast(u2, a4), b = __builtin_bit_cast(u2, b4);
                const auto r0 = __builtin_amdgcn_permlane32_swap(a.x, b.x, false, false);
                const auto r1 = __builtin_amdgcn_permlane32_swap(a.y, b.y, false, false);
                u4 w4; w4.x = r0[0]; w4.y = r1[0]; w4.z = r0[1]; w4.w = r1[1];
                *(u4*)(cs + nt * 32 + gp * 16) = w4;
            }
        __syncthreads();
    }
#undef ST_FETCH
}

__device__ __forceinline__ void phase_ssd_scan(const Params& P) {
    const hf* CS = (const hf*)(P.ws + OFF_CS); hf* HS = (hf*)(P.ws + OFF_HS); const float* DEC = (const float*)(P.ws + OFF_DEC);
    for (int e = blockIdx.x * 512 + opaque_tid(); e < 131072; e += gridDim.x * 512) {
        const int dir = e >> 16, head = (e >> 13) & 7, rest = e & 8191;
        float st = 0.f;
#pragma unroll 1
        for (int b0 = 0; b0 < NCHK; b0 += 26) {
            float cs[26], dc[26];
#pragma unroll
            for (int i = 0; i < 26; ++i) {
                const int step = b0 + i, cid = dir ? 129 - step : (step < 2 ? 128 + step : step - 2);
                cs[i] = (float)CS[(size_t)((cid * 2 + dir) * 8 + head) * 8192 + rest];
                dc[i] = DEC[(cid * 2 + dir) * 8 + head];
            }
#pragma unroll
            for (int i = 0; i < 26; ++i) {
                const int step = b0 + i, cid = dir ? 129 - step : (step < 2 ? 128 + step : step - 2);
                HS[(size_t)((cid * 2 + dir) * 8 + head) * 8192 + rest] = (hf)st;
                st = st * dc[i] + cs[i];
            }
        }
    }
}

struct AttnJob { const hf* Q0; const hf* Q1; const hf* K; const hf* VT; int qrow0; int ta0, na, tb0, nb; int use_sink; float sink0, sink1; int outcol; };

template <bool NOMAX>
__device__ __forceinline__ void attn_unit(const Params& P, const AttnJob& J, char* lds) {
    const int tid = opaque_tid(), lane = tid & 63, w = tid >> 6, r31 = lane & 31, h = lane >> 5, hsel = w >> 2;
    const int qbase = J.qrow0 + (w & 3) * 32;
    const int fsw = (r31 >> 1) & 7;
    const hf* Qp = (hsel ? J.Q1 : J.Q0) + (size_t)(qbase + r31) * 64 + h * 8;
    h8 qf[4];
#pragma unroll
    for (int kk = 0; kk < 4; ++kk) qf[kk] = *(const h8*)(Qp + kk * 16);
    asm volatile("" : "+v"(qf[0]), "+v"(qf[1]), "+v"(qf[2]), "+v"(qf[3]));
    fx16 o[2]; o[0] = zero16(); o[1] = zero16();
    float m = -1e30f, l = 0.f;
    fx16 ol = zero16();
    h8 ones; { const hf ov = (hf)((NOMAX && r31 == 0) ? 1.0f : 0.0f);
#pragma unroll
      for (int e = 0; e < 8; ++e) ones[e] = ov; }
    const int srow = tid >> 3, sc = tid & 7;
    const int kst = srow * 128 + ((sc ^ ((srow >> 1) & 7)) << 4);
    const int npairs = (J.na + J.nb) >> 1;
    u4 kr[2], vr[2];
#define TILE_OF(j) ((j) < J.na ? J.ta0 + (j) : J.tb0 + ((j) - J.na))
#pragma unroll
    for (int e = 0; e < 2; ++e) { const int tile = TILE_OF(e);
        kr[e] = *(const u4*)(J.K + (size_t)(tile * 64 + srow) * 64 + sc * 8); vr[e] = *(const u4*)(J.VT + (size_t)srow * NT + tile * 64 + sc * 8); }
#pragma unroll
    for (int e = 0; e < 2; ++e) { *(u4*)(lds + e * 16384 + kst) = kr[e]; *(u4*)(lds + e * 16384 + 8192 + kst) = vr[e]; }
    __syncthreads();
#pragma unroll 1
    for (int jp = 0; jp < npairs; ++jp) {
        const int cur = jp & 1;
        const bool more = jp + 1 < npairs;
        if (more) {
#pragma unroll
            for (int e = 0; e < 2; ++e) { const int tn = TILE_OF(2 * jp + 2 + e);
                kr[e] = *(const u4*)(J.K + (size_t)(tn * 64 + srow) * 64 + sc * 8); vr[e] = *(const u4*)(J.VT + (size_t)srow * NT + tn * 64 + sc * 8); }
        }
#pragma unroll
        for (int e2 = 0; e2 < 2; ++e2) {
        const int j = 2 * jp + e2;
        const int tile = TILE_OF(j);
        __builtin_amdgcn_sched_barrier(0);
        const char* lk = lds + cur * 32768 + e2 * 16384; const char* lv = lk + 8192;
        h8 kfr[2][4], vfr[4][2];
#pragma unroll
        for (int kk = 0; kk < 4; ++kk) {
            const int co = ((kk * 2 + h) ^ fsw) << 4;
#pragma unroll
            for (int kt = 0; kt < 2; ++kt) kfr[kt][kk] = *(const h8*)(lk + (kt * 32 + r31) * 128 + co);
        }
#pragma unroll
        for (int s4 = 0; s4 < 4; ++s4)
#pragma unroll
            for (int dt = 0; dt < 2; ++dt) {
                vfr[s4][dt] = *(const LAS h8*)((const LAS char*)lv + (dt * 32 + r31) * 128 + (((2 * s4 + h) ^ fsw) << 4));
            }
        __builtin_amdgcn_sched_barrier(0);
        fx16 s[2]; s[0] = zero16(); s[1] = zero16();
#pragma unroll
        for (int kk = 0; kk < 4; ++kk)
#pragma unroll
            for (int kt = 0; kt < 2; ++kt) s[kt] = mfma16(kfr[kt][kk], qf[kk], s[kt]);
        if (!NOMAX && j >= J.na) {
            const int qpos = qbase + r31;
#pragma unroll
            for (int kt = 0; kt < 2; ++kt)
#pragma unroll
                for (int i = 0; i < 16; ++i) { const int kpos = tile * 64 + kt * 32 + (i & 3) + 8 * (i >> 2) + 4 * h; const int dd = qpos - kpos; if (dd > 128 || dd < -128) s[kt][i] = -1e30f; }
        }
        float rs4[4] = {0.f, 0.f, 0.f, 0.f};
        if (NOMAX) {
#pragma unroll
            for (int kt = 0; kt < 2; ++kt)
#pragma unroll
                for (int i = 0; i < 16; ++i) s[kt][i] = __builtin_amdgcn_exp2f(s[kt][i]);
        } else {
            float mx = s[0][0];
#pragma unroll
            for (int kt = 0; kt < 2; ++kt)
#pragma unroll
                for (int i = 0; i < 16; ++i) mx = fmaxf(mx, s[kt][i]);
            mx = fmaxf(mx, shflx(mx, 32, lane));
            const float mn = fmaxf(m, mx);
            const float alpha = __builtin_amdgcn_exp2f(m - mn);
            m = mn;
#pragma unroll
            for (int kt = 0; kt < 2; ++kt)
#pragma unroll
                for (int i = 0; i < 16; ++i) { const float p = __builtin_amdgcn_exp2f(s[kt][i] - mn); s[kt][i] = p; rs4[i & 3] += p; }
            l = l * alpha + ((rs4[0] + rs4[1]) + (rs4[2] + rs4[3]));
            o[0] *= alpha; o[1] *= alpha;
        }
#pragma unroll
        for (int s4 = 0; s4 < 4; ++s4) {
            h8 pf;
#pragma unroll
            for (int e = 0; e < 8; ++e) pf[e] = (hf)s[s4 >> 1][8 * (s4 & 1) + e];
#pragma unroll
            for (int dt = 0; dt < 2; ++dt) o[dt] = mfma16(vfr[s4][dt], pf, o[dt]);
            if (NOMAX) ol = mfma16(ones, pf, ol);
        }
        }
        if (more) { char* lb = lds + (cur ^ 1) * 32768;
#pragma unroll
            for (int e = 0; e < 2; ++e) { *(u4*)(lb + e * 16384 + kst) = kr[e]; *(u4*)(lb + e * 16384 + 8192 + kst) = vr[e]; } }
        __syncthreads();
    }
#undef TILE_OF
    if (NOMAX) l = ol[0];
    l += shflx(l, 32, lane);
    if (!NOMAX && J.use_sink) l += __builtin_amdgcn_exp2f((hsel ? J.sink1 : J.sink0) * LOG2E - m);
    const float inv = 1.0f / l;
    hf* dst = (hf*)(P.ws + OFF_MIX) + (size_t)(qbase + r31) * 1024 + J.outcol + hsel * 64;
#pragma unroll
    for (int dt = 0; dt < 2; ++dt)
#pragma unroll
        for (int rg = 0; rg < 4; ++rg) { h4 ov;
#pragma unroll
            for (int e = 0; e < 4; ++e) ov[e] = (hf)(o[dt][rg * 4 + e] * inv);
            *(h4*)(dst + dt * 32 + rg * 8 + 4 * h) = ov; }
}

__device__ __forceinline__ fx16 neg4_16() { fx16 z; for (int i = 0; i < 16; ++i) z[i] = -4.0f; return z; }
__device__ __forceinline__ void attn_unit_pin(const Params& P, const AttnJob& J, char* lds) {
    const int tid = opaque_tid(), lane = tid & 63, w = tid >> 6, r31 = lane & 31, h = lane >> 5, kg = w >> 2;
    const int qbase = J.qrow0 + (w & 3) * 32;
    const int fsw = (r31 >> 1) & 7;
    h8 qf[2][4];
#pragma unroll
    for (int cb = 0; cb < 2; ++cb) { const hf* Qp = (cb ? J.Q1 : J.Q0) + (size_t)(qbase + r31) * 64 + h * 8;
#pragma unroll
        for (int kk = 0; kk < 4; ++kk) qf[cb][kk] = *(const h8*)(Qp + kk * 16); }
    asm volatile("" : "+v"(qf[0][0]), "+v"(qf[0][1]), "+v"(qf[0][2]), "+v"(qf[0][3]), "+v"(qf[1][0]), "+v"(qf[1][1]), "+v"(qf[1][2]), "+v"(qf[1][3]));
    fx16 o[4]; o[0] = zero16(); o[1] = zero16(); o[2] = zero16(); o[3] = zero16();
    float l0 = 0.f, l1 = 0.f;
    const int srow = tid >> 3, sc = tid & 7;
    const int kst = srow * 128 + ((sc ^ ((srow >> 1) & 7)) << 4);
    const int T = J.na;
    const char* kdp = (const char*)J.K + (size_t)J.ta0 * 8192 + kst;
    const int wb = __builtin_amdgcn_readfirstlane(w) * 1024;
    const char* vdp = (const char*)J.VT + (size_t)J.ta0 * 128 + (size_t)srow * (NT * 2) + ((sc ^ ((srow >> 1) & 7)) << 4);
#define PN_KDMA(t, S) __builtin_amdgcn_global_load_lds((const unsigned*)(kdp + (size_t)(t) * 8192), (LAS unsigned*)(lds + (S) * 16384 + wb), 16, 0, 0)
#define PN_VDMA(t, S) __builtin_amdgcn_global_load_lds((const unsigned*)(vdp + (size_t)(t) * 128), (LAS unsigned*)(lds + (S) * 16384 + 8192 + wb), 16, 0, 0)
    int ko[4], vo[2];
#pragma unroll
    for (int kk = 0; kk < 4; ++kk) ko[kk] = (kg * 32 + r31) * 128 + (((2 * kk + h) ^ fsw) << 4);
#pragma unroll
    for (int ks = 0; ks < 2; ++ks) vo[ks] = 8192 + r31 * 128 + (((2 * (2 * kg + ks) + h) ^ fsw) << 4);
    const LAS char* L3 = (const LAS char*)lds;
#define PN_KRD(j, S) do { kf[j] = *(const LAS h8*)(L3 + ko[j] + (S) * 16384); } while (0)
#define PN_VRD(v, S) do { vfr[v] = *(const LAS h8*)(L3 + vo[(v) >> 1] + (S) * 16384 + ((v) & 1) * 4096); } while (0)
#define PN_SB __builtin_amdgcn_sched_barrier(0)
#define PN_PIN(x) asm volatile("" : "+v"(x))
#define PN_BAR do { asm volatile("s_waitcnt lgkmcnt(0)" ::: "memory"); __builtin_amdgcn_s_barrier(); asm volatile("" ::: "memory"); } while (0)
#define PN_BAR8 do { asm volatile("s_waitcnt vmcnt(2)" ::: "memory"); __builtin_amdgcn_s_barrier(); asm volatile("" ::: "memory"); } while (0)
    PN_KDMA(0, 0); PN_KDMA(1, 1); PN_KDMA(2, 2); PN_VDMA(0, 0); PN_VDMA(1, 1);
    asm volatile("s_waitcnt vmcnt(0)" ::: "memory");
    PN_BAR;
    h8 kf[4], vfr[4]; unsigned pwe[16];
#pragma unroll
    for (int j = 0; j < 4; ++j) PN_KRD(j, 0);
    fx16 a0, a1, b0, b1;
    a0 = neg4_16(); a1 = neg4_16();
#pragma unroll
    for (int kk = 0; kk < 4; ++kk) { a0 = mfma16(kf[kk], qf[0][kk], a0); a1 = mfma16(kf[kk], qf[1][kk], a1); }
    PN_KDMA(3, 3); PN_VDMA(2, 2);
#pragma unroll
    for (int i = 0; i < 16; ++i) { a0[i] = __builtin_amdgcn_exp2f(a0[i]); if (i < 10) a1[i] = __builtin_amdgcn_exp2f(a1[i]); }
#pragma unroll
    for (int j = 0; j < 4; ++j) PN_KRD(j, 1);
    PN_BAR;
#define PN_PF(P0, P1, idx) ((idx) < 16 ? P0[(idx) & 15] : P1[(idx) & 15])
#define PN_PAIR(j) (__builtin_bit_cast(h2, (unsigned)pwe[2 * (j)]) + __builtin_bit_cast(h2, (unsigned)pwe[2 * (j) + 1]))
#define PN_GAPA(i, C0, C1, P0, P1, SP) do { if ((i) < 4) { PN_VRD(i, SP); } PN_SB; \
        if ((i) & 1) C1 = mfma16(kf[(i) >> 1], qf[1][(i) >> 1], C1); else C0 = mfma16(kf[(i) >> 1], qf[0][(i) >> 1], C0); PN_SB; \
        if ((i) < 6) { P1[10 + (i)] = __builtin_amdgcn_exp2f(P1[10 + (i)]); PN_PIN(P1); PN_SB; } \
          \
        h2 ps_; if ((i) > 0) { ps_ = PN_PAIR((i) - 1); PN_SB; } \
        pwe[2 * (i)] = pk2h(PN_PF(P0, P1, 4 * (i)), PN_PF(P0, P1, 4 * (i) + 1)); PN_PIN(pwe[2 * (i)]); PN_SB; \
        if ((i) == 1) hsA = ps_; else if ((i) > 1 && (i) <= 4) hsA = hsA + ps_; else if ((i) == 5) hsB = ps_; else if ((i) > 5) hsB = hsB + ps_; if ((i) > 0) { PN_SB; } \
        pwe[2 * (i) + 1] = pk2h(PN_PF(P0, P1, 4 * (i) + 2), PN_PF(P0, P1, 4 * (i) + 3)); PN_PIN(pwe[2 * (i) + 1]); PN_SB; } while (0)
#define PN_E1(C0, C1, idx) do { if ((idx) < 16) C0[(idx) & 15] = __builtin_amdgcn_exp2f(C0[(idx) & 15]); else C1[(idx) & 15] = __builtin_amdgcn_exp2f(C1[(idx) & 15]); } while (0)
#define PN_EXP4(C0, C1, i) do { if ((i) < 6) { PN_E1(C0, C1, 3 * (i)); PN_E1(C0, C1, 3 * (i) + 1); PN_E1(C0, C1, 3 * (i) + 2); } \
        else { PN_E1(C0, C1, 18 + 4 * ((i) - 6)); PN_E1(C0, C1, 19 + 4 * ((i) - 6)); PN_E1(C0, C1, 20 + 4 * ((i) - 6)); PN_E1(C0, C1, 21 + 4 * ((i) - 6)); } PN_PIN(C0); PN_PIN(C1); } while (0)
#define PN_PWV(s) ({ u4 q_; q_.x = pwe[4 * (s)]; q_.y = pwe[4 * (s) + 1]; q_.z = pwe[4 * (s) + 2]; q_.w = pwe[4 * (s) + 3]; __builtin_bit_cast(h8, q_); })
#define PN_PV(i) o[((i) >> 2) * 2 + ((i) & 1)] = mfma16(vfr[(((i) >> 1) & 1) * 2 + ((i) & 1)], PN_PWV((i) >> 1), o[((i) >> 2) * 2 + ((i) & 1)])
#define PN_GAPB(i, C0, C1) do { PN_PV(i); PN_EXP4(C0, C1, i); PN_SB; } while (0)
#define PN_STEP(C0, C1, P0, P1, t, S) do { PN_SB; \
        h2 hsA, hsB; C0 = neg4_16(); C1 = neg4_16(); \
        PN_GAPA(0, C0, C1, P0, P1, ((S) + 3) & 3); PN_GAPA(1, C0, C1, P0, P1, ((S) + 3) & 3); PN_GAPA(2, C0, C1, P0, P1, ((S) + 3) & 3); PN_GAPA(3, C0, C1, P0, P1, ((S) + 3) & 3); \
        PN_GAPA(4, C0, C1, P0, P1, ((S) + 3) & 3); PN_GAPA(5, C0, C1, P0, P1, ((S) + 3) & 3); PN_GAPA(6, C0, C1, P0, P1, ((S) + 3) & 3); PN_GAPA(7, C0, C1, P0, P1, ((S) + 3) & 3); \
        { const h2 ps7_ = PN_PAIR(7); hsB = hsB + ps7_; PN_SB; } l0 += (float)hsA[0] + (float)hsA[1]; l1 += (float)hsB[0] + (float)hsB[1]; \
        PN_KDMA((t) + 3, ((S) + 3) & 3); PN_VDMA((t) + 2, ((S) + 2) & 3); PN_SB; \
        PN_GAPB(0, C0, C1); PN_GAPB(1, C0, C1); \
        PN_KRD(0, ((S) + 1) & 3); PN_SB; PN_GAPB(2, C0, C1); PN_KRD(1, ((S) + 1) & 3); PN_SB; PN_GAPB(3, C0, C1); \
        PN_KRD(2, ((S) + 1) & 3); PN_SB; PN_GAPB(4, C0, C1); PN_KRD(3, ((S) + 1) & 3); PN_SB; PN_GAPB(5, C0, C1); \
        PN_GAPB(6, C0, C1); PN_GAPB(7, C0, C1); \
        PN_BAR8; } while (0)
    int t = 1;
#pragma unroll 1
    for (; t + 3 < T; t += 4) { PN_STEP(b0, b1, a0, a1, t, 1); PN_STEP(a0, a1, b0, b1, t + 1, 2); PN_STEP(b0, b1, a0, a1, t + 2, 3); PN_STEP(a0, a1, b0, b1, t + 3, 0); }
    PN_STEP(b0, b1, a0, a1, t, 1); PN_STEP(a0, a1, b0, b1, t + 1, 2); PN_STEP(b0, b1, a0, a1, t + 2, 3);
    {
#pragma unroll
        for (int i = 10; i < 16; ++i) b1[i] = __builtin_amdgcn_exp2f(b1[i]);
        float s0 = 0.f, s1 = 0.f;
#pragma unroll
        for (int i = 0; i < 16; ++i) { s0 += b0[i]; s1 += b1[i]; }
        l0 += s0; l1 += s1;
#pragma unroll
        for (int s4 = 0; s4 < 4; ++s4)
#pragma unroll
            for (int e = 0; e < 4; ++e) pwe[4 * s4 + e] = (s4 < 2) ? pk2h(b0[8 * s4 + 2 * e], b0[8 * s4 + 2 * e + 1]) : pk2h(b1[8 * (s4 - 2) + 2 * e], b1[8 * (s4 - 2) + 2 * e + 1]);
#pragma unroll
        for (int v = 0; v < 4; ++v) PN_VRD(v, 3);
        PN_PV(0); PN_PV(1); PN_PV(2); PN_PV(3); PN_PV(4); PN_PV(5); PN_PV(6); PN_PV(7);
    }
    asm volatile("s_waitcnt vmcnt(0)" ::: "memory");
    PN_BAR;
#undef PN_KDMA
#undef PN_VDMA
#undef PN_KRD
#undef PN_VRD
#undef PN_SB
#undef PN_PIN
#undef PN_BAR
#undef PN_BAR8
#undef PN_PF
#undef PN_GAPA
#undef PN_EXP4
#undef PN_E1
#undef PN_GAPB
#undef PN_PV
#undef PN_PAIR
#undef PN_PWV
#undef PN_STEP
    l0 += shflx(l0, 32, lane); l1 += shflx(l1, 32, lane);
    float* mg = (float*)lds;
    float* mgw = mg + (size_t)((w & 3) * 66) * 64 + lane;
    if (kg == 1) {
#pragma unroll
        for (int j = 0; j < 4; ++j)
#pragma unroll
            for (int i = 0; i < 16; ++i) mgw[(j * 16 + i) * 64] = o[j][i];
        mgw[64 * 64] = l0; mgw[65 * 64] = l1;
    }
    __syncthreads();
    if (kg == 0) {
#pragma unroll
        for (int j = 0; j < 4; ++j)
#pragma unroll
            for (int i = 0; i < 16; ++i) o[j][i] += mgw[(j * 16 + i) * 64];
        l0 += mgw[64 * 64]; l1 += mgw[65 * 64];
#pragma unroll
        for (int cb = 0; cb < 2; ++cb) {
            const float inv = 1.0f / (cb ? l1 : l0);
            hf* dst = (hf*)(P.ws + OFF_MIX) + (size_t)(qbase + r31) * 1024 + J.outcol + cb * 64;
#pragma unroll
            for (int dt = 0; dt < 2; ++dt)
#pragma unroll
                for (int rg = 0; rg < 4; ++rg) { h4 ov;
#pragma unroll
                    for (int e = 0; e < 4; ++e) ov[e] = (hf)(o[cb * 2 + dt][rg * 4 + e] * inv);
                    *(h4*)(dst + dt * 32 + rg * 8 + 4 * h) = ov; }
        }
    }
    __syncthreads();
}

__device__ __forceinline__ void ssd_out_unit(const Params& P, int layer, int cid, int g, int lh0, int lh1, char* lds) {
    const int tid = opaque_tid(), lane = tid & 63, w = tid >> 6, hh = w & 3, lt = w >> 2, r31 = lane & 31, h = lane >> 5;
    const int t0 = cid * 128, head = g * 4 + hh;
    float* tab = (float*)lds;
    float* sstab = (float*)(lds + 8192);
    char* Bm = lds + 16384;
    char* XT = lds + 49152;
    const hf* U = (const hf*)(P.ws + OFF_U); const hf* UT = (const hf*)(P.ws + OFF_UT); const hf* HS = (const hf*)(P.ws + OFF_HS);
    const hf* Z = (const hf*)(P.ws + OFF_Z); const float* DTP = (const float*)(P.ws + OFF_DTP);
    const int lq = lt * 32 + r31;
    stage_rows16<128>(U + (size_t)t0 * 1024 + 512 + g * 128, 1024, Bm, tid);
    stage_rows8<256>(UT + (size_t)(g * 256) * NT + t0, NT, XT, tid);
    if (w < 4) {
        const int hd = g * 4 + w;
        float* tbw = tab + w * 512;
#pragma unroll
        for (int dir = 0; dir < 2; ++dir) {
            const float a = -expf(P.a_log[layer * 16 + dir * 8 + hd]);
            const float dt0 = DTP[(size_t)(t0 + 2 * lane) * 16 + dir * 8 + hd], dt1 = DTP[(size_t)(t0 + 2 * lane + 1) * 16 + dir * 8 + hd];
            const float d0 = dt0 * a, d1 = dt1 * a;
            const float inc1 = wave_incl_scan(d0 + d1, lane), inc0 = inc1 - d1;
            const float total = rdlane(inc1, 63);
            const float c0 = (dir == 0 ? inc0 : total - inc0 + d0) * LOG2E, c1 = (dir == 0 ? inc1 : total - inc1 + d1) * LOG2E;
            tbw[dir * 128 + 2 * lane] = c0; tbw[dir * 128 + 2 * lane + 1] = c1;
            tbw[256 + dir * 128 + 2 * lane] = c0 - __builtin_amdgcn_logf(dt0); tbw[256 + dir * 128 + 2 * lane + 1] = c1 - __builtin_amdgcn_logf(dt1);
        }
    }
    __syncthreads();
    int lh = lh0;
#pragma unroll 1
    do {
    const int tid = opaque_tid(), lane = tid & 63, w = tid >> 6, hh = w & 3, lt = w >> 2, r31 = lane & 31, h = lane >> 5;
    const int head = g * 4 + hh, lq = lt * 32 + r31;
    const int lloc = lh * 64 + lq;
    const size_t lrow = (size_t)(t0 + lloc);
    h8 cf[8];
#pragma unroll
    for (int kk = 0; kk < 8; ++kk) cf[kk] = *(const h8*)(U + lrow * 1024 + 768 + g * 128 + kk * 16 + 8 * h);
    h8 hs0[2][8];
    { const hf* hp = HS + (size_t)((cid * 2 + 0) * 8 + head) * 8192 + (size_t)r31 * 128 + 8 * h;
#pragma unroll
      for (int pt = 0; pt < 2; ++pt)
#pragma unroll
          for (int kk = 0; kk < 8; ++kk) hs0[pt][kk] = *(const h8*)(hp + pt * 32 * 128 + kk * 16); }
    const float* tb = tab + hh * 512;
    fx16 Y[2]; Y[0] = zero16(); Y[1] = zero16();
    const float aFl = tb[lloc], aBl = tb[128 + lloc];
    const int sw16 = r31 & 15;
#pragma unroll
    for (int st = 0; st < 4; ++st) {
        h8 bf[8];
#pragma unroll
        for (int kk = 0; kk < 8; ++kk) bf[kk] = *(const h8*)(Bm + (st * 32 + r31) * 256 + (((2 * kk + h) ^ sw16) << 4));
        h8 xf[2][2];
#pragma unroll
        for (int sh = 0; sh < 2; ++sh)
#pragma unroll
            for (int pt = 0; pt < 2; ++pt) {
                const int q0 = 4 * (st * 2 + sh) + h;
                const LAS char* rowp = (const LAS char*)XT + (hh * 64 + pt * 32 + r31) * 256;
                const h4 v0 = *(const volatile LAS h4*)(rowp + ((q0 ^ r31) << 3)), v1 = *(const volatile LAS h4*)(rowp + (((q0 + 2) ^ r31) << 3));
                h8 x; x[0] = v0[0]; x[1] = v0[1]; x[2] = v0[2]; x[3] = v0[3]; x[4] = v1[0]; x[5] = v1[1]; x[6] = v1[2]; x[7] = v1[3];
                xf[sh][pt] = x;
            }
        __builtin_amdgcn_sched_barrier(0);
        fx16 T = zero16();
#pragma unroll
        for (int kk = 0; kk < 8; ++kk) T = mfma16(bf[kk], cf[kk], T);
#pragma unroll
        for (int rg = 0; rg < 4; ++rg) {
            const int s0 = st * 32 + rg * 8 + 4 * h;
            const f4 eFs = *(const f4*)(tb + 256 + s0), eBs = *(const f4*)(tb + 384 + s0);
#pragma unroll
            for (int e = 0; e < 4; ++e) {
                const int s = s0 + e;
                const float xf = s <= lloc ? aFl - eFs[e] : -INFINITY, xb = s >= lloc ? aBl - eBs[e] : -INFINITY;
                T[rg * 4 + e] *= __builtin_amdgcn_exp2f(xf) + __builtin_amdgcn_exp2f(xb);
            }
        }
#pragma unroll
        for (int sh = 0; sh < 2; ++sh) {
            h8 pf;
#pragma unroll
            for (int e = 0; e < 8; ++e) pf[e] = (hf)T[8 * sh + e];
#pragma unroll
            for (int pt = 0; pt < 2; ++pt) Y[pt] = mfma16(xf[sh][pt], pf, Y[pt]);
        }
    }
    h4 xsv[2][4], zzv[2][4];
    {
        h8 hs1[2][8];
        { const hf* hp = HS + (size_t)((cid * 2 + 1) * 8 + head) * 8192 + (size_t)r31 * 128 + 8 * h;
#pragma unroll
          for (int pt = 0; pt < 2; ++pt)
#pragma unroll
              for (int kk = 0; kk < 8; ++kk) hs1[pt][kk] = *(const h8*)(hp + pt * 32 * 128 + kk * 16); }
        __builtin_amdgcn_sched_barrier(0);
        const float exF = __builtin_amdgcn_exp2f(aFl), exB = __builtin_amdgcn_exp2f(aBl);
#pragma unroll
        for (int pt = 0; pt < 2; ++pt) {
            fx16 tmp = zero16();
#pragma unroll
            for (int kk = 0; kk < 8; ++kk) tmp = mfma16(hs0[pt][kk], cf[kk], tmp);
            Y[pt] += tmp * exF;
        }
        __builtin_amdgcn_sched_barrier(0);
#pragma unroll
        for (int pt = 0; pt < 2; ++pt)
#pragma unroll
            for (int rg = 0; rg < 4; ++rg) {
                const int p = pt * 32 + rg * 8 + 4 * h;
                xsv[pt][rg] = *(const h4*)(U + lrow * 1024 + head * 64 + p); zzv[pt][rg] = *(const h4*)(Z + lrow * 512 + head * 64 + p);
            }
        __builtin_amdgcn_sched_barrier(0);
#pragma unroll
        for (int pt = 0; pt < 2; ++pt) {
            fx16 tmp = zero16();
#pragma unroll
            for (int kk = 0; kk < 8; ++kk) tmp = mfma16(hs1[pt][kk], cf[kk], tmp);
            Y[pt] += tmp * exB;
        }
    }
    const float dsk = P.d_skip[layer * 8 + head];
    float ss = 0.f;
#pragma unroll
    for (int pt = 0; pt < 2; ++pt)
#pragma unroll
        for (int rg = 0; rg < 4; ++rg) {
            const h4 xs = xsv[pt][rg], zz = zzv[pt][rg];
#pragma unroll
            for (int e = 0; e < 4; ++e) { const float y = Y[pt][rg * 4 + e] + (float)xs[e] * dsk; const float gv = y * silu_f((float)zz[e]); Y[pt][rg * 4 + e] = gv; ss += gv * gv; }
        }
    ss += shflx(ss, 32, lane);
    if (h == 0) sstab[hh * 64 + lq] = ss;
    __syncthreads();
    {
        const float tot = (sstab[lq] + sstab[64 + lq]) + (sstab[128 + lq] + sstab[192 + lq]);
        const float rstd = 1.0f / sqrtf(tot * (1.0f / 256.0f) + 1e-6f);
        hf* dst = (hf*)(P.ws + OFF_MIX) + lrow * 1024 + 512 + head * 64;
#pragma unroll
        for (int pt = 0; pt < 2; ++pt)
#pragma unroll
            for (int rg = 0; rg < 4; ++rg) {
                const int p = pt * 32 + rg * 8 + 4 * h;
                const f4 gw = *(const f4*)(P.gnorm_w + layer * 512 + head * 64 + p);
                h4 ov;
#pragma unroll
                for (int e = 0; e < 4; ++e) ov[e] = (hf)(Y[pt][rg * 4 + e] * rstd * gw[e]);
                *(h4*)(dst + p) = ov;
            }
    }
    __syncthreads();
    } while (++lh < lh1);
}

#if defined(DBG_NAIVE_ATTN)
__device__ __forceinline__ void naive_attn(const Params& P, int layer, char* lds) {
    const int tid = opaque_tid(), lane = tid & 63, w = tid >> 6;
    const hf* qkv = (const hf*)(P.ws + OFF_QKV);
    float* qs = (float*)lds + w * 64;
    const int nrows = layer == 0 ? NT : NL;
    for (int item = blockIdx.x * 8 + w; item < nrows * 8; item += gridDim.x * 8) {
        const int row = item >> 3, hd8 = item & 7, isB = hd8 >> 2, head = hd8 & 3, kvh = head >> 1, base = isB ? 8 : 0;
        const hf* Q = qkv + (size_t)(base + head) * HT + (size_t)row * 64;
        const hf* K = qkv + (size_t)(base + 4 + kvh) * HT;
        const hf* VT = qkv + (size_t)(base + 6 + kvh) * HT;
        qs[lane] = (float)Q[lane];
        __builtin_amdgcn_s_waitcnt(0);
        float m = -1e30f, l = 0.f, o = 0.f;
        int r0a, r1a, r0b = 0, r1b = 0;
        if (row >= NL) { r0a = NL; r1a = NT; }
        else if (isB) { r0a = 0; r1a = NT; }
        else { r0a = NL; r1a = NT; r0b = row - 128 < 0 ? 0 : row - 128; r1b = row + 129 > NL ? NL : row + 129; }
        for (int rng = 0; rng < 2; ++rng) {
            const int k0 = rng ? r0b : r0a, k1 = rng ? r1b : r1a;
            for (int kb = k0; kb < k1; kb += 64) {
                const int key = kb + lane; const bool ok = key < k1;
                float s = -1e30f;
                if (ok) { s = 0.f; const hf* kp = K + (size_t)key * 64; for (int d = 0; d < 64; ++d) s += qs[d] * (float)kp[d]; }
                float mx = s;
                for (int dd = 32; dd >= 1; dd >>= 1) mx = fmaxf(mx, __shfl_xor(mx, dd));
                const float mn = fmaxf(m, mx), alpha = exp2f(m - mn);
                const float p = ok ? exp2f(s - mn) : 0.f;
                float ps = p;
                for (int dd = 32; dd >= 1; dd >>= 1) ps += __shfl_xor(ps, dd);
                l = l * alpha + ps; o *= alpha; m = mn;
                const int cnt = k1 - kb < 64 ? k1 - kb : 64;
                for (int j = 0; j < cnt; ++j) { const float pj = __shfl(p, j); o += pj * (float)VT[(size_t)lane * NT + kb + j]; }
            }
        }
        if (!isB) l += exp2f(P.sink[layer * 4 + head] * LOG2E - m);
        ((hf*)(P.ws + OFF_MIX))[(size_t)row * 1024 + (isB ? 256 : 0) + head * 64 + lane] = (hf)(o / l);
    }
}
#endif
#if defined(DBG_NAIVE_SSD)
__device__ __forceinline__ void naive_ssd_scan(const Params& P, int layer) {
    const int tid = opaque_tid(), lane = tid & 63, w = tid >> 6;
    const hf* U = (const hf*)(P.ws + OFF_U); const float* DTP = (const float*)(P.ws + OFF_DTP);
    float* Y = (float*)(P.ws + OFF_HS);
    for (int item = blockIdx.x * 8 + w; item < 512; item += gridDim.x * 8) {
        const int head = item >> 6, p = item & 63, g = head >> 2;
        for (int dir = 0; dir < 2; ++dir) {
            const float a = -expf(P.a_log[layer * 16 + dir * 8 + head]);
            float s0 = 0.f, s1 = 0.f;
            for (int step = 0; step < NT; ++step) {
                int t;
                if (dir == 0) t = step < NCX ? NL + step : step - NCX;
                else t = step < NCX ? NT - 1 - step : NL - 1 - (step - NCX);
                const float dt = DTP[(size_t)t * 16 + dir * 8 + head];
                const float x = (float)U[(size_t)t * 1024 + head * 64 + p];
                const float b0 = (float)U[(size_t)t * 1024 + 512 + g * 128 + lane], b1 = (float)U[(size_t)t * 1024 + 512 + g * 128 + 64 + lane];
                const float c0 = (float)U[(size_t)t * 1024 + 768 + g * 128 + lane], c1 = (float)U[(size_t)t * 1024 + 768 + g * 128 + 64 + lane];
                const float dec = expf(a * dt);
                s0 = s0 * dec + dt * b0 * x; s1 = s1 * dec + dt * b1 * x;
                float y = c0 * s0 + c1 * s1;
                for (int dd = 32; dd >= 1; dd >>= 1) y += __shfl_xor(y, dd);
                if (lane == 0) { float* yp = Y + (size_t)t * 512 + head * 64 + p; *yp = dir == 0 ? y : *yp + y; }
            }
        }
    }
}
__device__ __forceinline__ void naive_ssd_finish(const Params& P, int layer) {
    const int tid = opaque_tid(), lane = tid & 63, w = tid >> 6;
    const hf* U = (const hf*)(P.ws + OFF_U); const hf* Z = (const hf*)(P.ws + OFF_Z); const float* Y = (const float*)(P.ws + OFF_HS);
    const int nrows = layer == 0 ? NT : NL;
    for (int item = blockIdx.x * 8 + w; item < nrows * 2; item += gridDim.x * 8) {
        const int t = item >> 1, g = item & 1;
        float gv[4]; float ss = 0.f;
        for (int i = 0; i < 4; ++i) { const int ch = g * 256 + i * 64 + lane; const float y = Y[(size_t)t * 512 + ch] + (float)U[(size_t)t * 1024 + ch] * P.d_skip[layer * 8 + (ch >> 6)];
            const float z = (float)Z[(size_t)t * 512 + ch]; gv[i] = y * (z / (1.0f + expf(-z))); ss += gv[i] * gv[i]; }
        for (int dd = 32; dd >= 1; dd >>= 1) ss += __shfl_xor(ss, dd);
        const float rstd = 1.0f / sqrtf(ss / 256.0f + 1e-6f);
        for (int i = 0; i < 4; ++i) { const int ch = g * 256 + i * 64 + lane; ((hf*)(P.ws + OFF_MIX))[(size_t)t * 1024 + 512 + ch] = (hf)(gv[i] * rstd * P.gnorm_w[layer * 512 + ch]); }
    }
}
#endif
#if defined(DBG_NAIVE_INPROJ)
__device__ __forceinline__ void naive_inproj(const Params& P, int layer) {
    const int tid = opaque_tid(), lane = tid & 63, w = tid >> 6;
    const hf* H = (const hf*)(P.ws + OFF_H16); const hf* W = (const hf*)(P.ws + OFF_WIN) + (size_t)layer * INP * D;
    hf* qkv = (hf*)(P.ws + OFF_QKV);
    for (int item = blockIdx.x * 8 + w; item < NT * 16; item += gridDim.x * 8) {
        const int t = item >> 4, fb = item & 15, sub = fb & 7;
        const hf* hp = H + (size_t)t * D; const hf* wp = W + (size_t)(fb * 64 + lane) * D;
        float acc = 0.f;
        for (int k = 0; k < D; k += 8) { const h8 a = *(const h8*)(hp + k), b = *(const h8*)(wp + k); for (int j = 0; j < 8; ++j) acc += (float)a[j] * (float)b[j]; }
        float v = acc;
        if (sub < 6) {
            if (fb >= 8) { float ss = v * v; for (int dd = 32; dd >= 1; dd >>= 1) ss += __shfl_xor(ss, dd); v = v * (1.0f / sqrtf(ss / 64.0f + 1e-6f)) * (sub < 4 ? P.q_gain : P.k_gain)[layer * 64 + lane]; }
            if (t < NL) {
                const int axis = lane >> 5, half = (lane >> 4) & 1, f = lane & 15;
                const float pos = (float)(axis == 0 ? (t >> 6) : (t & 63));
                const float inv = powf(10000.0f, -(float)f / 16.0f); const float ang = pos * inv;
                const float other = __shfl_xor(v, 16);
                const float cs = cosf(ang), sn = sinf(ang);
                v = half == 0 ? v * cs - other * sn : other * sn + v * cs;
            }
            if (sub < 4) v *= 0.125f * LOG2E;
            qkv[(size_t)fb * HT + (size_t)t * 64 + lane] = (hf)v;
        } else qkv[(size_t)fb * HT + (size_t)lane * NT + t] = (hf)v;
    }
}
#endif


#if defined(DBG_NAIVE_INPROJ2)
__device__ __forceinline__ void naive_inproj2(const Params& P, int layer) {
    const int tid = opaque_tid(), lane = tid & 63, w = tid >> 6;
    const hf* H = (const hf*)(P.ws + OFF_H16); const hf* W = (const hf*)(P.ws + OFF_WIN) + (size_t)layer * INP * D;
    for (int item = blockIdx.x * 8 + w; item < NT * 25; item += gridDim.x * 8) {
        const int t = item / 25, fb = 16 + item % 25;
        const hf* hp = H + (size_t)t * D; const hf* wp = W + (size_t)(fb * 64 + lane) * D;
        float acc = 0.f;
        for (int k = 0; k < D; k += 8) { const h8 a = *(const h8*)(hp + k), b = *(const h8*)(wp + k); for (int j = 0; j < 8; ++j) acc += (float)a[j] * (float)b[j]; }
        if (fb < 24) ((hf*)(P.ws + OFF_Z))[(size_t)t * 512 + (fb - 16) * 64 + lane] = (hf)acc;
        else if (fb < 40) ((hf*)(P.ws + OFF_XBC))[(size_t)t * 1024 + (fb - 24) * 64 + lane] = (hf)acc;
        else if (lane < 16) ((float*)(P.ws + OFF_DTR))[(size_t)t * 16 + lane] = acc;
    }
}
#endif
#if defined(DBG_NAIVE_PREP)
__device__ __forceinline__ void naive_prep(const Params& P, int layer) {
    const hf* XBC = (const hf*)(P.ws + OFF_XBC); hf* U = (hf*)(P.ws + OFF_U); hf* UT = (hf*)(P.ws + OFF_UT);
    for (size_t e = (size_t)blockIdx.x * 512 + opaque_tid(); e < (size_t)NT * 1024; e += (size_t)gridDim.x * 512) {
        const int t = (int)(e >> 10), ch = (int)(e & 1023);
        const int seg0 = t < NL ? 0 : NL, seg1 = t < NL ? NL : NT;
        float s = P.conv_b[layer * 1024 + ch];
        for (int k = 0; k < 5; ++k) { const int tt = t + k - 2; if (tt >= seg0 && tt < seg1) s += P.conv_w[(size_t)layer * 5120 + k * 1024 + ch] * (float)XBC[(size_t)tt * 1024 + ch]; }
        const hf o = (hf)(s / (1.0f + expf(-s)));
        U[e] = o; if (ch < 768) UT[(size_t)ch * NT + t] = o;
    }
    const float* dr = (const float*)(P.ws + OFF_DTR); float* dp = (float*)(P.ws + OFF_DTP);
    for (int e = blockIdx.x * 512 + opaque_tid(); e < NT * 16; e += gridDim.x * 512) { const float xv = dr[e] + P.dt_bias[layer * 16 + (e & 15)]; dp[e] = xv > 20.f ? xv : log1pf(expf(xv)); }
}
#endif
#if defined(DBG_NAIVE_GEMM)
__device__ __forceinline__ void naive_res_gemm(const Params& P, const hf* A, const hf* Wt, int K, int nrows, int layer, int which_g, char* lds) {
    const int tid = opaque_tid(); float* ar = (float*)lds;
    for (int t = blockIdx.x; t < nrows; t += gridDim.x) {
        for (int k = tid; k < K; k += 512) ar[k] = (float)A[(size_t)t * K + k];
        __syncthreads();
        float* xr = xr_row(P, t); const float* g = modv(P, layer, t >= NL ? 1 : 0, which_g);
        for (int n = tid; n < D; n += 512) { const hf* wp = Wt + (size_t)n * K; float acc = 0.f;
            for (int k = 0; k < K; k += 8) { const h8 b = *(const h8*)(wp + k); for (int j = 0; j < 8; ++j) acc += ar[k + j] * (float)b[j]; }
            xr[n] = ALPHA * xr[n] + g[n] * acc; }
        __syncthreads();
    }
}
__device__ __forceinline__ void naive_gu_gemm(const Params& P, int layer, int nrows, char* lds) {
    const int tid = opaque_tid(); float* ar = (float*)lds;
    const hf* A = (const hf*)(P.ws + OFF_H16); hf* G = (hf*)(P.ws + OFF_G16);
    for (int t = blockIdx.x; t < nrows; t += gridDim.x) {
        for (int k = tid; k < D; k += 512) ar[k] = (float)A[(size_t)t * D + k];
        __syncthreads();
        for (int j = tid; j < DFF; j += 512) { float ag = 0.f, au = 0.f;
            for (int k = 0; k < D; ++k) { const float a = ar[k]; ag += a * (float)(hf)P.w_gu[(size_t)layer * D * NGU + (size_t)k * NGU + j]; au += a * (float)(hf)P.w_gu[(size_t)layer * D * NGU + (size_t)k * NGU + DFF + j]; }
            G[(size_t)t * DFF + j] = (hf)((ag / (1.0f + expf(-ag))) * au); }
        __syncthreads();
    }
}
#endif

__device__ __forceinline__ void phase_mix(const Params& P, int layer, char* lds) {
    const hf* qkv = (const hf*)(P.ws + OFF_QKV);
    const int ssd_end = 512 + (layer == 0 ? 264 : 256);
    const int nunits = ssd_end + (layer == 0 ? 8 : 0);
    float gq = 0.f, gk = 0.f;
    for (int i = 0; i < 64; ++i) { gq = fmaxf(gq, fabsf(P.q_gain[layer * 64 + i])); gk = fmaxf(gk, fabsf(P.k_gain[layer * 64 + i])); }
    const bool nomax_ok = 0.125f * LOG2E * 64.0f * gq * gk * 1.01f <= 14.0f;
#if defined(DBG_NAIVE_INPROJ)
    naive_inproj(P, layer); cg::this_grid().sync();
#endif
#if defined(DBG_NAIVE_ATTN)
    naive_attn(P, layer, lds); __syncthreads();
#endif
#if defined(DBG_NAIVE_SSD)
    naive_ssd_scan(P, layer); cg::this_grid().sync(); naive_ssd_finish(P, layer);
#endif
#pragma unroll 1
    for (int u = blockIdx.x; u < nunits; u += gridDim.x) {
#if defined(DBG_NAIVE_SSD)
        if (u >= 512 && u < ssd_end) continue;
#endif
#if defined(DBG_NAIVE_ATTN)
        if (u < 512 || u >= ssd_end) continue;
#endif
        if (u >= 512 && u < ssd_end) { const int i = u - 512;
            int cid = i >> 1, g = i & 1, l0 = 0, l1 = 2;
            if (i >= 256) { const int j = i - 256; cid = 128 + (j >> 2); g = (j >> 1) & 1; l0 = j & 1; l1 = l0 + 1; }
            ssd_out_unit(P, layer, cid, g, l0, l1, lds);
            continue; }
        int base, kvh, qrow0, ta0, na, tb0 = 0, nb = 0, use_sink, outcol;
        if (u < 256) {
            kvh = u & 1; base = 8; qrow0 = (u >> 1) * 128; ta0 = 0; na = 260; use_sink = 0; outcol = 256 + kvh * 128;
        } else if (u < 512) {
            const int i = u - 256, qb = i >> 1; kvh = i & 1; base = 0; qrow0 = qb * 128; ta0 = 256; na = 4;
            const int lo = 2 * qb - 2 < 0 ? 0 : 2 * qb - 2, hi = 2 * qb + 4 > 256 ? 256 : 2 * qb + 4;
            tb0 = lo; nb = hi - lo; use_sink = 1; outcol = kvh * 128;
        } else {
            const int i = u - ssd_end, isB = i >> 2, cq = i & 1; kvh = (i >> 1) & 1; base = isB ? 8 : 0;
            qrow0 = NL + cq * 128; ta0 = 256; na = 4; use_sink = isB ? 0 : 1; outcol = (isB ? 256 : 0) + kvh * 128;
        }
        AttnJob J; J.Q0 = qkv + (size_t)(base + 2 * kvh) * HT; J.Q1 = qkv + (size_t)(base + 1 + 2 * kvh) * HT; J.K = qkv + (size_t)(base + 4 + kvh) * HT; J.VT = qkv + (size_t)(base + 6 + kvh) * HT;
        J.qrow0 = qrow0; J.ta0 = ta0; J.na = na; J.tb0 = tb0; J.nb = nb; J.use_sink = use_sink; J.sink0 = P.sink[layer * 4 + 2 * kvh]; J.sink1 = P.sink[layer * 4 + 2 * kvh + 1]; J.outcol = outcol;
        if (u < 256 && nomax_ok) attn_unit_pin(P, J, lds); else attn_unit<false>(P, J, lds);
#if defined(PROBE_MIX_A)
        if (u >= 256) attn_unit<false>(P, J, lds);
#endif
#if defined(PROBE_MIX_B)
        if (u < 256) attn_unit<true>(P, J, lds);
#endif
    }
}

constexpr int PPL = 8;
constexpr int NPHASES = 3 + PPL * 2;

__device__ __forceinline__ void run_phase(const Params& P, int ph, char* lds) {
    const int layer_ = ph < 3 ? 0 : (ph - 3) / PPL, sub0 = ph < 3 ? 8 + ph : (ph - 3) % PPL;
    const bool pre_out = layer_ == 0 && sub0 == 6, pre_dn = layer_ == 1 && sub0 == 0, up1 = layer_ == 1 && sub0 == 6;
    const int nsteps = pre_out ? 3 : (pre_dn || up1) ? 2 : 1;
#pragma unroll 1
    for (int step = 0; step < nsteps; ++step) {
        const bool ctxout = pre_out && step == 0, ctxdn = pre_dn && step == 0, wlate = (pre_out && step == 2) || (up1 && step == 1);
        const int sub = ctxout ? 5 : ctxdn ? 7 : wlate ? 8 : sub0;
        const int layer = ctxdn ? 0 : layer_;
        const int mt = ctxdn ? 65 : (layer == 0 ? (sub == 7 ? 64 : 65) : 64);
        switch (sub) {
            case 0: { EpiIn e{P, layer}; gemm_phase(( const hf*)(P.ws + OFF_H16), (const hf*)(P.ws + OFF_WIN) + (size_t)layer * INP * D, 65, 11, D, e, lds, layer == 1 ? 4 : 0); } break;
            case 1: phase_prep(P, layer, lds); break;
            case 2: phase_ssd_states(P, layer, lds); break;
            case 3: phase_ssd_scan(P); break;
            case 4: phase_mix(P, layer, lds); break;
            case 5: { EpiResLN e{P, layer, 2, layer == 0 ? nullptr : P.ln2_g + (layer - 1) * D, layer == 0 ? nullptr : P.ln2_b + (layer - 1) * D,
                                 P.ln1_g + layer * D, P.ln1_b + layer * D, layer, 3, 4, 0, layer * 2};
                      gemm_phase((const hf*)(P.ws + OFF_MIX), (const hf*)(P.ws + OFF_WOUT) + (size_t)layer * D * D, ctxout ? 1 : 64, 4, D, e, lds, ctxout ? 1 : 0); } break;
            case 6: { EpiGU e{P}; gemm_phase((const hf*)(P.ws + OFF_H16), (const hf*)(P.ws + OFF_WGU) + (size_t)layer * NGU * D, mt, 22, D, e, lds, layer == 0 ? 2 : 0); } break;
            case 7: { EpiResLN e{P, layer, 5, P.ln1_g + layer * D, P.ln1_b + layer * D,
                                 P.ln2_g + layer * D, P.ln2_b + layer * D, layer == 0 ? 1 : 0, 0, 1, layer == 1 ? 1 : 0, layer * 2 + 1};
                      gemm_phase((const hf*)(P.ws + OFF_G16), (const hf*)(P.ws + OFF_WDN) + (size_t)layer * D * DFF, ctxdn ? 1 : mt, 4, DFF, e, lds, ctxdn ? 3 : 0); } break;
            case 8: phase_p0(P, lds, wlate ? (layer_ == 0 ? 1 : 2) : 0); break;
            case 9: phase_modfin(P); break;
            case 10: phase_rows(P, 0, NT, nullptr, nullptr, 0, 0, 1); break;
        }
    }
}

__global__ void __launch_bounds__(512) fwd_kernel(Params P) {
    extern __shared__ __attribute__((aligned(16))) char lds[];
    P.wv = __builtin_amdgcn_readfirstlane((int)(threadIdx.x >> 6));
    volatile LAS unsigned* st = (volatile LAS unsigned*)(lds + 131072);
    if (threadIdx.x < 4) st[threadIdx.x] = 0u;
    __syncthreads();
    const XcdBarrier xb = xcd_barrier_post((unsigned*)(P.ws + OFF_BAR), st);
#pragma unroll 1
    for (int ph = P.ph_lo; ph < P.ph_hi; ++ph) {
        run_phase(P, ph, lds);
#if defined(PROBE_REPEAT_SUB)
        { const int sub_ = ph >= 3 ? (ph - 3) % PPL : -1 - ph; if ((PROBE_REPEAT_MASK >> (sub_ + 3)) & 1) { xcd_barrier(xb); run_phase(P, ph, lds); } }
#endif
        if (ph + 1 < P.ph_hi) { if (ph == P.ph_lo) cg::this_grid().sync(); else xcd_barrier(xb); }
    }
}

constexpr int LDS_BYTES = 131072 + 256;

extern "C" void kernel_launch(void* const* d_in, const int* in_sizes, int n_in, void* d_out, int out_size, void* d_ws, size_t ws_size, hipStream_t stream) {
    static int grid = 0;
    if (grid == 0) {
        if (n_in != 23 || out_size != NL * D || ws_size < OFF_END) { fprintf(stderr, "kernel_launch: unexpected shapes (n_in %d out %d ws %zu need %zu)\n", n_in, out_size, ws_size, (size_t)OFF_END); grid = -1; return; }
        int dev = 0, cus = 0, per_cu = 0;
        hipGetDevice(&dev); hipDeviceGetAttribute(&cus, hipDeviceAttributeMultiprocessorCount, dev);
        hipFuncSetAttribute((const void*)fwd_kernel, hipFuncAttributeMaxDynamicSharedMemorySize, LDS_BYTES);
        hipOccupancyMaxActiveBlocksPerMultiprocessor(&per_cu, (const void*)fwd_kernel, 512, LDS_BYTES);
        if (per_cu < 1) { fprintf(stderr, "kernel_launch: occupancy query says %d blocks/CU\n", per_cu); }
        (void)hipGetLastError();
        grid = cus > 0 ? cus : 256;
    }
    if (grid < 0) return;
    Params p{};
    const float** pp = (const float**)&p;
    for (int i = 0; i < 23; ++i) pp[i] = (const float*)d_in[i];
    p.out = (float*)d_out; p.ws = (unsigned char*)d_ws;
#if MULTI_LAUNCH
    for (int ph = 0; ph < NPHASES; ++ph) { p.ph_lo = ph; p.ph_hi = ph + 1; hipLaunchKernelGGL(fwd_kernel, dim3(grid), dim3(512), LDS_BYTES, stream, p); }
#else
    p.ph_lo = 0; p.ph_hi = NPHASES;
    if (hipMemsetAsync((char*)d_ws + OFF_BAR, 0, 16384, stream) != hipSuccess) fprintf(stderr, "memset of barrier words failed\n");
    void* args[] = {&p};
    hipError_t e = hipLaunchCooperativeKernel((const void*)fwd_kernel, dim3(grid), dim3(512), args, LDS_BYTES, stream);
    if (e != hipSuccess) fprintf(stderr, "cooperative launch failed: %s (grid %d)\n", hipGetErrorString(e), grid);
#endif
}
```

```cpp
#include <hip/hip_runtime.h>
#include <hip/hip_cooperative_groups.h>
#include <cstdio>
#include <cstdint>
namespace cg = cooperative_groups;

#ifndef MULTI_LAUNCH
#define MULTI_LAUNCH 0
#endif

typedef _Float16 hf;
typedef hf h2 __attribute__((ext_vector_type(2)));
typedef hf h4 __attribute__((ext_vector_type(4)));
typedef hf h8 __attribute__((ext_vector_type(8)));
typedef float f4 __attribute__((ext_vector_type(4)));
typedef float fx16 __attribute__((ext_vector_type(16)));
typedef unsigned u4 __attribute__((ext_vector_type(4)));
typedef unsigned u2 __attribute__((ext_vector_type(2)));

constexpr int NL = 16384, NCX = 256, NT = 16640, D = 1024, INC = 2576, INP = 2816, DFF = 2816, NGU = 5632;
constexpr int NCHK = 130;
constexpr size_t HT = (size_t)NT * 64;
constexpr float LOG2E = 1.4426950408889634f;
constexpr float ALPHA = 1.4142135623730951f;

constexpr size_t OFF_WIN = 0;
constexpr size_t OFF_WOUT = OFF_WIN + (size_t)2 * INP * D * 2;
constexpr size_t OFF_WGU = OFF_WOUT + (size_t)2 * D * D * 2;
constexpr size_t OFF_WDN = OFF_WGU + (size_t)2 * NGU * D * 2;
constexpr size_t OFF_H16 = OFF_WDN + (size_t)2 * D * DFF * 2;
constexpr size_t OFF_SMALL = OFF_H16 + (size_t)NT * D * 2;
constexpr size_t OFF_MODP = OFF_SMALL;
constexpr size_t OFF_MOD = OFF_MODP + (size_t)8 * 2 * 2 * 6144 * 4;
constexpr size_t OFF_ROPE = OFF_MOD + (size_t)2 * 2 * 6144 * 4;
constexpr size_t OFF_XRC = OFF_ROPE + (size_t)256 * 16 * 2 * 4;
constexpr size_t OFF_DTR = OFF_XRC + (size_t)NCX * D * 4;
constexpr size_t OFF_DTP = OFF_DTR + (size_t)NT * 16 * 4;
constexpr size_t OFF_DEC = OFF_DTP + (size_t)NT * 16 * 4;
constexpr size_t OFF_BAR = OFF_DEC + 16384;
constexpr size_t OFF_CNT = OFF_BAR + 13824;
constexpr size_t OFF_STATS = OFF_BAR + 16384;
constexpr size_t OFF_BIG = OFF_SMALL + (size_t)4 * 1024 * 1024 + 262144;
constexpr size_t OFF_QKV = OFF_BIG;
constexpr size_t OFF_Z = OFF_QKV + 16 * HT * 2;
constexpr size_t OFF_XBC = OFF_Z + (size_t)NT * 512 * 2;
constexpr size_t OFF_HS = OFF_XBC;
constexpr size_t OFF_U = OFF_XBC + (size_t)NT * 1024 * 2;
constexpr size_t OFF_UT = OFF_U + (size_t)NT * 1024 * 2;
constexpr size_t OFF_XSL = OFF_UT;
constexpr size_t OFF_CS = OFF_UT + (size_t)768 * NT * 2;
constexpr size_t OFF_MIX = OFF_CS;
constexpr size_t OFF_G16 = OFF_BIG;
constexpr size_t OFF_END = OFF_CS + (size_t)NCHK * 2 * 8 * 64 * 128 * 2;
constexpr int XRB_SPLIT = 12288;
constexpr size_t OFF_XRB_A = ((OFF_G16 + (size_t)NT * DFF * 2 + 4095) / 4096) * 4096;
constexpr size_t OFF_XRB_B = OFF_UT + (size_t)1024 * 1024;
static_assert(OFF_XRB_A + (size_t)XRB_SPLIT * D * 2 <= OFF_UT && (size_t)NT * 32 <= (size_t)1024 * 1024 && OFF_XRB_B + (size_t)(NL - XRB_SPLIT) * D * 2 <= OFF_CS, "XRB overflow");
static_assert(NCHK * 2 * 8 * 4 <= 16384 && 3456 * 4 <= 16384 && OFF_STATS + (size_t)NT * 8 <= OFF_BIG, "small region overflow");
static_assert(OFF_G16 + (size_t)NT * DFF * 2 <= OFF_END, "G16 overflow");
static_assert(OFF_END <= (size_t)256 * 1024 * 1024, "workspace too large");

struct Params {
    const float* x; const float* c; const float* ctx; const float* c_ctx; const float* w_ada; const float* b_ada; const float* w_in;
    const float* sink; const float* q_gain; const float* k_gain; const float* conv_w; const float* conv_b; const float* a_log;
    const float* dt_bias; const float* d_skip; const float* gnorm_w; const float* w_out; const float* ln1_g; const float* ln1_b;
    const float* ln2_g; const float* ln2_b; const float* w_gu; const float* w_down;
    float* out; unsigned char* ws; int ph_lo, ph_hi; int wv;
};

__device__ __forceinline__ float silu_f(float x) { return x * __builtin_amdgcn_rcpf(1.0f + __builtin_amdgcn_exp2f(-x * LOG2E)); }
__device__ __forceinline__ hf* xr16_row(const Params& P, int row, bool in_ws) {
    if (row >= NL) return (hf*)(P.ws + OFF_XRC) + (size_t)(row - NL) * D;
    if (in_ws) return row < XRB_SPLIT ? (hf*)(P.ws + OFF_XRB_A) + (size_t)row * D : (hf*)(P.ws + OFF_XRB_B) + (size_t)(row - XRB_SPLIT) * D;
    return (hf*)P.out + (size_t)row * D;
}
__device__ __forceinline__ float* xr_row(const Params& P, int row) { return row < NL ? P.out + (size_t)row * D : (float*)(P.ws + OFF_XRC) + (size_t)(row - NL) * D; }
__device__ __forceinline__ const float* modv(const Params& P, int layer, int set, int which) { return (const float*)(P.ws + OFF_MOD) + (size_t)((layer * 2 + set) * 6 + which) * 1024; }
__device__ __forceinline__ u4 pair16(h4 a_, h4 b_) {
    const u2 a = __builtin_bit_cast(u2, a_), b = __builtin_bit_cast(u2, b_);
    const auto r0 = __builtin_amdgcn_permlane16_swap(a.x, b.x, false, false);
    const auto r1 = __builtin_amdgcn_permlane16_swap(a.y, b.y, false, false);
    u4 w; w.x = r0[0]; w.y = r1[0]; w.z = r0[1]; w.w = r1[1]; return w;
}
__device__ __forceinline__ int pair_off(int fq) { return (fq & 1) ? 16 + (fq - 1) * 4 : fq * 4; }
__device__ __forceinline__ fx16 mfma16(h8 a, h8 b, fx16 c) { return __builtin_amdgcn_mfma_f32_32x32x16_f16(a, b, c, 0, 0, 0); }
__device__ __forceinline__ int opaque_tid_w(int wv) { int z = 0; asm volatile("" : "+v"(z)); const int lane = __builtin_amdgcn_mbcnt_hi(-1, __builtin_amdgcn_mbcnt_lo(-1, z)); return (wv << 6) | lane; }
#define opaque_tid() opaque_tid_w(P.wv)
__device__ __forceinline__ float shflx(float v, int mask, int lane) { return __builtin_bit_cast(float, __builtin_amdgcn_ds_bpermute((lane ^ mask) << 2, __builtin_bit_cast(int, v))); }
__device__ __forceinline__ float rdlane(float v, int l) { return __builtin_bit_cast(float, __builtin_amdgcn_readlane(__builtin_bit_cast(int, v), l)); }
__device__ __forceinline__ fx16 zero16() { fx16 z; for (int i = 0; i < 16; ++i) z[i] = 0.f; return z; }


#define XB_TMO      128
#define XB_XCNT(j)  (256  + 64 * (j))
#define XB_XSUB(j)  (1280 + 64 * (j))
#define XB_XGEN(j)  (2304 + 64 * (j))
#define XB_TOP      3328
#define XB_TOPGEN   3392
#define XCD_BAR_WORDS 3456
#define XB_SPIN_CAP (1u << 22)
#define LAS __attribute__((address_space(3)))
__device__ __forceinline__ unsigned xb_ld(unsigned* p)              { return __hip_atomic_load(p, __ATOMIC_RELAXED, __HIP_MEMORY_SCOPE_AGENT); }
__device__ __forceinline__ unsigned xb_add(unsigned* p, unsigned v) { return __hip_atomic_fetch_add(p, v, __ATOMIC_RELAXED, __HIP_MEMORY_SCOPE_AGENT); }
__device__ __forceinline__ unsigned xb_xcc_id() { return (unsigned)__builtin_amdgcn_s_getreg((3 << 11) | 20) & 0xFu; }
#define XB_SPIN(cond, bar) do { unsigned _sp = 0; while (cond) { __builtin_amdgcn_s_sleep(1); \
    if ((++_sp & 255u) == 0u) { if (xb_ld(&(bar)[XB_TMO])) break; if (_sp > XB_SPIN_CAP) { atomicAdd(&(bar)[XB_TMO], 1u); break; } } } } while (0)
struct XcdBarrier { unsigned* bar; unsigned x; volatile LAS unsigned* st; };
__device__ __forceinline__ XcdBarrier xcd_barrier_post(unsigned* bar, volatile LAS unsigned* st) {
    XcdBarrier b; b.bar = bar; b.x = xb_xcc_id(); b.st = st;
    if (threadIdx.x == 0) (void)xb_add(&bar[XB_XCNT(b.x)], 1u);
    return b;
}
__device__ __forceinline__ void xcd_barrier_complete(unsigned* bar, unsigned x, unsigned& nloc, unsigned& nx) {
    const unsigned G = gridDim.x * gridDim.y * gridDim.z;
    unsigned sum, cnt, mine, sp = 0u;
    for (;;) {
        sum = 0u; cnt = 0u; mine = 0u;
#pragma unroll
        for (unsigned j = 0; j < 16; ++j) { const unsigned c = xb_ld(&bar[XB_XCNT(j)]); sum += c; cnt += (c > 0u) ? 1u : 0u; mine = (j == x) ? c : mine; }
        if (sum == G) break;
        __builtin_amdgcn_s_sleep(1);
        if ((++sp & 255u) == 0u) { if (xb_ld(&bar[XB_TMO])) break; if (sp > XB_SPIN_CAP) { atomicAdd(&bar[XB_TMO], 1u); break; } }
    }
    nloc = mine > 0u ? mine : 1u; nx = cnt > 0u ? cnt : 1u;
}
__device__ __forceinline__ void xcd_barrier(const XcdBarrier& b) {
    asm volatile("s_waitcnt vmcnt(0)" ::: "memory");
    __syncthreads();
    if (threadIdx.x == 0) {
        unsigned* bar = b.bar;
        __builtin_amdgcn_s_waitcnt(0);
        unsigned nloc = b.st[0], nx = b.st[1];
        if (nloc == 0u) { xcd_barrier_complete(bar, b.x, nloc, nx); b.st[0] = nloc; b.st[1] = nx; }
        const unsigned old = xb_add(&bar[XB_XSUB(b.x)], 1u);
        const unsigned gen = old / nloc;
        if (old + 1u == (gen + 1u) * nloc) {
            __builtin_amdgcn_fence(__ATOMIC_RELEASE, "agent");
            asm volatile("s_waitcnt vmcnt(0)" ::: "memory");
            const unsigned og = xb_add(&bar[XB_TOP], 1u);
            const unsigned tg = og / nx;
            if (og + 1u == (tg + 1u) * nx) xb_add(&bar[XB_TOPGEN], 1u);
            else XB_SPIN(xb_ld(&bar[XB_TOPGEN]) == tg, bar);
            __builtin_amdgcn_fence(__ATOMIC_ACQUIRE, "agent");
            xb_add(&bar[XB_XGEN(b.x)], 1u);
            asm volatile("s_waitcnt vmcnt(0)" ::: "memory");
        } else {
            XB_SPIN(xb_ld(&bar[XB_XGEN(b.x)]) == gen, bar);
            __builtin_amdgcn_fence(__ATOMIC_ACQUIRE, "agent");
            asm volatile("s_waitcnt vmcnt(0)" ::: "memory");
        }
    }
    __syncthreads();
}

__device__ __forceinline__ void phase_p0(const Params& P, char* lds) {
    const int tid = opaque_tid();
    float* tile = (float*)lds;
    for (int u = blockIdx.x; u < 1536 + 192 + 8; u += gridDim.x) {
        if (u < 1536) {
            const float* src; hf* dst; int ld, K, r0, k0, kind;
            if (u < 352) { const int l = u / 176, rem = u % 176; r0 = (rem / 16) * 256; k0 = (rem % 16) * 64; ld = INC; K = D; kind = 0; src = P.w_in + (size_t)l * D * INC; dst = (hf*)(P.ws + OFF_WIN) + (size_t)l * INP * D; }
            else if (u < 480) { const int i = u - 352, l = i / 64, rem = i % 64; r0 = (rem / 16) * 256; k0 = (rem % 16) * 64; ld = D; K = D; kind = 1; src = P.w_out + (size_t)l * D * D; dst = (hf*)(P.ws + OFF_WOUT) + (size_t)l * D * D; }
            else if (u < 1184) { const int i = u - 480, l = i / 352, rem = i % 352; r0 = (rem / 16) * 256; k0 = (rem % 16) * 64; ld = NGU; K = D; kind = 2; src = P.w_gu + (size_t)l * D * NGU; dst = (hf*)(P.ws + OFF_WGU) + (size_t)l * NGU * D; }
            else { const int i = u - 1184, l = i / 176, rem = i % 176; r0 = (rem / 44) * 256; k0 = (rem % 44) * 64; ld = D; K = DFF; kind = 3; src = P.w_down + (size_t)l * DFF * D; dst = (hf*)(P.ws + OFF_WDN) + (size_t)l * D * DFF; }
            const int c4 = (tid & 63) * 4, kq = tid >> 6;
            int scol = r0 + c4; bool valid = true;
            if (kind == 2) scol = c4 < 128 ? (r0 >> 1) + c4 : DFF + (r0 >> 1) + (c4 - 128);
            else if (kind == 0 && scol >= INC) valid = false;
            f4 v[8];
#pragma unroll
            for (int i = 0; i < 8; ++i) v[i] = valid ? *(const f4*)(src + (size_t)(k0 + kq + 8 * i) * ld + scol) : (f4){0.f, 0.f, 0.f, 0.f};
#pragma unroll
            for (int i = 0; i < 8; ++i) { float* tp = tile + (kq + 8 * i) * 257 + c4; tp[0] = v[i][0]; tp[1] = v[i][1]; tp[2] = v[i][2]; tp[3] = v[i][3]; }
            __syncthreads();
            const int kc = tid & 7;
#pragma unroll
            for (int p = 0; p < 4; ++p) {
                const int rr = (tid >> 3) + 64 * p;
                const int c = kind == 2 ? ((rr >> 5) & 1) * 128 + (rr >> 6) * 32 + (rr & 31) : rr;
                h8 o;
#pragma unroll
                for (int j = 0; j < 8; ++j) o[j] = (hf)tile[(kc * 8 + j) * 257 + c];
                *(h8*)(dst + (size_t)(r0 + rr) * K + k0 + kc * 8) = o;
            }
            __syncthreads();
        } else if (u < 1536 + 192) {
            const int i = u - 1536, l = i / 96, rem = i % 96, cc = rem / 8, ks = rem % 8;
            float* sv = (float*)lds;
            if (tid < 256) { const int set = tid >> 7, k = tid & 127; const float v = set ? P.c_ctx[ks * 128 + k] : P.c[ks * 128 + k]; sv[tid] = v / (1.0f + expf(-v)); }
            __syncthreads();
            const int n = cc * 512 + tid;
            const float* w = P.w_ada + (size_t)l * D * 6144 + (size_t)(ks * 128) * 6144 + n;
            float a0 = 0.f, a1 = 0.f;
#pragma unroll 16
            for (int k = 0; k < 128; ++k) { const float wv = w[(size_t)k * 6144]; a0 += sv[k] * wv; a1 += sv[128 + k] * wv; }
            float* mp = (float*)(P.ws + OFF_MODP);
            mp[(size_t)((ks * 2 + l) * 2 + 0) * 6144 + n] = a0;
            mp[(size_t)((ks * 2 + l) * 2 + 1) * 6144 + n] = a1;
            __syncthreads();
        } else {
            const int e = (u - 1728) * 512 + tid, pos = e >> 4, f = e & 15;
            const float inv = exp2f(-(float)f * (13.287712379549449f / 16.0f));
            const float ang = (float)pos * inv;
            float sn, cs; sincosf(ang, &sn, &cs);
            float2* rt = (float2*)(P.ws + OFF_ROPE);
            rt[e] = make_float2(cs, sn);
        }
    }
}

__device__ __forceinline__ void phase_modfin(const Params& P) {
    const float* mp = (const float*)(P.ws + OFF_MODP);
    float* mo = (float*)(P.ws + OFF_MOD);
    for (int e = blockIdx.x * 512 + opaque_tid(); e < 2 * 2 * 6144; e += gridDim.x * 512) {
        const int l = e / 12288, rem = e % 12288, set = rem / 6144, n = rem % 6144;
        float s = P.b_ada[l * 6144 + n];
#pragma unroll
        for (int ks = 0; ks < 8; ++ks) s += mp[(size_t)((ks * 2 + l) * 2 + set) * 6144 + n];
        mo[e] = s;
    }
}

__device__ __forceinline__ void phase_rows(const Params& P, int mode, int nrows, const float* lg, const float* lb, int modlayer, int which_sh, int which_sc) {
    const int tid = opaque_tid(), lane = tid & 63, w = tid >> 6;
    hf* H = (hf*)(P.ws + OFF_H16);
    float2* stats = (float2*)(P.ws + OFF_STATS);
    const int half = nrows >> 1;
    for (int r0 = blockIdx.x * 8 + w; r0 < half; r0 += gridDim.x * 8) {
        f4 v[2][4];
#pragma unroll
        for (int k = 0; k < 2; ++k) {
            const int row = r0 + k * half;
            const float* src = mode == 0 ? (row < NL ? P.x + (size_t)row * D : P.ctx + (size_t)(row - NL) * D) : xr_row(P, row);
#pragma unroll
            for (int i = 0; i < 4; ++i) v[k][i] = *(const f4*)(src + (lane + 64 * i) * 4);
        }
#pragma unroll
        for (int k = 0; k < 2; ++k) {
            const int row = r0 + k * half;
            const int set = row >= NL ? 1 : 0;
            if (mode != 0) {
                float s = 0.f;
#pragma unroll
                for (int i = 0; i < 4; ++i) s += (v[k][i][0] + v[k][i][1]) + (v[k][i][2] + v[k][i][3]);
#pragma unroll
                for (int d = 32; d >= 1; d >>= 1) s += shflx(s, d, lane);
                const float mean = s * (1.0f / 1024.0f);
                float q = 0.f;
#pragma unroll
                for (int i = 0; i < 4; ++i) { const f4 dd = v[k][i] - mean; q += (dd[0] * dd[0] + dd[1] * dd[1]) + (dd[2] * dd[2] + dd[3] * dd[3]); }
#pragma unroll
                for (int d = 32; d >= 1; d >>= 1) q += shflx(q, d, lane);
                const float rstd = 1.0f / sqrtf(q * (1.0f / 1024.0f) + 1e-5f);
                if (lane == 0) stats[row] = make_float2(mean, rstd);
#pragma unroll
                for (int i = 0; i < 4; ++i) { const int col = (lane + 64 * i) * 4; const f4 g = *(const f4*)(lg + col), b = *(const f4*)(lb + col); v[k][i] = (v[k][i] - mean) * rstd * g + b; }
            }
            if (mode == 2) {
                float* dst = xr_row(P, row);
#pragma unroll
                for (int i = 0; i < 4; ++i) *(f4*)(dst + (lane + 64 * i) * 4) = v[k][i];
            } else {
                const float* sh = modv(P, modlayer, set, which_sh); const float* sc = modv(P, modlayer, set, which_sc);
#pragma unroll
                for (int i = 0; i < 4; ++i) { const int col = (lane + 64 * i) * 4; const f4 a = *(const f4*)(sc + col), b = *(const f4*)(sh + col); const f4 y = v[k][i] * (1.0f + a) + b;
                    h4 o; o[0] = (hf)y[0]; o[1] = (hf)y[1]; o[2] = (hf)y[2]; o[3] = (hf)y[3]; *(h4*)(H + (size_t)row * D + col) = o; }
            }
        }
    }
}

__device__ __forceinline__ int lds_byte(int r, int c) { const int st = (r >> 4) * 2 + (c >> 5), rr = r & 15, cc = c & 31, ob = rr * 64 + cc * 2; return st * 1024 + (ob ^ (((ob >> 9) & 1) << 5)); }
__device__ __forceinline__ void stage_rc(int b, int& R, int& C) { const int st = b / 1024, sb = b % 1024, swz = sb ^ (((sb >> 9) & 1) << 5); R = (st >> 1) * 16 + swz / 64; C = (st & 1) * 32 + (swz % 64) / 2; }

template <class Epi>
__device__ __forceinline__ void gemm_phase(const hf* X, const hf* Wt, int Mtiles, int Ntiles, int K, const Epi& epi, char* lds, int mode) {
    constexpr int BK = 64, HALF = 128, HTB = HALF * BK * 2;
    const int tid = opaque_tid_w(epi.P.wv), lane = tid & 63, wid = tid >> 6, wr = wid >> 2, wc = wid & 3, fr = lane & 15, fq = lane >> 4;
#define SA(b, h) (lds + ((b) * 2 + (h)) * HTB)
#define SB(b, h) (lds + (4 + (b) * 2 + (h)) * HTB)
#define STAGE(Pp, BASE, br, kt) do { const hf* _g = (BASE) + (long)(br) * K + (long)(kt) * BK; \
      __builtin_amdgcn_global_load_lds((const unsigned*)((const char*)_g + soff), (LAS unsigned*)((Pp) + wbase), 16, 0, 0); \
      __builtin_amdgcn_global_load_lds((const unsigned*)((const char*)(_g + (long)64 * K) + soff), (LAS unsigned*)((Pp) + wbase + 8192), 16, 0, 0); } while (0)
#define LDA(dst, b, h) _Pragma("unroll") for (int m = 0; m < 4; ++m) _Pragma("unroll") for (int k = 0; k < 2; ++k) \
    dst[m][k] = *reinterpret_cast<const h8*>(SA(b, h) + lds_byte(wr * 64 + m * 16 + fr, k * 32 + fq * 8))
#define LDB(dst, b, h) _Pragma("unroll") for (int n = 0; n < 2; ++n) _Pragma("unroll") for (int k = 0; k < 2; ++k) \
    dst[n][k] = *reinterpret_cast<const h8*>(SB(b, h) + lds_byte(wc * 32 + n * 16 + fr, k * 32 + fq * 8))
#define MMA(ai, bj, At_, Bt_) do { __builtin_amdgcn_s_setprio(1); \
    _Pragma("unroll") for (int m = 0; m < 4; ++m) _Pragma("unroll") for (int n = 0; n < 2; ++n) _Pragma("unroll") for (int k = 0; k < 2; ++k) \
      acc[ai][bj][m][n] = __builtin_amdgcn_mfma_f32_16x16x32_f16(At_[m][k], Bt_[n][k], acc[ai][bj][m][n], 0, 0, 0); \
    __builtin_amdgcn_s_setprio(0); } while (0)
#define WAIT_V(n) asm volatile("s_waitcnt vmcnt(" #n ")" ::: "memory")
#define WAIT_L(n) asm volatile("s_waitcnt lgkmcnt(" #n ")" ::: "memory")
#define BAR __builtin_amdgcn_s_barrier()
#define SCHED __builtin_amdgcn_sched_barrier(0)
    const int nt = K / BK;
    const int wbase = __builtin_amdgcn_readfirstlane(wid) * 1024;
    unsigned soff; { int r0, c0; stage_rc(tid * 16, r0, c0); soff = (unsigned)(r0 * K + c0) * 2u; }
    const int G = gridDim.x, per = (G & 7) == 0 ? G >> 3 : 0, total = Mtiles * Ntiles;
#pragma unroll 1
    for (int it = 0;; ++it) {
        int v = per ? (it * 8 + (blockIdx.x & 7)) * per + (blockIdx.x >> 3) : it * G + blockIdx.x;
        if (mode == 1 || mode == 3) v = (it == 0 && (int)(blockIdx.x & 7) == (mode == 1 ? 5 : 7) && (blockIdx.x >> 3) < 4) ? (int)(blockIdx.x >> 3) : total;
        if (mode == 4 && (blockIdx.x & 7) == 7) {
            const int j = blockIdx.x >> 3;
            if (j < 4 && it >= 1) v = total; else if (j >= 4 && j < 8 && it == 2) v = 480 + (j - 4);
        }
        if (v >= total) break;
        const int grp = v / (4 * Ntiles), rem = v - grp * 4 * Ntiles, rows = Mtiles - 4 * grp < 4 ? Mtiles - 4 * grp : 4;
        int pn = rem / rows, pm = 4 * grp + rem % rows;
        if (mode == 1 || mode == 3) { pn = v; pm = 64; }
        unsigned* ctxready = (unsigned*)(epi.P.ws + OFF_CNT) + (mode >= 3 ? 301 : 300);
        if ((mode == 2 || mode == 4) && pm == 64) {
            if (opaque_tid_w(epi.P.wv) == 0) {
                unsigned spins = 0;
                while (__hip_atomic_load(ctxready, __ATOMIC_RELAXED, __HIP_MEMORY_SCOPE_AGENT) < 4u) { __builtin_amdgcn_s_sleep(2); if (++spins > (1u << 22)) break; }
                __builtin_amdgcn_fence(__ATOMIC_ACQUIRE, "agent");
                asm volatile("s_waitcnt vmcnt(0)" ::: "memory");
            }
            __syncthreads();
        }
        const int brow = pn * 256, bcol = pm * 256;
        f4 acc[2][2][4][2];
#pragma unroll
        for (int a = 0; a < 2; ++a)
#pragma unroll
            for (int b = 0; b < 2; ++b)
#pragma unroll
                for (int m = 0; m < 4; ++m)
#pragma unroll
                    for (int n = 0; n < 2; ++n) acc[a][b][m][n] = (f4){0.f, 0.f, 0.f, 0.f};
        h8 At[4][2], B0[2][2], B1[2][2];
        STAGE(SB(0, 0), X, bcol, 0); STAGE(SA(0, 0), Wt, brow, 0);
        STAGE(SB(0, 1), X, bcol + HALF, 0); STAGE(SA(0, 1), Wt, brow + HALF, 0);
        if (wr == 1) BAR;
        WAIT_V(4); BAR;
        STAGE(SB(1, 0), X, bcol, 1); STAGE(SA(1, 0), Wt, brow, 1); STAGE(SB(1, 1), X, bcol + HALF, 1);
        WAIT_V(6); BAR;
#pragma unroll 1
        for (int t = 0; t < nt - 2; t += 2) {
            LDB(B0, 0, 0); SCHED; LDA(At, 0, 0); STAGE(SA(1, 1), Wt, brow + HALF, t + 1);
            WAIT_L(8); BAR; WAIT_L(0); MMA(0, 0, At, B0); BAR; SCHED;
            LDB(B1, 0, 1); STAGE(SB(0, 0), X, bcol, t + 2);
            BAR; WAIT_L(0); MMA(0, 1, At, B1); BAR;
            LDA(At, 0, 1); STAGE(SA(0, 0), Wt, brow, t + 2);
            BAR; WAIT_L(0); MMA(1, 0, At, B0); BAR; SCHED;
            STAGE(SB(0, 1), X, bcol + HALF, t + 2);
            WAIT_V(6); BAR; MMA(1, 1, At, B1); BAR;
            LDB(B0, 1, 0); SCHED; LDA(At, 1, 0); STAGE(SA(0, 1), Wt, brow + HALF, t + 2);
            WAIT_L(8); BAR; WAIT_L(0); MMA(0, 0, At, B0); BAR; SCHED;
            LDB(B1, 1, 1); STAGE(SB(1, 0), X, bcol, t + 3);
            BAR; WAIT_L(0); MMA(0, 1, At, B1); BAR;
            LDA(At, 1, 1); STAGE(SA(1, 0), Wt, brow, t + 3);
            BAR; WAIT_L(0); MMA(1, 0, At, B0); BAR; SCHED;
            STAGE(SB(1, 1), X, bcol + HALF, t + 3);
            WAIT_V(6); BAR; MMA(1, 1, At, B1); BAR;
        }
        { LDB(B0, 0, 0); LDA(At, 0, 0); STAGE(SA(1, 1), Wt, brow + HALF, nt - 1);
          BAR; WAIT_L(0); MMA(0, 0, At, B0); BAR;
          LDB(B1, 0, 1); BAR; WAIT_L(0); MMA(0, 1, At, B1); BAR;
          LDA(At, 0, 1); WAIT_V(4); BAR; WAIT_L(0); MMA(1, 0, At, B0); MMA(1, 1, At, B1); BAR; }
        { LDB(B0, 1, 0); LDA(At, 1, 0); WAIT_V(2); BAR; WAIT_L(0); MMA(0, 0, At, B0); BAR;
          LDB(B1, 1, 1); WAIT_V(0); BAR; WAIT_L(0); MMA(0, 1, At, B1); BAR;
          LDA(At, 1, 1); BAR; WAIT_L(0); MMA(1, 0, At, B0); MMA(1, 1, At, B1); BAR; }
        if (wr == 0) BAR;
        epi(acc, pm, pn, wr, wc, fr, fq, lds);
        if (mode == 1 || mode == 3) {
            asm volatile("s_waitcnt vmcnt(0)" ::: "memory");
            __syncthreads();
            if (opaque_tid_w(epi.P.wv) == 0) {
                __builtin_amdgcn_fence(__ATOMIC_RELEASE, "agent");
                asm volatile("s_waitcnt vmcnt(0)" ::: "memory");
                __hip_atomic_fetch_add(ctxready, 1u, __ATOMIC_RELAXED, __HIP_MEMORY_SCOPE_AGENT);
            }
        }
    }
#undef SA
#undef SB
#undef STAGE
#undef LDA
#undef LDB
#undef MMA
#undef WAIT_V
#undef WAIT_L
#undef BAR
#undef SCHED
}

__device__ __forceinline__ unsigned pk2h(float lo, float hi) { h2 v; v[0] = (hf)lo; v[1] = (hf)hi; return __builtin_bit_cast(unsigned, v); }
struct EpiIn {
    Params P; int layer;
    __device__ __forceinline__ void operator()(f4 (&acc)[2][2][4][2], int pm, int pn, int, int, int, int, char*) const {
        hf* qkv = (hf*)(P.ws + OFF_QKV);
        const float2* rope = (const float2*)(P.ws + OFF_ROPE);
        const int tq_ = opaque_tid_w(P.wv), lane = tq_ & 63, wr = tq_ >> 8, wc = (tq_ >> 6) & 3, fr = lane & 15, fq = lane >> 4;
#pragma unroll
        for (int ai = 0; ai < 2; ++ai) {
            const int fb = pn * 4 + ai * 2 + wr;
            if (fb > 40) continue;
#pragma unroll
            for (int bj = 0; bj < 2; ++bj)
#pragma unroll
                for (int n = 0; n < 2; ++n) {
                    const int t = pm * 256 + bj * 128 + wc * 32 + n * 16 + fr;
                    f4 v[4];
#pragma unroll
                    for (int m = 0; m < 4; ++m) v[m] = acc[ai][bj][m][n];
                    if (fb < 16) {
                        const int sub = fb & 7;
                        if (sub < 6) {
                            if (fb >= 8) {
                                float ss = 0.f;
#pragma unroll
                                for (int m = 0; m < 4; ++m) ss += (v[m][0] * v[m][0] + v[m][1] * v[m][1]) + (v[m][2] * v[m][2] + v[m][3] * v[m][3]);
                                ss += shflx(ss, 16, lane); ss += shflx(ss, 32, lane);
                                const float rs = 1.0f / sqrtf(ss * (1.0f / 64.0f) + 1e-6f);
                                const float* gn = (sub < 4 ? P.q_gain : P.k_gain) + layer * 64;
#pragma unroll
                                for (int m = 0; m < 4; ++m) { const f4 g = *(const f4*)(gn + m * 16 + fq * 4); v[m] = v[m] * rs * g; }
                            }
                            if (t < NL) {
#pragma unroll
                                for (int ax = 0; ax < 2; ++ax) {
                                    const int pos = ax == 0 ? (t >> 6) : (t & 63);
                                    const f4* rp4 = (const f4*)(rope + pos * 16 + fq * 4);
                                    const f4 c01 = rp4[0], c23 = rp4[1];
#pragma unroll
                                    for (int j = 0; j < 4; ++j) { float2 cs; cs.x = (j < 2 ? c01 : c23)[(j & 1) * 2]; cs.y = (j < 2 ? c01 : c23)[(j & 1) * 2 + 1]; const float u1 = v[2 * ax][j], u2 = v[2 * ax + 1][j];
                                        v[2 * ax][j] = u1 * cs.x - u2 * cs.y; v[2 * ax + 1][j] = u1 * cs.y + u2 * cs.x; }
                                }
                            }
                            const float sc = sub < 4 ? 0.125f * LOG2E : 1.0f;
                            hf* dst = qkv + (size_t)fb * HT + (size_t)t * 64 + pair_off(fq);
#pragma unroll
                            for (int mp = 0; mp < 2; ++mp) { h4 o0, o1;
#pragma unroll
                                for (int e = 0; e < 4; ++e) { o0[e] = (hf)(v[2 * mp][e] * sc); o1[e] = (hf)(v[2 * mp + 1][e] * sc); }
                                *(u4*)(dst + mp * 32) = pair16(o0, o1); }
                        } else {
                            const int tp = (t & ~12) | (((t >> 2) & 1) << 3) | (((t >> 3) & 1) << 2);
                            const int q4 = fr & 3; const bool b0 = q4 & 1, b1 = (q4 & 2) != 0;
                            const int qd = fr >> 2, qpos = ((qd & 1) << 1) | (qd >> 1);
                            __attribute__((address_space(1))) hf* dst = (__attribute__((address_space(1))) hf*)(qkv + (size_t)fb * HT + (t & ~15) + 4 * qpos + (size_t)(4 * fq + q4) * NT);
#pragma unroll
                            for (int m = 0; m < 4; ++m) {
                                const float x0 = v[m][0], x1 = v[m][1], x2 = v[m][2], x3 = v[m][3];
                                const float r01 = __builtin_bit_cast(float, __builtin_amdgcn_update_dpp(0, __builtin_bit_cast(int, b0 ? x0 : x1), 0xB1, 0xf, 0xf, false));
                                const float r23 = __builtin_bit_cast(float, __builtin_amdgcn_update_dpp(0, __builtin_bit_cast(int, b0 ? x2 : x3), 0xB1, 0xf, 0xf, false));
                                const unsigned A0 = b0 ? pk2h(r01, x1) : pk2h(x0, r01), A1 = b0 ? pk2h(r23, x3) : pk2h(x2, r23);
                                const unsigned rB = (unsigned)__builtin_amdgcn_update_dpp(0, (int)(b1 ? A0 : A1), 0x4E, 0xf, 0xf, false);
                                u2 w2; w2.x = b1 ? rB : A0; w2.y = b1 ? A1 : rB;
                                *(__attribute__((address_space(1))) u2*)(dst + (size_t)(m * 16) * NT) = w2;
                            }
                        }
                    } else if (fb < 40) {
                        hf* dst = (fb < 24 ? (hf*)(P.ws + OFF_Z) + (size_t)t * 512 + (fb - 16) * 64 : (hf*)(P.ws + OFF_XBC) + (size_t)t * 1024 + (fb - 24) * 64) + pair_off(fq);
#pragma unroll
                        for (int mp = 0; mp < 2; ++mp) { h4 o0, o1;
#pragma unroll
                            for (int e = 0; e < 4; ++e) { o0[e] = (hf)v[2 * mp][e]; o1[e] = (hf)v[2 * mp + 1][e]; }
                            *(u4*)(dst + mp * 32) = pair16(o0, o1); }
                    } else {
                        *(f4*)((float*)(P.ws + OFF_DTR) + (size_t)t * 16 + fq * 4) = v[0];
                    }
                }
        }
    }
};

struct EpiRes {
    Params P; int layer; int which_g; const float* lng; const float* lnb;
    __device__ __forceinline__ void operator()(f4 (&acc)[2][2][4][2], int pm, int pn, int wr, int wc, int fr, int fq, char*) const {
        const float2* stats = (const float2*)(P.ws + OFF_STATS);
#pragma unroll
        for (int bj = 0; bj < 2; ++bj)
#pragma unroll
            for (int n = 0; n < 2; ++n) {
                const int t = pm * 256 + bj * 128 + wc * 32 + n * 16 + fr;
                float* xr = xr_row(P, t);
                const float* xin = lng ? xr : (t < NL ? P.x + (size_t)t * D : P.ctx + (size_t)(t - NL) * D);
                float2 st = make_float2(0.f, 1.f);
                if (lng) st = stats[t];
                const float* g = modv(P, layer, t >= NL ? 1 : 0, which_g);
#pragma unroll
                for (int ai = 0; ai < 2; ++ai)
#pragma unroll
                    for (int m = 0; m < 4; ++m) {
                        const int f = pn * 256 + ai * 128 + wr * 64 + m * 16 + fq * 4;
                        f4 xv = *(const f4*)(xin + f); const f4 gv = *(const f4*)(g + f);
                        if (lng) { const f4 lg4 = *(const f4*)(lng + f), lb4 = *(const f4*)(lnb + f); xv = (xv - st.x) * st.y * lg4 + lb4; }
                        *(f4*)(xr + f) = ALPHA * xv + gv * acc[ai][bj][m][n];
                    }
            }
    }
};

struct EpiResLN {
    Params P; int layer; int which_g; const float* lng_in; const float* lnb_in;
    const float* lng; const float* lnb; int modlayer, which_sh, which_sc; int final_out; int inst;
    __device__ __forceinline__ void operator()(f4 (&acc)[2][2][4][2], int pm, int pn, int wr, int wc, int fr, int fq, char* lds) const {
        const int tid = opaque_tid(), lane = tid & 63, wid = tid >> 6;
        float2* stats = (float2*)(P.ws + OFF_STATS);
        float2* part = (float2*)lds;
        float2* mr = (float2*)(lds + 4096);
        volatile LAS unsigned* flag = (volatile LAS unsigned*)(lds + 8192);
        unsigned long long* slots = (unsigned long long*)(P.ws + OFF_XSL);
        unsigned* cnt = (unsigned*)(P.ws + OFF_CNT) + inst * 65 + pm;
        const int wr1 = wid >> 2, wc1 = wid & 3, fr1 = lane & 15, fq1 = lane >> 4;
        const float* g = modv(P, layer, pm == 64 ? 1 : 0, which_g);
        float sa[2][2], qa[2][2];
#pragma unroll
        for (int bj = 0; bj < 2; ++bj)
#pragma unroll
            for (int n = 0; n < 2; ++n) { sa[bj][n] = 0.f; qa[bj][n] = 0.f; }
#pragma unroll
        for (int ai = 0; ai < 2; ++ai)
#pragma unroll
            for (int mp = 0; mp < 2; ++mp) {
                const int fp = pn * 256 + ai * 128 + wr1 * 64 + mp * 32;
                f4 gv[2], lg4[2], lb4[2];
#pragma unroll
                for (int mm = 0; mm < 2; ++mm) { const int f = fp + mm * 16 + fq1 * 4; gv[mm] = *(const f4*)(g + f);
                    if (lng_in) { lg4[mm] = *(const f4*)(lng_in + f); lb4[mm] = *(const f4*)(lnb_in + f); } }
#pragma unroll
                for (int bj = 0; bj < 2; ++bj)
#pragma unroll
                    for (int n = 0; n < 2; ++n) {
                        const int t = pm * 256 + bj * 128 + wc1 * 32 + n * 16 + fr1;
                        float2 st = make_float2(0.f, 1.f); if (lng_in) st = stats[t];
                        h4 x16[2];
                        if (lng_in) { const u4 wv = *(const u4*)(xr16_row(P, t, inst == 3) + fp + pair_off(fq1));
                            const auto r0 = __builtin_amdgcn_permlane16_swap(wv.x, wv.z, false, false); const auto r1 = __builtin_amdgcn_permlane16_swap(wv.y, wv.w, false, false);
                            u2 a2; a2.x = r0[0]; a2.y = r1[0]; u2 b2; b2.x = r0[1]; b2.y = r1[1];
                            x16[0] = __builtin_bit_cast(h4, a2); x16[1] = __builtin_bit_cast(h4, b2); }
                        h4 v16[2];
#pragma unroll
                        for (int mm = 0; mm < 2; ++mm) {
                            const int m = 2 * mp + mm;
                            const int f = fp + mm * 16 + fq1 * 4;
                            f4 xv;
                            if (lng_in) { xv[0] = (float)x16[mm][0]; xv[1] = (float)x16[mm][1]; xv[2] = (float)x16[mm][2]; xv[3] = (float)x16[mm][3];
                                xv = (xv - st.x) * st.y * lg4[mm] + lb4[mm]; }
                            else xv = *(const f4*)((t < NL ? P.x + (size_t)t * D : P.ctx + (size_t)(t - NL) * D) + f);
                            const f4 v = ALPHA * xv + gv[mm] * acc[ai][bj][m][n];
                            acc[ai][bj][m][n] = v;
                            v16[mm][0] = (hf)v[0]; v16[mm][1] = (hf)v[1]; v16[mm][2] = (hf)v[2]; v16[mm][3] = (hf)v[3];
                            sa[bj][n] += (v[0] + v[1]) + (v[2] + v[3]); qa[bj][n] += (v[0] * v[0] + v[1] * v[1]) + (v[2] * v[2] + v[3] * v[3]);
                        }
                        if (!final_out) *(u4*)(xr16_row(P, t, inst == 2) + fp + pair_off(fq1)) = pair16(v16[0], v16[1]);
                    }
            }
#pragma unroll
        for (int bj = 0; bj < 2; ++bj)
#pragma unroll
            for (int n = 0; n < 2; ++n) {
                float s = sa[bj][n], q = qa[bj][n];
                s += shflx(s, 16, lane); s += shflx(s, 32, lane); q += shflx(q, 16, lane); q += shflx(q, 32, lane);
                if (fq1 == 0) { const int t2 = opaque_tid();
                    part[(bj * 128 + ((t2 >> 6) & 3) * 32 + n * 16 + (t2 & 15)) * 2 + (t2 >> 8)] = make_float2(s, q); }
            }
        __syncthreads();
        if (tid < 256) { const float2 a = part[tid * 2], b = part[tid * 2 + 1];
            const unsigned long long wv = ((unsigned long long)__float_as_uint(a.y + b.y) << 32) | __float_as_uint(a.x + b.x);
            __hip_atomic_store(slots + (size_t)(pm * 256 + tid) * 4 + pn, wv, __ATOMIC_RELAXED, __HIP_MEMORY_SCOPE_AGENT); }
        asm volatile("s_waitcnt vmcnt(0)" ::: "memory");
        __syncthreads();
        if (wid == 0) {
            if (lane == 0) __hip_atomic_fetch_add(cnt, 1u, __ATOMIC_RELAXED, __HIP_MEMORY_SCOPE_AGENT);
            unsigned spins = 0; bool dead = false;
            while ((unsigned)__builtin_amdgcn_readfirstlane((int)__hip_atomic_load(cnt, __ATOMIC_RELAXED, __HIP_MEMORY_SCOPE_AGENT)) < 4u) {
                __builtin_amdgcn_s_sleep(2);
                if (++spins > (1u << 22)) { dead = true; break; }
            }
            __builtin_amdgcn_fence(__ATOMIC_ACQUIRE, "agent");
            asm volatile("s_waitcnt vmcnt(0)" ::: "memory");
            if (lane == 0) flag[0] = dead ? 1u : 0u;
        }
        __syncthreads();
        if (tid < 256) { const unsigned long long* sl = slots + (size_t)(pm * 256 + tid) * 4; float s = 0.f, q = 0.f;
#pragma unroll
            for (int k = 0; k < 4; ++k) { const unsigned long long wv = __hip_atomic_load(sl + k, __ATOMIC_RELAXED, __HIP_MEMORY_SCOPE_AGENT); s += __uint_as_float((unsigned)wv); q += __uint_as_float((unsigned)(wv >> 32)); }
            const float mean = s * (1.0f / 1024.0f);
            float var = q * (1.0f / 1024.0f) - mean * mean; var = var < 0.f ? 0.f : var;
            float2 o = make_float2(mean, 1.0f / sqrtf(var + 1e-5f));
            if (flag[0]) o = make_float2(__builtin_nanf(""), __builtin_nanf(""));
            mr[tid] = o;
            if (pn == 0) stats[pm * 256 + tid] = o; }
        __syncthreads();
        hf* H = (hf*)(P.ws + OFF_H16);
        const int t4 = opaque_tid(), wr4 = t4 >> 8, wc4 = (t4 >> 6) & 3, fr4 = t4 & 15, fq4 = (t4 >> 4) & 3;
        const float* sh = modv(P, modlayer, pm == 64 ? 1 : 0, which_sh); const float* sc = modv(P, modlayer, pm == 64 ? 1 : 0, which_sc);
#pragma unroll
        for (int ai = 0; ai < 2; ++ai)
#pragma unroll
            for (int mp = 0; mp < 2; ++mp) {
                const int fp = pn * 256 + ai * 128 + wr4 * 64 + mp * 32;
                f4 lg4[2], lb4[2], sc4[2], sh4[2];
#pragma unroll
                for (int mm = 0; mm < 2; ++mm) { const int f = fp + mm * 16 + fq4 * 4; lg4[mm] = *(const f4*)(lng + f); lb4[mm] = *(const f4*)(lnb + f);
                    if (!final_out) { sc4[mm] = *(const f4*)(sc + f); sh4[mm] = *(const f4*)(sh + f); } }
#pragma unroll
                for (int bj = 0; bj < 2; ++bj)
#pragma unroll
                    for (int n = 0; n < 2; ++n) {
                        const int tl = bj * 128 + wc4 * 32 + n * 16 + fr4, t = pm * 256 + tl;
                        const float2 st = mr[tl];
                        h4 o16[2];
#pragma unroll
                        for (int mm = 0; mm < 2; ++mm) {
                            const int m = 2 * mp + mm;
                            const f4 xn = (acc[ai][bj][m][n] - st.x) * st.y * lg4[mm] + lb4[mm];
                            if (final_out) { if (t < NL) *(f4*)(P.out + (size_t)t * D + fp + mm * 16 + fq4 * 4) = xn; }
                            else { const f4 y = xn * (1.0f + sc4[mm]) + sh4[mm];
                                o16[mm][0] = (hf)y[0]; o16[mm][1] = (hf)y[1]; o16[mm][2] = (hf)y[2]; o16[mm][3] = (hf)y[3]; }
                        }
                        if (!final_out) *(u4*)(H + (size_t)t * D + fp + pair_off(fq4)) = pair16(o16[0], o16[1]);
                    }
            }
        __syncthreads();
    }
};

struct EpiGU {
    Params P;
    __device__ __forceinline__ void operator()(f4 (&acc)[2][2][4][2], int pm, int pn, int, int, int, int, char*) const {
        hf* G = (hf*)(P.ws + OFF_G16);
        const int tq_ = opaque_tid_w(P.wv), wr = tq_ >> 8, wc = (tq_ >> 6) & 3, fr = tq_ & 15, fq = (tq_ >> 4) & 3;
        const int offe = pair_off(fq);
#pragma unroll
        for (int bj = 0; bj < 2; ++bj)
#pragma unroll
            for (int n = 0; n < 2; ++n) {
                const int t = pm * 256 + bj * 128 + wc * 32 + n * 16 + fr;
#pragma unroll
                for (int ai = 0; ai < 2; ++ai) {
                    u2 pk[2];
#pragma unroll
                    for (int mm = 0; mm < 2; ++mm) {
                        const f4 gt = acc[ai][bj][mm][n], up = acc[ai][bj][mm + 2][n];
                        h4 o;
#pragma unroll
                        for (int e = 0; e < 4; ++e) o[e] = (hf)(silu_f(gt[e]) * up[e]);
                        pk[mm] = __builtin_bit_cast(u2, o);
                    }
                    const auto r0 = __builtin_amdgcn_permlane16_swap(pk[0].x, pk[1].x, false, false);
                    const auto r1 = __builtin_amdgcn_permlane16_swap(pk[0].y, pk[1].y, false, false);
                    u4 w4; w4.x = r0[0]; w4.y = r1[0]; w4.z = r0[1]; w4.w = r1[1];
                    *(u4*)(G + (size_t)t * DFF + pn * 128 + (ai * 2 + wr) * 32 + offe) = w4;
                }
            }
    }
};

__device__ __forceinline__ void phase_prep(const Params& P, int layer, char* lds) {
    const int tid = opaque_tid();
    hf* raw = (hf*)lds;
    hf* outt = (hf*)(lds + 32768);
    const hf* XBC = (const hf*)(P.ws + OFF_XBC);
    hf* U = (hf*)(P.ws + OFF_U); hf* UT = (hf*)(P.ws + OFF_UT);
    u4 pre[3];
#define PREP_FETCH(uu) do { const int tb_ = (uu) >> 3, cb_ = (uu) & 7, t0_ = tb_ * 64, c0_ = cb_ * 128; const int s0_ = t0_ < NL ? 0 : NL, s1_ = t0_ < NL ? NL : NT; \
    _Pragma("unroll") for (int i_ = 0; i_ < 3; ++i_) { const int e_ = tid + i_ * 512, r_ = e_ >> 4, ch_ = e_ & 15, t_ = t0_ - 2 + r_; u4 v_ = {0u, 0u, 0u, 0u}; \
        if (e_ < 68 * 16 && t_ >= s0_ && t_ < s1_) v_ = *(const u4*)(XBC + (size_t)t_ * 1024 + c0_ + ch_ * 8); pre[i_] = v_; } } while (0)
    if (blockIdx.x < 260 * 8) PREP_FETCH(blockIdx.x);
    float wv[5] = {0.f, 0.f, 0.f, 0.f, 0.f}, bb = 0.f; int cbw = -1;
    for (int u = blockIdx.x; u < 260 * 8; u += gridDim.x) {
        const int tb = u >> 3, cb = u & 7, t0 = tb * 64, c0 = cb * 128;
#pragma unroll
        for (int i = 0; i < 3; ++i) { const int e = tid + i * 512; if (e < 68 * 16) *(u4*)(raw + (e >> 4) * 128 + (e & 15) * 8) = pre[i]; }
        __syncthreads();
        if (u + (int)gridDim.x < 260 * 8) PREP_FETCH(u + gridDim.x);
        {
            const int ch = tid & 127, tq = tid >> 7, gc = c0 + ch;
            if (cb != cbw) {
                cbw = cb;
#pragma unroll
                for (int k = 0; k < 5; ++k) wv[k] = P.conv_w[(size_t)layer * 5 * 1024 + k * 1024 + gc];
                bb = P.conv_b[layer * 1024 + gc];
            }
            float xin[20];
#pragma unroll
            for (int i = 0; i < 20; ++i) xin[i] = (float)raw[(tq * 16 + i) * 128 + ch];
            h8 o0, o1;
#pragma unroll
            for (int i = 0; i < 16; ++i) {
                float s = bb;
#pragma unroll
                for (int k = 0; k < 5; ++k) s += wv[k] * xin[i + k];
                const hf ov = (hf)silu_f(s);
                outt[(tq * 16 + i) * 128 + ch] = ov;
                if (i < 8) o0[i] = ov; else o1[i - 8] = ov;
            }
            if (gc < 768) { hf* d = UT + (size_t)gc * NT + t0 + tq * 16; *(h8*)d = o0; *(h8*)(d + 8) = o1; }
        }
        __syncthreads();
        for (int e = tid; e < 64 * 16; e += 512) { const int r = e >> 4, ch = e & 15; *(u4*)(U + (size_t)(t0 + r) * 1024 + c0 + ch * 8) = *(const u4*)(outt + r * 128 + ch * 8); }
        if (cb == 0) {
            const float* dr = (const float*)(P.ws + OFF_DTR); float* dp = (float*)(P.ws + OFF_DTP);
            for (int e = tid; e < 1024; e += 512) { const int j = e & 15; const float xv = dr[(size_t)t0 * 16 + e] + P.dt_bias[layer * 16 + j]; dp[(size_t)t0 * 16 + e] = xv > 20.f ? xv : log1pf(expf(xv)); }
        }
    }
#undef PREP_FETCH
    __syncthreads();
}

template <int NROWS>
__device__ __forceinline__ void stage_rows16(const hf* src, size_t ld, char* dst, int tid) {
#pragma unroll
    for (int i = 0; i < NROWS * 16 / 512; ++i) { const int e = tid + i * 512, r = e >> 4, c = e & 15;
        *(u4*)(dst + r * 256 + ((c ^ (r & 15)) << 4)) = *(const u4*)(src + (size_t)r * ld + c * 8); }
}
template <int NROWS>
__device__ __forceinline__ void stage_rows8(const hf* src, size_t ld, char* dst, int tid) {
    typedef unsigned u2 __attribute__((ext_vector_type(2)));
#pragma unroll
    for (int i = 0; i < NROWS * 16 / 512; ++i) { const int e = tid + i * 512, r = e >> 4, c = e & 15;
        const u4 v = *(const u4*)(src + (size_t)r * ld + c * 8);
        u2 lo; lo.x = v.x; lo.y = v.y; u2 hi; hi.x = v.z; hi.y = v.w;
        *(u2*)(dst + r * 256 + (((2 * c) ^ (r & 31)) << 3)) = lo; *(u2*)(dst + r * 256 + (((2 * c + 1) ^ (r & 31)) << 3)) = hi; }
}

__device__ __forceinline__ float wave_incl_scan(float v, int lane) {
#pragma unroll
    for (int d = 1; d < 64; d <<= 1) { const float t = __builtin_bit_cast(float, __builtin_amdgcn_ds_bpermute((lane - d) << 2, __builtin_bit_cast(int, v))); if (lane >= d) v += t; }
    return v;
}

__device__ __forceinline__ void phase_ssd_states(const Params& P, int layer, char* lds) {
    const int tid = opaque_tid(), lane = tid & 63, w = tid >> 6, hh = w & 3, dir = w >> 2, r31 = lane & 31, h = lane >> 5;
    float* wtab = (float*)lds + w * 128;
    char* XT = lds + 16384;
    char* BT = lds + 16384 + 65536;
    const hf* UT = (const hf*)(P.ws + OFF_UT); const float* DTP = (const float*)(P.ws + OFF_DTP);
    hf* CS = (hf*)(P.ws + OFF_CS); float* DEC = (float*)(P.ws + OFF_DEC);
    const int sw16 = r31 & 15;
    u4 pre[8]; float pdt0 = 0.f, pdt1 = 0.f;
#define ST_FETCH(uu) do { const int cid_ = (uu) >> 2, g_ = ((uu) >> 1) & 1, ph_ = (uu) & 1, t0_ = cid_ * 128; \
        _Pragma("unroll") for (int i_ = 0; i_ < 4; ++i_) { const int e_ = tid + i_ * 512, r_ = e_ >> 4, c_ = e_ & 15; \
            pre[i_] = *(const u4*)(UT + (size_t)(g_ * 256 + (r_ >> 5) * 64 + ph_ * 32 + (r_ & 31)) * NT + t0_ + c_ * 8); \
            pre[4 + i_] = *(const u4*)(UT + (size_t)(512 + g_ * 128 + r_) * NT + t0_ + c_ * 8); } \
        pdt0 = DTP[(size_t)(t0_ + 2 * lane) * 16 + dir * 8 + g_ * 4 + hh]; pdt1 = DTP[(size_t)(t0_ + 2 * lane + 1) * 16 + dir * 8 + g_ * 4 + hh]; } while (0)
    if ((int)blockIdx.x < NCHK * 4) ST_FETCH((int)blockIdx.x);
    for (int u = blockIdx.x; u < NCHK * 4; u += gridDim.x) {
        const int cid = u >> 2, g = (u >> 1) & 1, ph = u & 1, t0 = cid * 128, head = g * 4 + hh;
#pragma unroll
        for (int i = 0; i < 4; ++i) { const int e = tid + i * 512, r = e >> 4, c = e & 15;
            *(u4*)(XT + r * 256 + ((c ^ (r & 15)) << 4)) = pre[i]; *(u4*)(BT + r * 256 + ((c ^ (r & 15)) << 4)) = pre[4 + i]; }
        const float a = -expf(P.a_log[layer * 16 + dir * 8 + head]);
        const float dt0 = pdt0, dt1 = pdt1;
        if (u + (int)gridDim.x < NCHK * 4) ST_FETCH(u + (int)gridDim.x);
        const float d0 = dt0 * a, d1 = dt1 * a;
        const float inc1 = wave_incl_scan(d0 + d1, lane), inc0 = inc1 - d1;
        const float total = rdlane(inc1, 63);
        float w0, w1;
        if (dir == 0) { w0 = expf(total - inc0) * dt0; w1 = expf(total - inc1) * dt1; }
        else { w0 = expf(inc0 - d0) * dt0; w1 = expf(inc1 - d1) * dt1; }
        wtab[2 * lane] = w0; wtab[2 * lane + 1] = w1;
        if (lane == 0) DEC[(cid * 2 + dir) * 8 + head] = expf(total);
        __syncthreads();
        fx16 S[4];
#pragma unroll
        for (int b = 0; b < 4; ++b) S[b] = zero16();
#pragma unroll 4
        for (int kk = 0; kk < 8; ++kk) {
            const f4 wa = *(const f4*)(wtab + kk * 16 + 8 * h), wb = *(const f4*)(wtab + kk * 16 + 8 * h + 4);
            h8 w8; w8[0] = (hf)wa[0]; w8[1] = (hf)wa[1]; w8[2] = (hf)wa[2]; w8[3] = (hf)wa[3]; w8[4] = (hf)wb[0]; w8[5] = (hf)wb[1]; w8[6] = (hf)wb[2]; w8[7] = (hf)wb[3];
            const int co = ((2 * kk + h) ^ sw16) << 4;
            h8 bf[4];
            const h8 xf = *(const h8*)(XT + (hh * 32 + r31) * 256 + co) * w8;
#pragma unroll
            for (int nt = 0; nt < 4; ++nt) bf[nt] = *(const h8*)(BT + (nt * 32 + r31) * 256 + co);
#pragma unroll
            for (int nt = 0; nt < 4; ++nt) S[nt] = mfma16(bf[nt], xf, S[nt]);
        }
        hf* cs = CS + (size_t)((cid * 2 + dir) * 8 + head) * 8192 + (size_t)(ph * 32 + r31) * 128 + (h ? 8 : 0);
#pragma unroll
        for (int nt = 0; nt < 4; ++nt)
#pragma unroll
            for (int gp = 0; gp < 2; ++gp) {
                h4 a4, b4;
#pragma unroll
                for (int e = 0; e < 4; ++e) { a4[e] = (hf)S[nt][8 * gp + e]; b4[e] = (hf)S[nt][8 * gp + 4 + e]; }
                const u2 a = __builtin_bit_cast(u2, a4), b = __builtin_bit_cast(u2, b4);
                const auto r0 = __builtin_amdgcn_permlane32_swap(a.x, b.x, false, false);
                const auto r1 = __builtin_amdgcn_permlane32_swap(a.y, b.y, false, false);
                u4 w4; w4.x = r0[0]; w4.y = r1[0]; w4.z = r0[1]; w4.w = r1[1];
                *(u4*)(cs + nt * 32 + gp * 16) = w4;
            }
        __syncthreads();
    }
#undef ST_FETCH
}

__device__ __forceinline__ void phase_ssd_scan(const Params& P) {
    const hf* CS = (const hf*)(P.ws + OFF_CS); hf* HS = (hf*)(P.ws + OFF_HS); const float* DEC = (const float*)(P.ws + OFF_DEC);
    for (int e = blockIdx.x * 512 + opaque_tid(); e < 131072; e += gridDim.x * 512) {
        const int dir = e >> 16, head = (e >> 13) & 7, rest = e & 8191;
        float st = 0.f;
#pragma unroll 1
        for (int b0 = 0; b0 < NCHK; b0 += 26) {
            float cs[26], dc[26];
#pragma unroll
            for (int i = 0; i < 26; ++i) {
                const int step = b0 + i, cid = dir ? 129 - step : (step < 2 ? 128 + step : step - 2);
                cs[i] = (float)CS[(size_t)((cid * 2 + dir) * 8 + head) * 8192 + rest];
                dc[i] = DEC[(cid * 2 + dir) * 8 + head];
            }
#pragma unroll
            for (int i = 0; i < 26; ++i) {
                const int step = b0 + i, cid = dir ? 129 - step : (step < 2 ? 128 + step : step - 2);
                HS[(size_t)((cid * 2 + dir) * 8 + head) * 8192 + rest] = (hf)st;
                st = st * dc[i] + cs[i];
            }
        }
    }
}

struct AttnJob { const hf* Q0; const hf* Q1; const hf* K; const hf* VT; int qrow0; int ta0, na, tb0, nb; int use_sink; float sink0, sink1; int outcol; };

template <bool NOMAX>
__device__ __forceinline__ void attn_unit(const Params& P, const AttnJob& J, char* lds) {
    const int tid = opaque_tid(), lane = tid & 63, w = tid >> 6, r31 = lane & 31, h = lane >> 5, hsel = w >> 2;
    const int qbase = J.qrow0 + (w & 3) * 32;
    const int fsw = (r31 >> 1) & 7;
    const hf* Qp = (hsel ? J.Q1 : J.Q0) + (size_t)(qbase + r31) * 64 + h * 8;
    h8 qf[4];
#pragma unroll
    for (int kk = 0; kk < 4; ++kk) qf[kk] = *(const h8*)(Qp + kk * 16);
    asm volatile("" : "+v"(qf[0]), "+v"(qf[1]), "+v"(qf[2]), "+v"(qf[3]));
    fx16 o[2]; o[0] = zero16(); o[1] = zero16();
    float m = -1e30f, l = 0.f;
    fx16 ol = zero16();
    h8 ones; { const hf ov = (hf)((NOMAX && r31 == 0) ? 1.0f : 0.0f);
#pragma unroll
      for (int e = 0; e < 8; ++e) ones[e] = ov; }
    const int srow = tid >> 3, sc = tid & 7;
    const int kst = srow * 128 + ((sc ^ ((srow >> 1) & 7)) << 4);
    const int npairs = (J.na + J.nb) >> 1;
    u4 kr[2], vr[2];
#define TILE_OF(j) ((j) < J.na ? J.ta0 + (j) : J.tb0 + ((j) - J.na))
#pragma unroll
    for (int e = 0; e < 2; ++e) { const int tile = TILE_OF(e);
        kr[e] = *(const u4*)(J.K + (size_t)(tile * 64 + srow) * 64 + sc * 8); vr[e] = *(const u4*)(J.VT + (size_t)srow * NT + tile * 64 + sc * 8); }
#pragma unroll
    for (int e = 0; e < 2; ++e) { *(u4*)(lds + e * 16384 + kst) = kr[e]; *(u4*)(lds + e * 16384 + 8192 + kst) = vr[e]; }
    __syncthreads();
#pragma unroll 1
    for (int jp = 0; jp < npairs; ++jp) {
        const int cur = jp & 1;
        const bool more = jp + 1 < npairs;
        if (more) {
#pragma unroll
            for (int e = 0; e < 2; ++e) { const int tn = TILE_OF(2 * jp + 2 + e);
                kr[e] = *(const u4*)(J.K + (size_t)(tn * 64 + srow) * 64 + sc * 8); vr[e] = *(const u4*)(J.VT + (size_t)srow * NT + tn * 64 + sc * 8); }
        }
#pragma unroll
        for (int e2 = 0; e2 < 2; ++e2) {
        const int j = 2 * jp + e2;
        const int tile = TILE_OF(j);
        __builtin_amdgcn_sched_barrier(0);
        const char* lk = lds + cur * 32768 + e2 * 16384; const char* lv = lk + 8192;
        h8 kfr[2][4], vfr[4][2];
#pragma unroll
        for (int kk = 0; kk < 4; ++kk) {
            const int co = ((kk * 2 + h) ^ fsw) << 4;
#pragma unroll
            for (int kt = 0; kt < 2; ++kt) kfr[kt][kk] = *(const h8*)(lk + (kt * 32 + r31) * 128 + co);
        }
#pragma unroll
        for (int s4 = 0; s4 < 4; ++s4)
#pragma unroll
            for (int dt = 0; dt < 2; ++dt) {
                vfr[s4][dt] = *(const LAS h8*)((const LAS char*)lv + (dt * 32 + r31) * 128 + (((2 * s4 + h) ^ fsw) << 4));
            }
        __builtin_amdgcn_sched_barrier(0);
        fx16 s[2]; s[0] = zero16(); s[1] = zero16();
#pragma unroll
        for (int kk = 0; kk < 4; ++kk)
#pragma unroll
            for (int kt = 0; kt < 2; ++kt) s[kt] = mfma16(kfr[kt][kk], qf[kk], s[kt]);
        if (!NOMAX && j >= J.na) {
            const int qpos = qbase + r31;
#pragma unroll
            for (int kt = 0; kt < 2; ++kt)
#pragma unroll
                for (int i = 0; i < 16; ++i) { const int kpos = tile * 64 + kt * 32 + (i & 3) + 8 * (i >> 2) + 4 * h; const int dd = qpos - kpos; if (dd > 128 || dd < -128) s[kt][i] = -1e30f; }
        }
        float rs4[4] = {0.f, 0.f, 0.f, 0.f};
        if (NOMAX) {
#pragma unroll
            for (int kt = 0; kt < 2; ++kt)
#pragma unroll
                for (int i = 0; i < 16; ++i) s[kt][i] = __builtin_amdgcn_exp2f(s[kt][i]);
        } else {
            float mx = s[0][0];
#pragma unroll
            for (int kt = 0; kt < 2; ++kt)
#pragma unroll
                for (int i = 0; i < 16; ++i) mx = fmaxf(mx, s[kt][i]);
            mx = fmaxf(mx, shflx(mx, 32, lane));
            const float mn = fmaxf(m, mx);
            const float alpha = __builtin_amdgcn_exp2f(m - mn);
            m = mn;
#pragma unroll
            for (int kt = 0; kt < 2; ++kt)
#pragma unroll
                for (int i = 0; i < 16; ++i) { const float p = __builtin_amdgcn_exp2f(s[kt][i] - mn); s[kt][i] = p; rs4[i & 3] += p; }
            l = l * alpha + ((rs4[0] + rs4[1]) + (rs4[2] + rs4[3]));
            o[0] *= alpha; o[1] *= alpha;
        }
#pragma unroll
        for (int s4 = 0; s4 < 4; ++s4) {
            h8 pf;
#pragma unroll
            for (int e = 0; e < 8; ++e) pf[e] = (hf)s[s4 >> 1][8 * (s4 & 1) + e];
#pragma unroll
            for (int dt = 0; dt < 2; ++dt) o[dt] = mfma16(vfr[s4][dt], pf, o[dt]);
            if (NOMAX) ol = mfma16(ones, pf, ol);
        }
        }
        if (more) { char* lb = lds + (cur ^ 1) * 32768;
#pragma unroll
            for (int e = 0; e < 2; ++e) { *(u4*)(lb + e * 16384 + kst) = kr[e]; *(u4*)(lb + e * 16384 + 8192 + kst) = vr[e]; } }
        __syncthreads();
    }
#undef TILE_OF
    if (NOMAX) l = ol[0];
    l += shflx(l, 32, lane);
    if (!NOMAX && J.use_sink) l += __builtin_amdgcn_exp2f((hsel ? J.sink1 : J.sink0) * LOG2E - m);
    const float inv = 1.0f / l;
    hf* dst = (hf*)(P.ws + OFF_MIX) + (size_t)(qbase + r31) * 1024 + J.outcol + hsel * 64;
#pragma unroll
    for (int dt = 0; dt < 2; ++dt)
#pragma unroll
        for (int rg = 0; rg < 4; ++rg) { h4 ov;
#pragma unroll
            for (int e = 0; e < 4; ++e) ov[e] = (hf)(o[dt][rg * 4 + e] * inv);
            *(h4*)(dst + dt * 32 + rg * 8 + 4 * h) = ov; }
}

__device__ __forceinline__ fx16 neg4_16() { fx16 z; for (int i = 0; i < 16; ++i) z[i] = -4.0f; return z; }
__device__ __forceinline__ void attn_unit_pin(const Params& P, const AttnJob& J, char* lds) {
    const int tid = opaque_tid(), lane = tid & 63, w = tid >> 6, r31 = lane & 31, h = lane >> 5, kg = w >> 2;
    const int qbase = J.qrow0 + (w & 3) * 32;
    const int fsw = (r31 >> 1) & 7;
    h8 qf[2][4];
#pragma unroll
    for (int cb = 0; cb < 2; ++cb) { const hf* Qp = (cb ? J.Q1 : J.Q0) + (size_t)(qbase + r31) * 64 + h * 8;
#pragma unroll
        for (int kk = 0; kk < 4; ++kk) qf[cb][kk] = *(const h8*)(Qp + kk * 16); }
    asm volatile("" : "+v"(qf[0][0]), "+v"(qf[0][1]), "+v"(qf[0][2]), "+v"(qf[0][3]), "+v"(qf[1][0]), "+v"(qf[1][1]), "+v"(qf[1][2]), "+v"(qf[1][3]));
    fx16 o[4]; o[0] = zero16(); o[1] = zero16(); o[2] = zero16(); o[3] = zero16();
    float l0 = 0.f, l1 = 0.f;
    const int srow = tid >> 3, sc = tid & 7;
    const int kst = srow * 128 + ((sc ^ ((srow >> 1) & 7)) << 4);
    const int T = J.na;
    const char* kdp = (const char*)J.K + (size_t)J.ta0 * 8192 + kst;
    const int wb = __builtin_amdgcn_readfirstlane(w) * 1024;
    const char* vdp = (const char*)J.VT + (size_t)J.ta0 * 128 + (size_t)srow * (NT * 2) + ((sc ^ ((srow >> 1) & 7)) << 4);
#define PN_KDMA(t, S) __builtin_amdgcn_global_load_lds((const unsigned*)(kdp + (size_t)(t) * 8192), (LAS unsigned*)(lds + (S) * 16384 + wb), 16, 0, 0)
#define PN_VDMA(t, S) __builtin_amdgcn_global_load_lds((const unsigned*)(vdp + (size_t)(t) * 128), (LAS unsigned*)(lds + (S) * 16384 + 8192 + wb), 16, 0, 0)
    int ko[4], vo[2];
#pragma unroll
    for (int kk = 0; kk < 4; ++kk) ko[kk] = (kg * 32 + r31) * 128 + (((2 * kk + h) ^ fsw) << 4);
#pragma unroll
    for (int ks = 0; ks < 2; ++ks) vo[ks] = 8192 + r31 * 128 + (((2 * (2 * kg + ks) + h) ^ fsw) << 4);
    const LAS char* L3 = (const LAS char*)lds;
#define PN_KRD(j, S) do { kf[j] = *(const LAS h8*)(L3 + ko[j] + (S) * 16384); } while (0)
#define PN_VRD(v, S) do { vfr[v] = *(const LAS h8*)(L3 + vo[(v) >> 1] + (S) * 16384 + ((v) & 1) * 4096); } while (0)
#define PN_SB __builtin_amdgcn_sched_barrier(0)
#define PN_PIN(x) asm volatile("" : "+v"(x))
#define PN_BAR do { asm volatile("s_waitcnt lgkmcnt(0)" ::: "memory"); __builtin_amdgcn_s_barrier(); asm volatile("" ::: "memory"); } while (0)
#define PN_BAR8 do { asm volatile("s_waitcnt vmcnt(2)" ::: "memory"); __builtin_amdgcn_s_barrier(); asm volatile("" ::: "memory"); } while (0)
    PN_KDMA(0, 0); PN_KDMA(1, 1); PN_KDMA(2, 2); PN_VDMA(0, 0); PN_VDMA(1, 1);
    asm volatile("s_waitcnt vmcnt(0)" ::: "memory");
    PN_BAR;
    h8 kf[4], vfr[4]; unsigned pwe[16];
#pragma unroll
    for (int j = 0; j < 4; ++j) PN_KRD(j, 0);
    fx16 a0, a1, b0, b1;
    a0 = neg4_16(); a1 = neg4_16();
#pragma unroll
    for (int kk = 0; kk < 4; ++kk) { a0 = mfma16(kf[kk], qf[0][kk], a0); a1 = mfma16(kf[kk], qf[1][kk], a1); }
    PN_KDMA(3, 3); PN_VDMA(2, 2);
#pragma unroll
    for (int i = 0; i < 16; ++i) { a0[i] = __builtin_amdgcn_exp2f(a0[i]); if (i < 10) a1[i] = __builtin_amdgcn_exp2f(a1[i]); }
#pragma unroll
    for (int j = 0; j < 4; ++j) PN_KRD(j, 1);
    PN_BAR;
#define PN_PF(P0, P1, idx) ((idx) < 16 ? P0[(idx) & 15] : P1[(idx) & 15])
#define PN_PAIR(j) (__builtin_bit_cast(h2, (unsigned)pwe[2 * (j)]) + __builtin_bit_cast(h2, (unsigned)pwe[2 * (j) + 1]))
#define PN_GAPA(i, C0, C1, P0, P1, SP) do { if ((i) < 4) { PN_VRD(i, SP); } PN_SB; \
        if ((i) & 1) C1 = mfma16(kf[(i) >> 1], qf[1][(i) >> 1], C1); else C0 = mfma16(kf[(i) >> 1], qf[0][(i) >> 1], C0); PN_SB; \
        if ((i) < 6) { P1[10 + (i)] = __builtin_amdgcn_exp2f(P1[10 + (i)]); PN_PIN(P1); PN_SB; } \
          \
        h2 ps_; if ((i) > 0) { ps_ = PN_PAIR((i) - 1); PN_SB; } \
        pwe[2 * (i)] = pk2h(PN_PF(P0, P1, 4 * (i)), PN_PF(P0, P1, 4 * (i) + 1)); PN_PIN(pwe[2 * (i)]); PN_SB; \
        if ((i) == 1) hsA = ps_; else if ((i) > 1 && (i) <= 4) hsA = hsA + ps_; else if ((i) == 5) hsB = ps_; else if ((i) > 5) hsB = hsB + ps_; if ((i) > 0) { PN_SB; } \
        pwe[2 * (i) + 1] = pk2h(PN_PF(P0, P1, 4 * (i) + 2), PN_PF(P0, P1, 4 * (i) + 3)); PN_PIN(pwe[2 * (i) + 1]); PN_SB; } while (0)
#define PN_E1(C0, C1, idx) do { if ((idx) < 16) C0[(idx) & 15] = __builtin_amdgcn_exp2f(C0[(idx) & 15]); else C1[(idx) & 15] = __builtin_amdgcn_exp2f(C1[(idx) & 15]); } while (0)
#define PN_EXP4(C0, C1, i) do { if ((i) < 6) { PN_E1(C0, C1, 3 * (i)); PN_E1(C0, C1, 3 * (i) + 1); PN_E1(C0, C1, 3 * (i) + 2); } \
        else { PN_E1(C0, C1, 18 + 4 * ((i) - 6)); PN_E1(C0, C1, 19 + 4 * ((i) - 6)); PN_E1(C0, C1, 20 + 4 * ((i) - 6)); PN_E1(C0, C1, 21 + 4 * ((i) - 6)); } PN_PIN(C0); PN_PIN(C1); } while (0)
#define PN_PWV(s) ({ u4 q_; q_.x = pwe[4 * (s)]; q_.y = pwe[4 * (s) + 1]; q_.z = pwe[4 * (s) + 2]; q_.w = pwe[4 * (s) + 3]; __builtin_bit_cast(h8, q_); })
#define PN_PV(i) o[((i) >> 2) * 2 + ((i) & 1)] = mfma16(vfr[(((i) >> 1) & 1) * 2 + ((i) & 1)], PN_PWV((i) >> 1), o[((i) >> 2) * 2 + ((i) & 1)])
#define PN_GAPB(i, C0, C1) do { PN_PV(i); PN_EXP4(C0, C1, i); PN_SB; } while (0)
#define PN_STEP(C0, C1, P0, P1, t, S) do { PN_SB; \
        h2 hsA, hsB; C0 = neg4_16(); C1 = neg4_16(); \
        PN_GAPA(0, C0, C1, P0, P1, ((S) + 3) & 3); PN_GAPA(1, C0, C1, P0, P1, ((S) + 3) & 3); PN_GAPA(2, C0, C1, P0, P1, ((S) + 3) & 3); PN_GAPA(3, C0, C1, P0, P1, ((S) + 3) & 3); \
        PN_GAPA(4, C0, C1, P0, P1, ((S) + 3) & 3); PN_GAPA(5, C0, C1, P0, P1, ((S) + 3) & 3); PN_GAPA(6, C0, C1, P0, P1, ((S) + 3) & 3); PN_GAPA(7, C0, C1, P0, P1, ((S) + 3) & 3); \
        { const h2 ps7_ = PN_PAIR(7); hsB = hsB + ps7_; PN_SB; } l0 += (float)hsA[0] + (float)hsA[1]; l1 += (float)hsB[0] + (float)hsB[1]; \
        PN_KDMA((t) + 3, ((S) + 3) & 3); PN_VDMA((t) + 2, ((S) + 2) & 3); PN_SB; \
        PN_GAPB(0, C0, C1); PN_GAPB(1, C0, C1); \
        PN_KRD(0, ((S) + 1) & 3); PN_SB; PN_GAPB(2, C0, C1); PN_KRD(1, ((S) + 1) & 3); PN_SB; PN_GAPB(3, C0, C1); \
        PN_KRD(2, ((S) + 1) & 3); PN_SB; PN_GAPB(4, C0, C1); PN_KRD(3, ((S) + 1) & 3); PN_SB; PN_GAPB(5, C0, C1); \
        PN_GAPB(6, C0, C1); PN_GAPB(7, C0, C1); \
        PN_BAR8; } while (0)
    int t = 1;
#pragma unroll 1
    for (; t + 3 < T; t += 4) { PN_STEP(b0, b1, a0, a1, t, 1); PN_STEP(a0, a1, b0, b1, t + 1, 2); PN_STEP(b0, b1, a0, a1, t + 2, 3); PN_STEP(a0, a1, b0, b1, t + 3, 0); }
    PN_STEP(b0, b1, a0, a1, t, 1); PN_STEP(a0, a1, b0, b1, t + 1, 2); PN_STEP(b0, b1, a0, a1, t + 2, 3);
    {
#pragma unroll
        for (int i = 10; i < 16; ++i) b1[i] = __builtin_amdgcn_exp2f(b1[i]);
        float s0 = 0.f, s1 = 0.f;
#pragma unroll
        for (int i = 0; i < 16; ++i) { s0 += b0[i]; s1 += b1[i]; }
        l0 += s0; l1 += s1;
#pragma unroll
        for (int s4 = 0; s4 < 4; ++s4)
#pragma unroll
            for (int e = 0; e < 4; ++e) pwe[4 * s4 + e] = (s4 < 2) ? pk2h(b0[8 * s4 + 2 * e], b0[8 * s4 + 2 * e + 1]) : pk2h(b1[8 * (s4 - 2) + 2 * e], b1[8 * (s4 - 2) + 2 * e + 1]);
#pragma unroll
        for (int v = 0; v < 4; ++v) PN_VRD(v, 3);
        PN_PV(0); PN_PV(1); PN_PV(2); PN_PV(3); PN_PV(4); PN_PV(5); PN_PV(6); PN_PV(7);
    }
    asm volatile("s_waitcnt vmcnt(0)" ::: "memory");
    PN_BAR;
#undef PN_KDMA
#undef PN_VDMA
#undef PN_KRD
#undef PN_VRD
#undef PN_SB
#undef PN_PIN
#undef PN_BAR
#undef PN_BAR8
#undef PN_PF
#undef PN_GAPA
#undef PN_EXP4
#undef PN_E1
#undef PN_GAPB
#undef PN_PV
#undef PN_PAIR
#undef PN_PWV
#undef PN_STEP
    l0 += shflx(l0, 32, lane); l1 += shflx(l1, 32, lane);
    float* mg = (float*)lds;
    float* mgw = mg + (size_t)((w & 3) * 66) * 64 + lane;
    if (kg == 1) {
#pragma unroll
        for (int j = 0; j < 4; ++j)
#pragma unroll
            for (int i = 0; i < 16; ++i) mgw[(j * 16 + i) * 64] = o[j][i];
        mgw[64 * 64] = l0; mgw[65 * 64] = l1;
    }
    __syncthreads();
    if (kg == 0) {
#pragma unroll
        for (int j = 0; j < 4; ++j)
#pragma unroll
            for (int i = 0; i < 16; ++i) o[j][i] += mgw[(j * 16 + i) * 64];
        l0 += mgw[64 * 64]; l1 += mgw[65 * 64];
#pragma unroll
        for (int cb = 0; cb < 2; ++cb) {
            const float inv = 1.0f / (cb ? l1 : l0);
            hf* dst = (hf*)(P.ws + OFF_MIX) + (size_t)(qbase + r31) * 1024 + J.outcol + cb * 64;
#pragma unroll
            for (int dt = 0; dt < 2; ++dt)
#pragma unroll
                for (int rg = 0; rg < 4; ++rg) { h4 ov;
#pragma unroll
                    for (int e = 0; e < 4; ++e) ov[e] = (hf)(o[cb * 2 + dt][rg * 4 + e] * inv);
                    *(h4*)(dst + dt * 32 + rg * 8 + 4 * h) = ov; }
        }
    }
    __syncthreads();
}

__device__ __forceinline__ void ssd_out_unit(const Params& P, int layer, int cid, int g, int lh0, int lh1, char* lds) {
    const int tid = opaque_tid(), lane = tid & 63, w = tid >> 6, hh = w & 3, lt = w >> 2, r31 = lane & 31, h = lane >> 5;
    const int t0 = cid * 128, head = g * 4 + hh;
    float* tab = (float*)lds;
    float* sstab = (float*)(lds + 8192);
    char* Bm = lds + 16384;
    char* XT = lds + 49152;
    const hf* U = (const hf*)(P.ws + OFF_U); const hf* UT = (const hf*)(P.ws + OFF_UT); const hf* HS = (const hf*)(P.ws + OFF_HS);
    const hf* Z = (const hf*)(P.ws + OFF_Z); const float* DTP = (const float*)(P.ws + OFF_DTP);
    const int lq = lt * 32 + r31;
    stage_rows16<128>(U + (size_t)t0 * 1024 + 512 + g * 128, 1024, Bm, tid);
    stage_rows8<256>(UT + (size_t)(g * 256) * NT + t0, NT, XT, tid);
    if (w < 4) {
        const int hd = g * 4 + w;
        float* tbw = tab + w * 512;
#pragma unroll
        for (int dir = 0; dir < 2; ++dir) {
            const float a = -expf(P.a_log[layer * 16 + dir * 8 + hd]);
            const float dt0 = DTP[(size_t)(t0 + 2 * lane) * 16 + dir * 8 + hd], dt1 = DTP[(size_t)(t0 + 2 * lane + 1) * 16 + dir * 8 + hd];
            const float d0 = dt0 * a, d1 = dt1 * a;
            const float inc1 = wave_incl_scan(d0 + d1, lane), inc0 = inc1 - d1;
            const float total = rdlane(inc1, 63);
            const float c0 = (dir == 0 ? inc0 : total - inc0 + d0) * LOG2E, c1 = (dir == 0 ? inc1 : total - inc1 + d1) * LOG2E;
            tbw[dir * 128 + 2 * lane] = c0; tbw[dir * 128 + 2 * lane + 1] = c1;
            tbw[256 + dir * 128 + 2 * lane] = c0 - __builtin_amdgcn_logf(dt0); tbw[256 + dir * 128 + 2 * lane + 1] = c1 - __builtin_amdgcn_logf(dt1);
        }
    }
    __syncthreads();
    int lh = lh0;
    h8 cfn[8];
    { const int tid = opaque_tid(), lane = tid & 63, w = tid >> 6;
      const size_t row0 = (size_t)(t0 + lh0 * 64 + (w >> 2) * 32 + (lane & 31));
#pragma unroll
      for (int kk = 0; kk < 8; ++kk) cfn[kk] = *(const h8*)(U + row0 * 1024 + 768 + g * 128 + kk * 16 + 8 * (lane >> 5)); }
#pragma unroll 1
    do {
    const int tid = opaque_tid(), lane = tid & 63, w = tid >> 6, hh = w & 3, lt = w >> 2, r31 = lane & 31, h = lane >> 5;
    const int head = g * 4 + hh, lq = lt * 32 + r31;
    const int lloc = lh * 64 + lq;
    const size_t lrow = (size_t)(t0 + lloc);
    h8 cf[8];
#pragma unroll
    for (int kk = 0; kk < 8; ++kk) cf[kk] = cfn[kk];
    h8 hs0[2][8];
    { const hf* hp = HS + (size_t)((cid * 2 + 0) * 8 + head) * 8192 + (size_t)r31 * 128 + 8 * h;
#pragma unroll
      for (int pt = 0; pt < 2; ++pt)
#pragma unroll
          for (int kk = 0; kk < 8; ++kk) hs0[pt][kk] = *(const h8*)(hp + pt * 32 * 128 + kk * 16); }
    const float* tb = tab + hh * 512;
    fx16 Y[2]; Y[0] = zero16(); Y[1] = zero16();
    const float aFl = tb[lloc], aBl = tb[128 + lloc];
    const int sw16 = r31 & 15;
#pragma unroll
    for (int st = 0; st < 4; ++st) {
        h8 bf[8];
#pragma unroll
        for (int kk = 0; kk < 8; ++kk) bf[kk] = *(const h8*)(Bm + (st * 32 + r31) * 256 + (((2 * kk + h) ^ sw16) << 4));
        h8 xf[2][2];
#pragma unroll
        for (int sh = 0; sh < 2; ++sh)
#pragma unroll
            for (int pt = 0; pt < 2; ++pt) {
                const int q0 = 4 * (st * 2 + sh) + h;
                const LAS char* rowp = (const LAS char*)XT + (hh * 64 + pt * 32 + r31) * 256;
                const h4 v0 = *(const volatile LAS h4*)(rowp + ((q0 ^ r31) << 3)), v1 = *(const volatile LAS h4*)(rowp + (((q0 + 2) ^ r31) << 3));
                h8 x; x[0] = v0[0]; x[1] = v0[1]; x[2] = v0[2]; x[3] = v0[3]; x[4] = v1[0]; x[5] = v1[1]; x[6] = v1[2]; x[7] = v1[3];
                xf[sh][pt] = x;
            }
        __builtin_amdgcn_sched_barrier(0);
        fx16 T = zero16();
#pragma unroll
        for (int kk = 0; kk < 8; ++kk) T = mfma16(bf[kk], cf[kk], T);
#pragma unroll
        for (int rg = 0; rg < 4; ++rg) {
            const int s0 = st * 32 + rg * 8 + 4 * h;
            const f4 eFs = *(const f4*)(tb + 256 + s0), eBs = *(const f4*)(tb + 384 + s0);
#pragma unroll
            for (int e = 0; e < 4; ++e) {
                const int s = s0 + e;
                const float xf = s <= lloc ? aFl - eFs[e] : -INFINITY, xb = s >= lloc ? aBl - eBs[e] : -INFINITY;
                T[rg * 4 + e] *= __builtin_amdgcn_exp2f(xf) + __builtin_amdgcn_exp2f(xb);
            }
        }
#pragma unroll
        for (int sh = 0; sh < 2; ++sh) {
            h8 pf;
#pragma unroll
            for (int e = 0; e < 8; ++e) pf[e] = (hf)T[8 * sh + e];
#pragma unroll
            for (int pt = 0; pt < 2; ++pt) Y[pt] = mfma16(xf[sh][pt], pf, Y[pt]);
        }
    }
    h4 xsv[2][4], zzv[2][4];
    {
        h8 hs1[2][8];
        { const hf* hp = HS + (size_t)((cid * 2 + 1) * 8 + head) * 8192 + (size_t)r31 * 128 + 8 * h;
#pragma unroll
          for (int pt = 0; pt < 2; ++pt)
#pragma unroll
              for (int kk = 0; kk < 8; ++kk) hs1[pt][kk] = *(const h8*)(hp + pt * 32 * 128 + kk * 16); }
        __builtin_amdgcn_sched_barrier(0);
        const float exF = __builtin_amdgcn_exp2f(aFl), exB = __builtin_amdgcn_exp2f(aBl);
#pragma unroll
        for (int pt = 0; pt < 2; ++pt) {
            fx16 tmp = zero16();
#pragma unroll
            for (int kk = 0; kk < 8; ++kk) tmp = mfma16(hs0[pt][kk], cf[kk], tmp);
            Y[pt] += tmp * exF;
        }
        __builtin_amdgcn_sched_barrier(0);
#pragma unroll
        for (int pt = 0; pt < 2; ++pt)
#pragma unroll
            for (int rg = 0; rg < 4; ++rg) {
                const int p = pt * 32 + rg * 8 + 4 * h;
                xsv[pt][rg] = *(const h4*)(U + lrow * 1024 + head * 64 + p); zzv[pt][rg] = *(const h4*)(Z + lrow * 512 + head * 64 + p);
            }
        __builtin_amdgcn_sched_barrier(0);
#pragma unroll
        for (int pt = 0; pt < 2; ++pt) {
            fx16 tmp = zero16();
#pragma unroll
            for (int kk = 0; kk < 8; ++kk) tmp = mfma16(hs1[pt][kk], cf[kk], tmp);
            Y[pt] += tmp * exB;
        }
    }
    if (lh + 1 < lh1) {
#pragma unroll
        for (int kk = 0; kk < 8; ++kk) cfn[kk] = *(const h8*)(U + (lrow + 64) * 1024 + 768 + g * 128 + kk * 16 + 8 * h);
    }
    const float dsk = P.d_skip[layer * 8 + head];
    float ss = 0.f;
#pragma unroll
    for (int pt = 0; pt < 2; ++pt)
#pragma unroll
        for (int rg = 0; rg < 4; ++rg) {
            const h4 xs = xsv[pt][rg], zz = zzv[pt][rg];
#pragma unroll
            for (int e = 0; e < 4; ++e) { const float y = Y[pt][rg * 4 + e] + (float)xs[e] * dsk; const float gv = y * silu_f((float)zz[e]); Y[pt][rg * 4 + e] = gv; ss += gv * gv; }
        }
    ss += shflx(ss, 32, lane);
    if (h == 0) sstab[hh * 64 + lq] = ss;
    __syncthreads();
    {
        const float tot = (sstab[lq] + sstab[64 + lq]) + (sstab[128 + lq] + sstab[192 + lq]);
        const float rstd = 1.0f / sqrtf(tot * (1.0f / 256.0f) + 1e-6f);
        hf* dst = (hf*)(P.ws + OFF_MIX) + lrow * 1024 + 512 + head * 64;
#pragma unroll
        for (int pt = 0; pt < 2; ++pt)
#pragma unroll
            for (int rg = 0; rg < 4; ++rg) {
                const int p = pt * 32 + rg * 8 + 4 * h;
                const f4 gw = *(const f4*)(P.gnorm_w + layer * 512 + head * 64 + p);
                h4 ov;
#pragma unroll
                for (int e = 0; e < 4; ++e) ov[e] = (hf)(Y[pt][rg * 4 + e] * rstd * gw[e]);
                *(h4*)(dst + p) = ov;
            }
    }
    __syncthreads();
    } while (++lh < lh1);
}

#if defined(DBG_NAIVE_ATTN)
__device__ __forceinline__ void naive_attn(const Params& P, int layer, char* lds) {
    const int tid = opaque_tid(), lane = tid & 63, w = tid >> 6;
    const hf* qkv = (const hf*)(P.ws + OFF_QKV);
    float* qs = (float*)lds + w * 64;
    const int nrows = layer == 0 ? NT : NL;
    for (int item = blockIdx.x * 8 + w; item < nrows * 8; item += gridDim.x * 8) {
        const int row = item >> 3, hd8 = item & 7, isB = hd8 >> 2, head = hd8 & 3, kvh = head >> 1, base = isB ? 8 : 0;
        const hf* Q = qkv + (size_t)(base + head) * HT + (size_t)row * 64;
        const hf* K = qkv + (size_t)(base + 4 + kvh) * HT;
        const hf* VT = qkv + (size_t)(base + 6 + kvh) * HT;
        qs[lane] = (float)Q[lane];
        __builtin_amdgcn_s_waitcnt(0);
        float m = -1e30f, l = 0.f, o = 0.f;
        int r0a, r1a, r0b = 0, r1b = 0;
        if (row >= NL) { r0a = NL; r1a = NT; }
        else if (isB) { r0a = 0; r1a = NT; }
        else { r0a = NL; r1a = NT; r0b = row - 128 < 0 ? 0 : row - 128; r1b = row + 129 > NL ? NL : row + 129; }
        for (int rng = 0; rng < 2; ++rng) {
            const int k0 = rng ? r0b : r0a, k1 = rng ? r1b : r1a;
            for (int kb = k0; kb < k1; kb += 64) {
                const int key = kb + lane; const bool ok = key < k1;
                float s = -1e30f;
                if (ok) { s = 0.f; const hf* kp = K + (size_t)key * 64; for (int d = 0; d < 64; ++d) s += qs[d] * (float)kp[d]; }
                float mx = s;
                for (int dd = 32; dd >= 1; dd >>= 1) mx = fmaxf(mx, __shfl_xor(mx, dd));
                const float mn = fmaxf(m, mx), alpha = exp2f(m - mn);
                const float p = ok ? exp2f(s - mn) : 0.f;
                float ps = p;
                for (int dd = 32; dd >= 1; dd >>= 1) ps += __shfl_xor(ps, dd);
                l = l * alpha + ps; o *= alpha; m = mn;
                const int cnt = k1 - kb < 64 ? k1 - kb : 64;
                for (int j = 0; j < cnt; ++j) { const float pj = __shfl(p, j); o += pj * (float)VT[(size_t)lane * NT + kb + j]; }
            }
        }
        if (!isB) l += exp2f(P.sink[layer * 4 + head] * LOG2E - m);
        ((hf*)(P.ws + OFF_MIX))[(size_t)row * 1024 + (isB ? 256 : 0) + head * 64 + lane] = (hf)(o / l);
    }
}
#endif
#if defined(DBG_NAIVE_SSD)
__device__ __forceinline__ void naive_ssd_scan(const Params& P, int layer) {
    const int tid = opaque_tid(), lane = tid & 63, w = tid >> 6;
    const hf* U = (const hf*)(P.ws + OFF_U); const float* DTP = (const float*)(P.ws + OFF_DTP);
    float* Y = (float*)(P.ws + OFF_HS);
    for (int item = blockIdx.x * 8 + w; item < 512; item += gridDim.x * 8) {
        const int head = item >> 6, p = item & 63, g = head >> 2;
        for (int dir = 0; dir < 2; ++dir) {
            const float a = -expf(P.a_log[layer * 16 + dir * 8 + head]);
            float s0 = 0.f, s1 = 0.f;
            for (int step = 0; step < NT; ++step) {
                int t;
                if (dir == 0) t = step < NCX ? NL + step : step - NCX;
                else t = step < NCX ? NT - 1 - step : NL - 1 - (step - NCX);
                const float dt = DTP[(size_t)t * 16 + dir * 8 + head];
                const float x = (float)U[(size_t)t * 1024 + head * 64 + p];
                const float b0 = (float)U[(size_t)t * 1024 + 512 + g * 128 + lane], b1 = (float)U[(size_t)t * 1024 + 512 + g * 128 + 64 + lane];
                const float c0 = (float)U[(size_t)t * 1024 + 768 + g * 128 + lane], c1 = (float)U[(size_t)t * 1024 + 768 + g * 128 + 64 + lane];
                const float dec = expf(a * dt);
                s0 = s0 * dec + dt * b0 * x; s1 = s1 * dec + dt * b1 * x;
                float y = c0 * s0 + c1 * s1;
                for (int dd = 32; dd >= 1; dd >>= 1) y += __shfl_xor(y, dd);
                if (lane == 0) { float* yp = Y + (size_t)t * 512 + head * 64 + p; *yp = dir == 0 ? y : *yp + y; }
            }
        }
    }
}
__device__ __forceinline__ void naive_ssd_finish(const Params& P, int layer) {
    const int tid = opaque_tid(), lane = tid & 63, w = tid >> 6;
    const hf* U = (const hf*)(P.ws + OFF_U); const hf* Z = (const hf*)(P.ws + OFF_Z); const float* Y = (const float*)(P.ws + OFF_HS);
    const int nrows = layer == 0 ? NT : NL;
    for (int item = blockIdx.x * 8 + w; item < nrows * 2; item += gridDim.x * 8) {
        const int t = item >> 1, g = item & 1;
        float gv[4]; float ss = 0.f;
        for (int i = 0; i < 4; ++i) { const int ch = g * 256 + i * 64 + lane; const float y = Y[(size_t)t * 512 + ch] + (float)U[(size_t)t * 1024 + ch] * P.d_skip[layer * 8 + (ch >> 6)];
            const float z = (float)Z[(size_t)t * 512 + ch]; gv[i] = y * (z / (1.0f + expf(-z))); ss += gv[i] * gv[i]; }
        for (int dd = 32; dd >= 1; dd >>= 1) ss += __shfl_xor(ss, dd);
        const float rstd = 1.0f / sqrtf(ss / 256.0f + 1e-6f);
        for (int i = 0; i < 4; ++i) { const int ch = g * 256 + i * 64 + lane; ((hf*)(P.ws + OFF_MIX))[(size_t)t * 1024 + 512 + ch] = (hf)(gv[i] * rstd * P.gnorm_w[layer * 512 + ch]); }
    }
}
#endif
#if defined(DBG_NAIVE_INPROJ)
__device__ __forceinline__ void naive_inproj(const Params& P, int layer) {
    const int tid = opaque_tid(), lane = tid & 63, w = tid >> 6;
    const hf* H = (const hf*)(P.ws + OFF_H16); const hf* W = (const hf*)(P.ws + OFF_WIN) + (size_t)layer * INP * D;
    hf* qkv = (hf*)(P.ws + OFF_QKV);
    for (int item = blockIdx.x * 8 + w; item < NT * 16; item += gridDim.x * 8) {
        const int t = item >> 4, fb = item & 15, sub = fb & 7;
        const hf* hp = H + (size_t)t * D; const hf* wp = W + (size_t)(fb * 64 + lane) * D;
        float acc = 0.f;
        for (int k = 0; k < D; k += 8) { const h8 a = *(const h8*)(hp + k), b = *(const h8*)(wp + k); for (int j = 0; j < 8; ++j) acc += (float)a[j] * (float)b[j]; }
        float v = acc;
        if (sub < 6) {
            if (fb >= 8) { float ss = v * v; for (int dd = 32; dd >= 1; dd >>= 1) ss += __shfl_xor(ss, dd); v = v * (1.0f / sqrtf(ss / 64.0f + 1e-6f)) * (sub < 4 ? P.q_gain : P.k_gain)[layer * 64 + lane]; }
            if (t < NL) {
                const int axis = lane >> 5, half = (lane >> 4) & 1, f = lane & 15;
                const float pos = (float)(axis == 0 ? (t >> 6) : (t & 63));
                const float inv = powf(10000.0f, -(float)f / 16.0f); const float ang = pos * inv;
                const float other = __shfl_xor(v, 16);
                const float cs = cosf(ang), sn = sinf(ang);
                v = half == 0 ? v * cs - other * sn : other * sn + v * cs;
            }
            if (sub < 4) v *= 0.125f * LOG2E;
            qkv[(size_t)fb * HT + (size_t)t * 64 + lane] = (hf)v;
        } else qkv[(size_t)fb * HT + (size_t)lane * NT + t] = (hf)v;
    }
}
#endif


#if defined(DBG_NAIVE_INPROJ2)
__device__ __forceinline__ void naive_inproj2(const Params& P, int layer) {
    const int tid = opaque_tid(), lane = tid & 63, w = tid >> 6;
    const hf* H = (const hf*)(P.ws + OFF_H16); const hf* W = (const hf*)(P.ws + OFF_WIN) + (size_t)layer * INP * D;
    for (int item = blockIdx.x * 8 + w; item < NT * 25; item += gridDim.x * 8) {
        const int t = item / 25, fb = 16 + item % 25;
        const hf* hp = H + (size_t)t * D; const hf* wp = W + (size_t)(fb * 64 + lane) * D;
        float acc = 0.f;
        for (int k = 0; k < D; k += 8) { const h8 a = *(const h8*)(hp + k), b = *(const h8*)(wp + k); for (int j = 0; j < 8; ++j) acc += (float)a[j] * (float)b[j]; }
        if (fb < 24) ((hf*)(P.ws + OFF_Z))[(size_t)t * 512 + (fb - 16) * 64 + lane] = (hf)acc;
        else if (fb < 40) ((hf*)(P.ws + OFF_XBC))[(size_t)t * 1024 + (fb - 24) * 64 + lane] = (hf)acc;
        else if (lane < 16) ((float*)(P.ws + OFF_DTR))[(size_t)t * 16 + lane] = acc;
    }
}
#endif
#if defined(DBG_NAIVE_PREP)
__device__ __forceinline__ void naive_prep(const Params& P, int layer) {
    const hf* XBC = (const hf*)(P.ws + OFF_XBC); hf* U = (hf*)(P.ws + OFF_U); hf* UT = (hf*)(P.ws + OFF_UT);
    for (size_t e = (size_t)blockIdx.x * 512 + opaque_tid(); e < (size_t)NT * 1024; e += (size_t)gridDim.x * 512) {
        const int t = (int)(e >> 10), ch = (int)(e & 1023);
        const int seg0 = t < NL ? 0 : NL, seg1 = t < NL ? NL : NT;
        float s = P.conv_b[layer * 1024 + ch];
        for (int k = 0; k < 5; ++k) { const int tt = t + k - 2; if (tt >= seg0 && tt < seg1) s += P.conv_w[(size_t)layer * 5120 + k * 1024 + ch] * (float)XBC[(size_t)tt * 1024 + ch]; }
        const hf o = (hf)(s / (1.0f + expf(-s)));
        U[e] = o; if (ch < 768) UT[(size_t)ch * NT + t] = o;
    }
    const float* dr = (const float*)(P.ws + OFF_DTR); float* dp = (float*)(P.ws + OFF_DTP);
    for (int e = blockIdx.x * 512 + opaque_tid(); e < NT * 16; e += gridDim.x * 512) { const float xv = dr[e] + P.dt_bias[layer * 16 + (e & 15)]; dp[e] = xv > 20.f ? xv : log1pf(expf(xv)); }
}
#endif
#if defined(DBG_NAIVE_GEMM)
__device__ __forceinline__ void naive_res_gemm(const Params& P, const hf* A, const hf* Wt, int K, int nrows, int layer, int which_g, char* lds) {
    const int tid = opaque_tid(); float* ar = (float*)lds;
    for (int t = blockIdx.x; t < nrows; t += gridDim.x) {
        for (int k = tid; k < K; k += 512) ar[k] = (float)A[(size_t)t * K + k];
        __syncthreads();
        float* xr = xr_row(P, t); const float* g = modv(P, layer, t >= NL ? 1 : 0, which_g);
        for (int n = tid; n < D; n += 512) { const hf* wp = Wt + (size_t)n * K; float acc = 0.f;
            for (int k = 0; k < K; k += 8) { const h8 b = *(const h8*)(wp + k); for (int j = 0; j < 8; ++j) acc += ar[k + j] * (float)b[j]; }
            xr[n] = ALPHA * xr[n] + g[n] * acc; }
        __syncthreads();
    }
}
__device__ __forceinline__ void naive_gu_gemm(const Params& P, int layer, int nrows, char* lds) {
    const int tid = opaque_tid(); float* ar = (float*)lds;
    const hf* A = (const hf*)(P.ws + OFF_H16); hf* G = (hf*)(P.ws + OFF_G16);
    for (int t = blockIdx.x; t < nrows; t += gridDim.x) {
        for (int k = tid; k < D; k += 512) ar[k] = (float)A[(size_t)t * D + k];
        __syncthreads();
        for (int j = tid; j < DFF; j += 512) { float ag = 0.f, au = 0.f;
            for (int k = 0; k < D; ++k) { const float a = ar[k]; ag += a * (float)(hf)P.w_gu[(size_t)layer * D * NGU + (size_t)k * NGU + j]; au += a * (float)(hf)P.w_gu[(size_t)layer * D * NGU + (size_t)k * NGU + DFF + j]; }
            G[(size_t)t * DFF + j] = (hf)((ag / (1.0f + expf(-ag))) * au); }
        __syncthreads();
    }
}
#endif

__device__ __forceinline__ void phase_mix(const Params& P, int layer, char* lds) {
    const hf* qkv = (const hf*)(P.ws + OFF_QKV);
    const int ssd_end = 512 + (layer == 0 ? 264 : 256);
    const int nunits = ssd_end + (layer == 0 ? 8 : 0);
    float gq = 0.f, gk = 0.f;
    for (int i = 0; i < 64; ++i) { gq = fmaxf(gq, fabsf(P.q_gain[layer * 64 + i])); gk = fmaxf(gk, fabsf(P.k_gain[layer * 64 + i])); }
    const bool nomax_ok = 0.125f * LOG2E * 64.0f * gq * gk * 1.01f <= 14.0f;
#if defined(DBG_NAIVE_INPROJ)
    naive_inproj(P, layer); cg::this_grid().sync();
#endif
#if defined(DBG_NAIVE_ATTN)
    naive_attn(P, layer, lds); __syncthreads();
#endif
#if defined(DBG_NAIVE_SSD)
    naive_ssd_scan(P, layer); cg::this_grid().sync(); naive_ssd_finish(P, layer);
#endif
#pragma unroll 1
    for (int u = blockIdx.x; u < nunits; u += gridDim.x) {
#if defined(DBG_NAIVE_SSD)
        if (u >= 512 && u < ssd_end) continue;
#endif
#if defined(DBG_NAIVE_ATTN)
        if (u < 512 || u >= ssd_end) continue;
#endif
        if (u >= 512 && u < ssd_end) { const int i = u - 512;
            int cid = i >> 1, g = i & 1, l0 = 0, l1 = 2;
            if (i >= 256) { const int j = i - 256; cid = 128 + (j >> 2); g = (j >> 1) & 1; l0 = j & 1; l1 = l0 + 1; }
            ssd_out_unit(P, layer, cid, g, l0, l1, lds);
            continue; }
        int base, kvh, qrow0, ta0, na, tb0 = 0, nb = 0, use_sink, outcol;
        if (u < 256) {
            kvh = u & 1; base = 8; qrow0 = (u >> 1) * 128; ta0 = 0; na = 260; use_sink = 0; outcol = 256 + kvh * 128;
        } else if (u < 512) {
            const int i = u - 256, qb = i >> 1; kvh = i & 1; base = 0; qrow0 = qb * 128; ta0 = 256; na = 4;
            const int lo = 2 * qb - 2 < 0 ? 0 : 2 * qb - 2, hi = 2 * qb + 4 > 256 ? 256 : 2 * qb + 4;
            tb0 = lo; nb = hi - lo; use_sink = 1; outcol = kvh * 128;
        } else {
            const int i = u - ssd_end, isB = i >> 2, cq = i & 1; kvh = (i >> 1) & 1; base = isB ? 8 : 0;
            qrow0 = NL + cq * 128; ta0 = 256; na = 4; use_sink = isB ? 0 : 1; outcol = (isB ? 256 : 0) + kvh * 128;
        }
        AttnJob J; J.Q0 = qkv + (size_t)(base + 2 * kvh) * HT; J.Q1 = qkv + (size_t)(base + 1 + 2 * kvh) * HT; J.K = qkv + (size_t)(base + 4 + kvh) * HT; J.VT = qkv + (size_t)(base + 6 + kvh) * HT;
        J.qrow0 = qrow0; J.ta0 = ta0; J.na = na; J.tb0 = tb0; J.nb = nb; J.use_sink = use_sink; J.sink0 = P.sink[layer * 4 + 2 * kvh]; J.sink1 = P.sink[layer * 4 + 2 * kvh + 1]; J.outcol = outcol;
        if (u < 256 && nomax_ok) attn_unit_pin(P, J, lds); else attn_unit<false>(P, J, lds);
#if defined(PROBE_MIX_A)
        if (u >= 256) attn_unit<false>(P, J, lds);
#endif
#if defined(PROBE_MIX_B)
        if (u < 256) attn_unit<true>(P, J, lds);
#endif
    }
}

constexpr int PPL = 8;
constexpr int NPHASES = 3 + PPL * 2;

__device__ __forceinline__ void run_phase(const Params& P, int ph, char* lds) {
    if (ph == 0) { phase_p0(P, lds); return; }
    if (ph == 1) { phase_modfin(P); return; }
    if (ph == 2) { phase_rows(P, 0, NT, nullptr, nullptr, 0, 0, 1); return; }
    const int layer = (ph - 3) / PPL, sub0 = (ph - 3) % PPL;
    const bool pre_out = layer == 0 && sub0 == 6, pre_dn = layer == 1 && sub0 == 0;
    const int nsteps = (pre_out || pre_dn) ? 2 : 1;
    const int layer_ = layer;
#pragma unroll 1
    for (int step = 0; step < nsteps; ++step) {
        const bool ctxout = pre_out && step == 0, ctxdn = pre_dn && step == 0;
        const int sub = ctxout ? 5 : ctxdn ? 7 : sub0;
        const int layer = ctxdn ? 0 : layer_;
        const int mt = ctxdn ? 65 : (layer == 0 ? (sub == 7 ? 64 : 65) : 64);
        switch (sub) {
            case 0: { EpiIn e{P, layer}; gemm_phase(( const hf*)(P.ws + OFF_H16), (const hf*)(P.ws + OFF_WIN) + (size_t)layer * INP * D, 65, 11, D, e, lds, layer == 1 ? 4 : 0); } break;
            case 1: phase_prep(P, layer, lds); break;
            case 2: phase_ssd_states(P, layer, lds); break;
            case 3: phase_ssd_scan(P); break;
            case 4: phase_mix(P, layer, lds); break;
            case 5: { EpiResLN e{P, layer, 2, layer == 0 ? nullptr : P.ln2_g + (layer - 1) * D, layer == 0 ? nullptr : P.ln2_b + (layer - 1) * D,
                                 P.ln1_g + layer * D, P.ln1_b + layer * D, layer, 3, 4, 0, layer * 2};
                      gemm_phase((const hf*)(P.ws + OFF_MIX), (const hf*)(P.ws + OFF_WOUT) + (size_t)layer * D * D, ctxout ? 1 : 64, 4, D, e, lds, ctxout ? 1 : 0); } break;
            case 6: { EpiGU e{P}; gemm_phase((const hf*)(P.ws + OFF_H16), (const hf*)(P.ws + OFF_WGU) + (size_t)layer * NGU * D, mt, 22, D, e, lds, layer == 0 ? 2 : 0); } break;
            case 7: { EpiResLN e{P, layer, 5, P.ln1_g + layer * D, P.ln1_b + layer * D,
                                 P.ln2_g + layer * D, P.ln2_b + layer * D, layer == 0 ? 1 : 0, 0, 1, layer == 1 ? 1 : 0, layer * 2 + 1};
                      gemm_phase((const hf*)(P.ws + OFF_G16), (const hf*)(P.ws + OFF_WDN) + (size_t)layer * D * DFF, ctxdn ? 1 : mt, 4, DFF, e, lds, ctxdn ? 3 : 0); } break;
        }
    }
}

__global__ void __launch_bounds__(512) fwd_kernel(Params P) {
    extern __shared__ __attribute__((aligned(16))) char lds[];
    P.wv = __builtin_amdgcn_readfirstlane((int)(threadIdx.x >> 6));
    volatile LAS unsigned* st = (volatile LAS unsigned*)(lds + 131072);
    if (threadIdx.x < 4) st[threadIdx.x] = 0u;
    __syncthreads();
    const XcdBarrier xb = xcd_barrier_post((unsigned*)(P.ws + OFF_BAR), st);
#pragma unroll 1
    for (int ph = P.ph_lo; ph < P.ph_hi; ++ph) {
        run_phase(P, ph, lds);
#if defined(PROBE_REPEAT_SUB)
        { const int sub_ = ph >= 3 ? (ph - 3) % PPL : -1 - ph; if ((PROBE_REPEAT_MASK >> (sub_ + 3)) & 1) { xcd_barrier(xb); run_phase(P, ph, lds); } }
#endif
        if (ph + 1 < P.ph_hi) { if (ph == P.ph_lo) cg::this_grid().sync(); else xcd_barrier(xb); }
    }
}

constexpr int LDS_BYTES = 131072 + 256;

extern "C" void kernel_launch(void* const* d_in, const int* in_sizes, int n_in, void* d_out, int out_size, void* d_ws, size_t ws_size, hipStream_t stream) {
    static int grid = 0;
    if (grid == 0) {
        if (n_in != 23 || out_size != NL * D || ws_size < OFF_END) { fprintf(stderr, "kernel_launch: unexpected shapes (n_in %d out %d ws %zu need %zu)\n", n_in, out_size, ws_size, (size_t)OFF_END); grid = -1; return; }
        int dev = 0, cus = 0, per_cu = 0;
        hipGetDevice(&dev); hipDeviceGetAttribute(&cus, hipDeviceAttributeMultiprocessorCount, dev);
        hipFuncSetAttribute((const void*)fwd_kernel, hipFuncAttributeMaxDynamicSharedMemorySize, LDS_BYTES);
        hipOccupancyMaxActiveBlocksPerMultiprocessor(&per_cu, (const void*)fwd_kernel, 512, LDS_BYTES);
        if (per_cu < 1) { fprintf(stderr, "kernel_launch: occupancy query says %d blocks/CU\n", per_cu); }
        (void)hipGetLastError();
        grid = cus > 0 ? cus : 256;
    }
    if (grid < 0) return;
    Params p{};
    const float** pp = (const float**)&p;
    for (int i = 0; i < 23; ++i) pp[i] = (const float*)d_in[i];
    p.out = (float*)d_out; p.ws = (unsigned char*)d_ws;
#if MULTI_LAUNCH
    for (int ph = 0; ph < NPHASES; ++ph) { p.ph_lo = ph; p.ph_hi = ph + 1; hipLaunchKernelGGL(fwd_kernel, dim3(grid), dim3(512), LDS_BYTES, stream, p); }
#else
    p.ph_lo = 0; p.ph_hi = NPHASES;
    if (hipMemsetAsync((char*)d_ws + OFF_BAR, 0, 16384, stream) != hipSuccess) fprintf(stderr, "memset of barrier words failed\n");
    void* args[] = {&p};
    hipError_t e = hipLaunchCooperativeKernel((const void*)fwd_kernel, dim3(grid), dim3(512), args, LDS_BYTES, stream);
    if (e != hipSuccess) fprintf(stderr, "cooperative launch failed: %s (grid %d)\n", hipGetErrorString(e), grid);
#endif
}
```

```cpp
#include <hip/hip_runtime.h>
#include <hip/hip_cooperative_groups.h>
#include <cstdio>
#include <cstdint>
namespace cg = cooperative_groups;

#ifndef MULTI_LAUNCH
#define MULTI_LAUNCH 0
#endif

typedef _Float16 hf;
typedef hf h2 __attribute__((ext_vector_type(2)));
typedef hf h4 __attribute__((ext_vector_type(4)));
typedef hf h8 __attribute__((ext_vector_type(8)));
typedef float f4 __attribute__((ext_vector_type(4)));
typedef float fx16 __attribute__((ext_vector_type(16)));
typedef unsigned u4 __attribute__((ext_vector_type(4)));
typedef unsigned u2 __attribute__((ext_vector_type(2)));

constexpr int NL = 16384, NCX = 256, NT = 16640, D = 1024, INC = 2576, INP = 2816, DFF = 2816, NGU = 5632;
constexpr int NCHK = 130;
constexpr size_t HT = (size_t)NT * 64;
constexpr float LOG2E = 1.4426950408889634f;
constexpr float ALPHA = 1.4142135623730951f;

constexpr size_t OFF_WIN = 0;
constexpr size_t OFF_WOUT = OFF_WIN + (size_t)2 * INP * D * 2;
constexpr size_t OFF_WGU = OFF_WOUT + (size_t)2 * D * D * 2;
constexpr size_t OFF_WDN = OFF_WGU + (size_t)2 * NGU * D * 2;
constexpr size_t OFF_H16 = OFF_WDN + (size_t)2 * D * DFF * 2;
constexpr size_t OFF_SMALL = OFF_H16 + (size_t)NT * D * 2;
constexpr size_t OFF_MODP = OFF_SMALL;
constexpr size_t OFF_MOD = OFF_MODP + (size_t)8 * 2 * 2 * 6144 * 4;
constexpr size_t OFF_ROPE = OFF_MOD + (size_t)2 * 2 * 6144 * 4;
constexpr size_t OFF_XRC = OFF_ROPE + (size_t)256 * 16 * 2 * 4;
constexpr size_t OFF_DTR = OFF_XRC + (size_t)NCX * D * 4;
constexpr size_t OFF_DTP = OFF_DTR + (size_t)NT * 16 * 4;
constexpr size_t OFF_DEC = OFF_DTP + (size_t)NT * 16 * 4;
constexpr size_t OFF_BAR = OFF_DEC + 16384;
constexpr size_t OFF_CNT = OFF_BAR + 13824;
constexpr size_t OFF_STATS = OFF_BAR + 16384;
constexpr size_t OFF_BIG = OFF_SMALL + (size_t)4 * 1024 * 1024 + 262144;
constexpr size_t OFF_QKV = OFF_BIG;
constexpr size_t OFF_Z = OFF_QKV + 16 * HT * 2;
constexpr size_t OFF_XBC = OFF_Z + (size_t)NT * 512 * 2;
constexpr size_t OFF_HS = OFF_XBC;
constexpr size_t OFF_U = OFF_XBC + (size_t)NT * 1024 * 2;
constexpr size_t OFF_UT = OFF_U + (size_t)NT * 1024 * 2;
constexpr size_t OFF_XSL = OFF_UT;
constexpr size_t OFF_CS = OFF_UT + (size_t)768 * NT * 2;
constexpr size_t OFF_MIX = OFF_CS;
constexpr size_t OFF_G16 = OFF_BIG;
constexpr size_t OFF_END = OFF_CS + (size_t)NCHK * 2 * 8 * 64 * 128 * 2;
constexpr int XRB_SPLIT = 12288;
constexpr size_t OFF_XRB_A = ((OFF_G16 + (size_t)NT * DFF * 2 + 4095) / 4096) * 4096;
constexpr size_t OFF_XRB_B = OFF_UT + (size_t)1024 * 1024;
static_assert(OFF_XRB_A + (size_t)XRB_SPLIT * D * 2 <= OFF_UT && (size_t)NT * 32 <= (size_t)1024 * 1024 && OFF_XRB_B + (size_t)(NL - XRB_SPLIT) * D * 2 <= OFF_CS, "XRB overflow");
static_assert(NCHK * 2 * 8 * 4 <= 16384 && 3456 * 4 <= 16384 && OFF_STATS + (size_t)NT * 8 <= OFF_BIG, "small region overflow");
static_assert(OFF_G16 + (size_t)NT * DFF * 2 <= OFF_END, "G16 overflow");
static_assert(OFF_END <= (size_t)256 * 1024 * 1024, "workspace too large");

struct Params {
    const float* x; const float* c; const float* ctx; const float* c_ctx; const float* w_ada; const float* b_ada; const float* w_in;
    const float* sink; const float* q_gain; const float* k_gain; const float* conv_w; const float* conv_b; const float* a_log;
    const float* dt_bias; const float* d_skip; const float* gnorm_w; const float* w_out; const float* ln1_g; const float* ln1_b;
    const float* ln2_g; const float* ln2_b; const float* w_gu; const float* w_down;
    float* out; unsigned char* ws; int ph_lo, ph_hi; int wv;
};

__device__ __forceinline__ float silu_f(float x) { return x * __builtin_amdgcn_rcpf(1.0f + __builtin_amdgcn_exp2f(-x * LOG2E)); }
__device__ __forceinline__ hf* xr16_row(const Params& P, int row, bool in_ws) {
    if (row >= NL) return (hf*)(P.ws + OFF_XRC) + (size_t)(row - NL) * D;
    if (in_ws) return row < XRB_SPLIT ? (hf*)(P.ws + OFF_XRB_A) + (size_t)row * D : (hf*)(P.ws + OFF_XRB_B) + (size_t)(row - XRB_SPLIT) * D;
    return (hf*)P.out + (size_t)row * D;
}
__device__ __forceinline__ float* xr_row(const Params& P, int row) { return row < NL ? P.out + (size_t)row * D : (float*)(P.ws + OFF_XRC) + (size_t)(row - NL) * D; }
__device__ __forceinline__ const float* modv(const Params& P, int layer, int set, int which) { return (const float*)(P.ws + OFF_MOD) + (size_t)((layer * 2 + set) * 6 + which) * 1024; }
__device__ __forceinline__ u4 pair16(h4 a_, h4 b_) {
    const u2 a = __builtin_bit_cast(u2, a_), b = __builtin_bit_cast(u2, b_);
    const auto r0 = __builtin_amdgcn_permlane16_swap(a.x, b.x, false, false);
    const auto r1 = __builtin_amdgcn_permlane16_swap(a.y, b.y, false, false);
    u4 w; w.x = r0[0]; w.y = r1[0]; w.z = r0[1]; w.w = r1[1]; return w;
}
__device__ __forceinline__ int pair_off(int fq) { return (fq & 1) ? 16 + (fq - 1) * 4 : fq * 4; }
__device__ __forceinline__ fx16 mfma16(h8 a, h8 b, fx16 c) { return __builtin_amdgcn_mfma_f32_32x32x16_f16(a, b, c, 0, 0, 0); }
__device__ __forceinline__ int opaque_tid_w(int wv) { int z = 0; asm volatile("" : "+v"(z)); const int lane = __builtin_amdgcn_mbcnt_hi(-1, __builtin_amdgcn_mbcnt_lo(-1, z)); return (wv << 6) | lane; }
#define opaque_tid() opaque_tid_w(P.wv)
__device__ __forceinline__ float shflx(float v, int mask, int lane) { return __builtin_bit_cast(float, __builtin_amdgcn_ds_bpermute((lane ^ mask) << 2, __builtin_bit_cast(int, v))); }
__device__ __forceinline__ float rdlane(float v, int l) { return __builtin_bit_cast(float, __builtin_amdgcn_readlane(__builtin_bit_cast(int, v), l)); }
__device__ __forceinline__ fx16 zero16() { fx16 z; for (int i = 0; i < 16; ++i) z[i] = 0.f; return z; }


#define XB_TMO      128
#define XB_XCNT(j)  (256  + 64 * (j))
#define XB_XSUB(j)  (1280 + 64 * (j))
#define XB_XGEN(j)  (2304 + 64 * (j))
#define XB_TOP      3328
#define XB_TOPGEN   3392
#define XCD_BAR_WORDS 3456
#define XB_SPIN_CAP (1u << 22)
#define LAS __attribute__((address_space(3)))
__device__ __forceinline__ unsigned xb_ld(unsigned* p)              { return __hip_atomic_load(p, __ATOMIC_RELAXED, __HIP_MEMORY_SCOPE_AGENT); }
__device__ __forceinline__ unsigned xb_add(unsigned* p, unsigned v) { return __hip_atomic_fetch_add(p, v, __ATOMIC_RELAXED, __HIP_MEMORY_SCOPE_AGENT); }
__device__ __forceinline__ unsigned xb_xcc_id() { return (unsigned)__builtin_amdgcn_s_getreg((3 << 11) | 20) & 0xFu; }
#define XB_SPIN(cond, bar) do { unsigned _sp = 0; while (cond) { __builtin_amdgcn_s_sleep(1); \
    if ((++_sp & 255u) == 0u) { if (xb_ld(&(bar)[XB_TMO])) break; if (_sp > XB_SPIN_CAP) { atomicAdd(&(bar)[XB_TMO], 1u); break; } } } } while (0)
struct XcdBarrier { unsigned* bar; unsigned x; volatile LAS unsigned* st; };
__device__ __forceinline__ XcdBarrier xcd_barrier_post(unsigned* bar, volatile LAS unsigned* st) {
    XcdBarrier b; b.bar = bar; b.x = xb_xcc_id(); b.st = st;
    if (threadIdx.x == 0) (void)xb_add(&bar[XB_XCNT(b.x)], 1u);
    return b;
}
__device__ __forceinline__ void xcd_barrier_complete(unsigned* bar, unsigned x, unsigned& nloc, unsigned& nx) {
    const unsigned G = gridDim.x * gridDim.y * gridDim.z;
    unsigned sum, cnt, mine, sp = 0u;
    for (;;) {
        sum = 0u; cnt = 0u; mine = 0u;
#pragma unroll
        for (unsigned j = 0; j < 16; ++j) { const unsigned c = xb_ld(&bar[XB_XCNT(j)]); sum += c; cnt += (c > 0u) ? 1u : 0u; mine = (j == x) ? c : mine; }
        if (sum == G) break;
        __builtin_amdgcn_s_sleep(1);
        if ((++sp & 255u) == 0u) { if (xb_ld(&bar[XB_TMO])) break; if (sp > XB_SPIN_CAP) { atomicAdd(&bar[XB_TMO], 1u); break; } }
    }
    nloc = mine > 0u ? mine : 1u; nx = cnt > 0u ? cnt : 1u;
}
__device__ __forceinline__ void xcd_barrier(const XcdBarrier& b) {
    asm volatile("s_waitcnt vmcnt(0)" ::: "memory");
    __syncthreads();
    if (threadIdx.x == 0) {
        unsigned* bar = b.bar;
        __builtin_amdgcn_s_waitcnt(0);
        unsigned nloc = b.st[0], nx = b.st[1];
        if (nloc == 0u) { xcd_barrier_complete(bar, b.x, nloc, nx); b.st[0] = nloc; b.st[1] = nx; }
        const unsigned old = xb_add(&bar[XB_XSUB(b.x)], 1u);
        const unsigned gen = old / nloc;
        if (old + 1u == (gen + 1u) * nloc) {
            __builtin_amdgcn_fence(__ATOMIC_RELEASE, "agent");
            asm volatile("s_waitcnt vmcnt(0)" ::: "memory");
            const unsigned og = xb_add(&bar[XB_TOP], 1u);
            const unsigned tg = og / nx;
            if (og + 1u == (tg + 1u) * nx) xb_add(&bar[XB_TOPGEN], 1u);
            else XB_SPIN(xb_ld(&bar[XB_TOPGEN]) == tg, bar);
            __builtin_amdgcn_fence(__ATOMIC_ACQUIRE, "agent");
            xb_add(&bar[XB_XGEN(b.x)], 1u);
            asm volatile("s_waitcnt vmcnt(0)" ::: "memory");
        } else {
            XB_SPIN(xb_ld(&bar[XB_XGEN(b.x)]) == gen, bar);
            __builtin_amdgcn_fence(__ATOMIC_ACQUIRE, "agent");
            asm volatile("s_waitcnt vmcnt(0)" ::: "memory");
        }
    }
    __syncthreads();
}

__device__ __forceinline__ void phase_p0(const Params& P, char* lds) {
    const int tid = opaque_tid();
    float* tile = (float*)lds;
    for (int u = blockIdx.x; u < 1536 + 192 + 8; u += gridDim.x) {
        if (u < 1536) {
            const float* src; hf* dst; int ld, K, r0, k0, kind;
            if (u < 352) { const int l = u / 176, rem = u % 176; r0 = (rem / 16) * 256; k0 = (rem % 16) * 64; ld = INC; K = D; kind = 0; src = P.w_in + (size_t)l * D * INC; dst = (hf*)(P.ws + OFF_WIN) + (size_t)l * INP * D; }
            else if (u < 480) { const int i = u - 352, l = i / 64, rem = i % 64; r0 = (rem / 16) * 256; k0 = (rem % 16) * 64; ld = D; K = D; kind = 1; src = P.w_out + (size_t)l * D * D; dst = (hf*)(P.ws + OFF_WOUT) + (size_t)l * D * D; }
            else if (u < 1184) { const int i = u - 480, l = i / 352, rem = i % 352; r0 = (rem / 16) * 256; k0 = (rem % 16) * 64; ld = NGU; K = D; kind = 2; src = P.w_gu + (size_t)l * D * NGU; dst = (hf*)(P.ws + OFF_WGU) + (size_t)l * NGU * D; }
            else { const int i = u - 1184, l = i / 176, rem = i % 176; r0 = (rem / 44) * 256; k0 = (rem % 44) * 64; ld = D; K = DFF; kind = 3; src = P.w_down + (size_t)l * DFF * D; dst = (hf*)(P.ws + OFF_WDN) + (size_t)l * D * DFF; }
            const int c4 = (tid & 63) * 4, kq = tid >> 6;
            int scol = r0 + c4; bool valid = true;
            if (kind == 2) scol = c4 < 128 ? (r0 >> 1) + c4 : DFF + (r0 >> 1) + (c4 - 128);
            else if (kind == 0 && scol >= INC) valid = false;
            f4 v[8];
#pragma unroll
            for (int i = 0; i < 8; ++i) v[i] = valid ? *(const f4*)(src + (size_t)(k0 + kq + 8 * i) * ld + scol) : (f4){0.f, 0.f, 0.f, 0.f};
#pragma unroll
            for (int i = 0; i < 8; ++i) { float* tp = tile + (kq + 8 * i) * 257 + c4; tp[0] = v[i][0]; tp[1] = v[i][1]; tp[2] = v[i][2]; tp[3] = v[i][3]; }
            __syncthreads();
            const int kc = tid & 7;
#pragma unroll
            for (int p = 0; p < 4; ++p) {
                const int rr = (tid >> 3) + 64 * p;
                const int c = kind == 2 ? ((rr >> 5) & 1) * 128 + (rr >> 6) * 32 + (rr & 31) : rr;
                h8 o;
#pragma unroll
                for (int j = 0; j < 8; ++j) o[j] = (hf)tile[(kc * 8 + j) * 257 + c];
                *(h8*)(dst + (size_t)(r0 + rr) * K + k0 + kc * 8) = o;
            }
            __syncthreads();
        } else if (u < 1536 + 192) {
            const int i = u - 1536, l = i / 96, rem = i % 96, cc = rem / 8, ks = rem % 8;
            float* sv = (float*)lds;
            if (tid < 256) { const int set = tid >> 7, k = tid & 127; const float v = set ? P.c_ctx[ks * 128 + k] : P.c[ks * 128 + k]; sv[tid] = v / (1.0f + expf(-v)); }
            __syncthreads();
            const int n = cc * 512 + tid;
            const float* w = P.w_ada + (size_t)l * D * 6144 + (size_t)(ks * 128) * 6144 + n;
            float a0 = 0.f, a1 = 0.f;
#pragma unroll 16
            for (int k = 0; k < 128; ++k) { const float wv = w[(size_t)k * 6144]; a0 += sv[k] * wv; a1 += sv[128 + k] * wv; }
            float* mp = (float*)(P.ws + OFF_MODP);
            mp[(size_t)((ks * 2 + l) * 2 + 0) * 6144 + n] = a0;
            mp[(size_t)((ks * 2 + l) * 2 + 1) * 6144 + n] = a1;
            __syncthreads();
        } else {
            const int e = (u - 1728) * 512 + tid, pos = e >> 4, f = e & 15;
            const float inv = exp2f(-(float)f * (13.287712379549449f / 16.0f));
            const float ang = (float)pos * inv;
            float sn, cs; sincosf(ang, &sn, &cs);
            float2* rt = (float2*)(P.ws + OFF_ROPE);
            rt[e] = make_float2(cs, sn);
        }
    }
}

__device__ __forceinline__ void phase_modfin(const Params& P) {
    const float* mp = (const float*)(P.ws + OFF_MODP);
    float* mo = (float*)(P.ws + OFF_MOD);
    for (int e = blockIdx.x * 512 + opaque_tid(); e < 2 * 2 * 6144; e += gridDim.x * 512) {
        const int l = e / 12288, rem = e % 12288, set = rem / 6144, n = rem % 6144;
        float s = P.b_ada[l * 6144 + n];
#pragma unroll
        for (int ks = 0; ks < 8; ++ks) s += mp[(size_t)((ks * 2 + l) * 2 + set) * 6144 + n];
        mo[e] = s;
    }
}

__device__ __forceinline__ void phase_rows(const Params& P, int mode, int nrows, const float* lg, const float* lb, int modlayer, int which_sh, int which_sc) {
    const int tid = opaque_tid(), lane = tid & 63, w = tid >> 6;
    hf* H = (hf*)(P.ws + OFF_H16);
    float2* stats = (float2*)(P.ws + OFF_STATS);
    const int half = nrows >> 1;
    for (int r0 = blockIdx.x * 8 + w; r0 < half; r0 += gridDim.x * 8) {
        f4 v[2][4];
#pragma unroll
        for (int k = 0; k < 2; ++k) {
            const int row = r0 + k * half;
            const float* src = mode == 0 ? (row < NL ? P.x + (size_t)row * D : P.ctx + (size_t)(row - NL) * D) : xr_row(P, row);
#pragma unroll
            for (int i = 0; i < 4; ++i) v[k][i] = *(const f4*)(src + (lane + 64 * i) * 4);
        }
#pragma unroll
        for (int k = 0; k < 2; ++k) {
            const int row = r0 + k * half;
            const int set = row >= NL ? 1 : 0;
            if (mode != 0) {
                float s = 0.f;
#pragma unroll
                for (int i = 0; i < 4; ++i) s += (v[k][i][0] + v[k][i][1]) + (v[k][i][2] + v[k][i][3]);
#pragma unroll
                for (int d = 32; d >= 1; d >>= 1) s += shflx(s, d, lane);
                const float mean = s * (1.0f / 1024.0f);
                float q = 0.f;
#pragma unroll
                for (int i = 0; i < 4; ++i) { const f4 dd = v[k][i] - mean; q += (dd[0] * dd[0] + dd[1] * dd[1]) + (dd[2] * dd[2] + dd[3] * dd[3]); }
#pragma unroll
                for (int d = 32; d >= 1; d >>= 1) q += shflx(q, d, lane);
                const float rstd = 1.0f / sqrtf(q * (1.0f / 1024.0f) + 1e-5f);
                if (lane == 0) stats[row] = make_float2(mean, rstd);
#pragma unroll
                for (int i = 0; i < 4; ++i) { const int col = (lane + 64 * i) * 4; const f4 g = *(const f4*)(lg + col), b = *(const f4*)(lb + col); v[k][i] = (v[k][i] - mean) * rstd * g + b; }
            }
            if (mode == 2) {
                float* dst = xr_row(P, row);
#pragma unroll
                for (int i = 0; i < 4; ++i) *(f4*)(dst + (lane + 64 * i) * 4) = v[k][i];
            } else {
                const float* sh = modv(P, modlayer, set, which_sh); const float* sc = modv(P, modlayer, set, which_sc);
#pragma unroll
                for (int i = 0; i < 4; ++i) { const int col = (lane + 64 * i) * 4; const f4 a = *(const f4*)(sc + col), b = *(const f4*)(sh + col); const f4 y = v[k][i] * (1.0f + a) + b;
                    h4 o; o[0] = (hf)y[0]; o[1] = (hf)y[1]; o[2] = (hf)y[2]; o[3] = (hf)y[3]; *(h4*)(H + (size_t)row * D + col) = o; }
            }
        }
    }
}

__device__ __forceinline__ int lds_byte(int r, int c) { const int st = (r >> 4) * 2 + (c >> 5), rr = r & 15, cc = c & 31, ob = rr * 64 + cc * 2; return st * 1024 + (ob ^ (((ob >> 9) & 1) << 5)); }
__device__ __forceinline__ void stage_rc(int b, int& R, int& C) { const int st = b / 1024, sb = b % 1024, swz = sb ^ (((sb >> 9) & 1) << 5); R = (st >> 1) * 16 + swz / 64; C = (st & 1) * 32 + (swz % 64) / 2; }

template <class Epi>
__device__ __forceinline__ void gemm_phase(const hf* X, const hf* Wt, int Mtiles, int Ntiles, int K, const Epi& epi, char* lds, int mode) {
    constexpr int BK = 64, HALF = 128, HTB = HALF * BK * 2;
    const int tid = opaque_tid_w(epi.P.wv), lane = tid & 63, wid = tid >> 6, wr = wid >> 2, wc = wid & 3, fr = lane & 15, fq = lane >> 4;
#define SA(b, h) (lds + ((b) * 2 + (h)) * HTB)
#define SB(b, h) (lds + (4 + (b) * 2 + (h)) * HTB)
#define STAGE(Pp, BASE, br, kt) do { const int so_ = ((br) * K + (kt) * BK) * 2; \
      __builtin_amdgcn_raw_ptr_buffer_load_lds(rs_##BASE, (LAS void*)((LAS char*)(Pp) + wbase), 16, (int)soff, so_, 0, 0); \
      __builtin_amdgcn_raw_ptr_buffer_load_lds(rs_##BASE, (LAS void*)((LAS char*)(Pp) + wbase + 8192), 16, (int)soff, so_ + 128 * K, 0, 0); } while (0)
#define LDA(dst, b, h) _Pragma("unroll") for (int m = 0; m < 4; ++m) _Pragma("unroll") for (int k = 0; k < 2; ++k) \
    dst[m][k] = *reinterpret_cast<const h8*>(SA(b, h) + lds_byte(wr * 64 + m * 16 + fr, k * 32 + fq * 8))
#define LDB(dst, b, h) _Pragma("unroll") for (int n = 0; n < 2; ++n) _Pragma("unroll") for (int k = 0; k < 2; ++k) \
    dst[n][k] = *reinterpret_cast<const h8*>(SB(b, h) + lds_byte(wc * 32 + n * 16 + fr, k * 32 + fq * 8))
#define MMA(ai, bj, At_, Bt_) do { __builtin_amdgcn_s_setprio(1); \
    _Pragma("unroll") for (int m = 0; m < 4; ++m) _Pragma("unroll") for (int n = 0; n < 2; ++n) _Pragma("unroll") for (int k = 0; k < 2; ++k) \
      acc[ai][bj][m][n] = __builtin_amdgcn_mfma_f32_16x16x32_f16(At_[m][k], Bt_[n][k], acc[ai][bj][m][n], 0, 0, 0); \
    __builtin_amdgcn_s_setprio(0); } while (0)
#define WAIT_V(n) asm volatile("s_waitcnt vmcnt(" #n ")" ::: "memory")
#define WAIT_L(n) asm volatile("s_waitcnt lgkmcnt(" #n ")" ::: "memory")
#define BAR __builtin_amdgcn_s_barrier()
#define SCHED __builtin_amdgcn_sched_barrier(0)
    const int nt = K / BK;
    const int wbase = __builtin_amdgcn_readfirstlane(wid) * 1024;
    const __amdgpu_buffer_rsrc_t rs_X = __builtin_amdgcn_make_buffer_rsrc((void*)X, 0, 0x7fffffff, 0x00020000);
    const __amdgpu_buffer_rsrc_t rs_Wt = __builtin_amdgcn_make_buffer_rsrc((void*)Wt, 0, 0x7fffffff, 0x00020000);
    unsigned soff; { int r0, c0; stage_rc(tid * 16, r0, c0); soff = (unsigned)(r0 * K + c0) * 2u; }
    const int G = gridDim.x, per = (G & 7) == 0 ? G >> 3 : 0, total = Mtiles * Ntiles;
#pragma unroll 1
    for (int it = 0;; ++it) {
        int v = per ? (it * 8 + (blockIdx.x & 7)) * per + (blockIdx.x >> 3) : it * G + blockIdx.x;
        if (mode == 1 || mode == 3) v = (it == 0 && (int)(blockIdx.x & 7) == (mode == 1 ? 5 : 7) && (blockIdx.x >> 3) < 4) ? (int)(blockIdx.x >> 3) : total;
        if (mode == 4 && (blockIdx.x & 7) == 7) {
            const int j = blockIdx.x >> 3;
            if (j < 4 && it >= 1) v = total; else if (j >= 4 && j < 8 && it == 2) v = 480 + (j - 4);
        }
        if (v >= total) break;
        const int grp = v / (4 * Ntiles), rem = v - grp * 4 * Ntiles, rows = Mtiles - 4 * grp < 4 ? Mtiles - 4 * grp : 4;
        int pn = rem / rows, pm = 4 * grp + rem % rows;
        if (mode == 1 || mode == 3) { pn = v; pm = 64; }
        unsigned* ctxready = (unsigned*)(epi.P.ws + OFF_CNT) + (mode >= 3 ? 301 : 300);
        if ((mode == 2 || mode == 4) && pm == 64) {
            if (opaque_tid_w(epi.P.wv) == 0) {
                unsigned spins = 0;
                while (__hip_atomic_load(ctxready, __ATOMIC_RELAXED, __HIP_MEMORY_SCOPE_AGENT) < 4u) { __builtin_amdgcn_s_sleep(2); if (++spins > (1u << 22)) break; }
                __builtin_amdgcn_fence(__ATOMIC_ACQUIRE, "agent");
                asm volatile("s_waitcnt vmcnt(0)" ::: "memory");
            }
            __syncthreads();
        }
        const int brow = pn * 256, bcol = pm * 256;
        f4 acc[2][2][4][2];
#pragma unroll
        for (int a = 0; a < 2; ++a)
#pragma unroll
            for (int b = 0; b < 2; ++b)
#pragma unroll
                for (int m = 0; m < 4; ++m)
#pragma unroll
                    for (int n = 0; n < 2; ++n) acc[a][b][m][n] = (f4){0.f, 0.f, 0.f, 0.f};
        h8 At[4][2], B0[2][2], B1[2][2];
        STAGE(SB(0, 0), X, bcol, 0); STAGE(SA(0, 0), Wt, brow, 0);
        STAGE(SB(0, 1), X, bcol + HALF, 0); STAGE(SA(0, 1), Wt, brow + HALF, 0);
        if (wr == 1) BAR;
        WAIT_V(4); BAR;
        STAGE(SB(1, 0), X, bcol, 1); STAGE(SA(1, 0), Wt, brow, 1); STAGE(SB(1, 1), X, bcol + HALF, 1);
        WAIT_V(6); BAR;
#pragma unroll 1
        for (int t = 0; t < nt - 2; t += 2) {
            LDB(B0, 0, 0); SCHED; LDA(At, 0, 0); STAGE(SA(1, 1), Wt, brow + HALF, t + 1);
            WAIT_L(8); BAR; WAIT_L(0); MMA(0, 0, At, B0); BAR; SCHED;
            LDB(B1, 0, 1); STAGE(SB(0, 0), X, bcol, t + 2);
            BAR; WAIT_L(0); MMA(0, 1, At, B1); BAR;
            LDA(At, 0, 1); STAGE(SA(0, 0), Wt, brow, t + 2);
            BAR; WAIT_L(0); MMA(1, 0, At, B0); BAR; SCHED;
            STAGE(SB(0, 1), X, bcol + HALF, t + 2);
            WAIT_V(6); BAR; MMA(1, 1, At, B1); BAR;
            LDB(B0, 1, 0); SCHED; LDA(At, 1, 0); STAGE(SA(0, 1), Wt, brow + HALF, t + 2);
            WAIT_L(8); BAR; WAIT_L(0); MMA(0, 0, At, B0); BAR; SCHED;
            LDB(B1, 1, 1); STAGE(SB(1, 0), X, bcol, t + 3);
            BAR; WAIT_L(0); MMA(0, 1, At, B1); BAR;
            LDA(At, 1, 1); STAGE(SA(1, 0), Wt, brow, t + 3);
            BAR; WAIT_L(0); MMA(1, 0, At, B0); BAR; SCHED;
            STAGE(SB(1, 1), X, bcol + HALF, t + 3);
            WAIT_V(6); BAR; MMA(1, 1, At, B1); BAR;
        }
        { LDB(B0, 0, 0); LDA(At, 0, 0); STAGE(SA(1, 1), Wt, brow + HALF, nt - 1);
          BAR; WAIT_L(0); MMA(0, 0, At, B0); BAR;
          LDB(B1, 0, 1); BAR; WAIT_L(0); MMA(0, 1, At, B1); BAR;
          LDA(At, 0, 1); WAIT_V(4); BAR; WAIT_L(0); MMA(1, 0, At, B0); MMA(1, 1, At, B1); BAR; }
        { LDB(B0, 1, 0); LDA(At, 1, 0); WAIT_V(2); BAR; WAIT_L(0); MMA(0, 0, At, B0); BAR;
          LDB(B1, 1, 1); WAIT_V(0); BAR; WAIT_L(0); MMA(0, 1, At, B1); BAR;
          LDA(At, 1, 1); BAR; WAIT_L(0); MMA(1, 0, At, B0); MMA(1, 1, At, B1); BAR; }
        if (wr == 0) BAR;
        epi(acc, pm, pn, wr, wc, fr, fq, lds);
        if (mode == 1 || mode == 3) {
            asm volatile("s_waitcnt vmcnt(0)" ::: "memory");
            __syncthreads();
            if (opaque_tid_w(epi.P.wv) == 0) {
                __builtin_amdgcn_fence(__ATOMIC_RELEASE, "agent");
                asm volatile("s_waitcnt vmcnt(0)" ::: "memory");
                __hip_atomic_fetch_add(ctxready, 1u, __ATOMIC_RELAXED, __HIP_MEMORY_SCOPE_AGENT);
            }
        }
    }
#undef SA
#undef SB
#undef STAGE
#undef LDA
#undef LDB
#undef MMA
#undef WAIT_V
#undef WAIT_L
#undef BAR
#undef SCHED
}

__device__ __forceinline__ unsigned pk2h(float lo, float hi) { h2 v; v[0] = (hf)lo; v[1] = (hf)hi; return __builtin_bit_cast(unsigned, v); }
struct EpiIn {
    Params P; int layer;
    __device__ __forceinline__ void operator()(f4 (&acc)[2][2][4][2], int pm, int pn, int, int, int, int, char*) const {
        hf* qkv = (hf*)(P.ws + OFF_QKV);
        const float2* rope = (const float2*)(P.ws + OFF_ROPE);
        const int tq_ = opaque_tid_w(P.wv), lane = tq_ & 63, wr = tq_ >> 8, wc = (tq_ >> 6) & 3, fr = lane & 15, fq = lane >> 4;
#pragma unroll
        for (int ai = 0; ai < 2; ++ai) {
            const int fb = pn * 4 + ai * 2 + wr;
            if (fb > 40) continue;
#pragma unroll
            for (int bj = 0; bj < 2; ++bj)
#pragma unroll
                for (int n = 0; n < 2; ++n) {
                    const int t = pm * 256 + bj * 128 + wc * 32 + n * 16 + fr;
                    f4 v[4];
#pragma unroll
                    for (int m = 0; m < 4; ++m) v[m] = acc[ai][bj][m][n];
                    if (fb < 16) {
                        const int sub = fb & 7;
                        if (sub < 6) {
                            if (fb >= 8) {
                                float ss = 0.f;
#pragma unroll
                                for (int m = 0; m < 4; ++m) ss += (v[m][0] * v[m][0] + v[m][1] * v[m][1]) + (v[m][2] * v[m][2] + v[m][3] * v[m][3]);
                                ss += shflx(ss, 16, lane); ss += shflx(ss, 32, lane);
                                const float rs = 1.0f / sqrtf(ss * (1.0f / 64.0f) + 1e-6f);
                                const float* gn = (sub < 4 ? P.q_gain : P.k_gain) + layer * 64;
#pragma unroll
                                for (int m = 0; m < 4; ++m) { const f4 g = *(const f4*)(gn + m * 16 + fq * 4); v[m] = v[m] * rs * g; }
                            }
                            if (t < NL) {
#pragma unroll
                                for (int ax = 0; ax < 2; ++ax) {
                                    const int pos = ax == 0 ? (t >> 6) : (t & 63);
                                    const f4* rp4 = (const f4*)(rope + pos * 16 + fq * 4);
                                    const f4 c01 = rp4[0], c23 = rp4[1];
#pragma unroll
                                    for (int j = 0; j < 4; ++j) { float2 cs; cs.x = (j < 2 ? c01 : c23)[(j & 1) * 2]; cs.y = (j < 2 ? c01 : c23)[(j & 1) * 2 + 1]; const float u1 = v[2 * ax][j], u2 = v[2 * ax + 1][j];
                                        v[2 * ax][j] = u1 * cs.x - u2 * cs.y; v[2 * ax + 1][j] = u1 * cs.y + u2 * cs.x; }
                                }
                            }
                            const float sc = sub < 4 ? 0.125f * LOG2E : 1.0f;
                            hf* dst = qkv + (size_t)fb * HT + (size_t)t * 64 + pair_off(fq);
#pragma unroll
                            for (int mp = 0; mp < 2; ++mp) { h4 o0, o1;
#pragma unroll
                                for (int e = 0; e < 4; ++e) { o0[e] = (hf)(v[2 * mp][e] * sc); o1[e] = (hf)(v[2 * mp + 1][e] * sc); }
                                *(u4*)(dst + mp * 32) = pair16(o0, o1); }
                        } else {
                            const int tp = (t & ~12) | (((t >> 2) & 1) << 3) | (((t >> 3) & 1) << 2);
                            const int q4 = fr & 3; const bool b0 = q4 & 1, b1 = (q4 & 2) != 0;
                            const int qd = fr >> 2, qpos = ((qd & 1) << 1) | (qd >> 1);
                            __attribute__((address_space(1))) hf* dst = (__attribute__((address_space(1))) hf*)(qkv + (size_t)fb * HT + (t & ~15) + 4 * qpos + (size_t)(4 * fq + q4) * NT);
#pragma unroll
                            for (int m = 0; m < 4; ++m) {
                                const float x0 = v[m][0], x1 = v[m][1], x2 = v[m][2], x3 = v[m][3];
                                const float r01 = __builtin_bit_cast(float, __builtin_amdgcn_update_dpp(0, __builtin_bit_cast(int, b0 ? x0 : x1), 0xB1, 0xf, 0xf, false));
                                const float r23 = __builtin_bit_cast(float, __builtin_amdgcn_update_dpp(0, __builtin_bit_cast(int, b0 ? x2 : x3), 0xB1, 0xf, 0xf, false));
                                const unsigned A0 = b0 ? pk2h(r01, x1) : pk2h(x0, r01), A1 = b0 ? pk2h(r23, x3) : pk2h(x2, r23);
                                const unsigned rB = (unsigned)__builtin_amdgcn_update_dpp(0, (int)(b1 ? A0 : A1), 0x4E, 0xf, 0xf, false);
                                u2 w2; w2.x = b1 ? rB : A0; w2.y = b1 ? A1 : rB;
                                *(__attribute__((address_space(1))) u2*)(dst + (size_t)(m * 16) * NT) = w2;
                            }
                        }
                    } else if (fb < 40) {
                        hf* dst = (fb < 24 ? (hf*)(P.ws + OFF_Z) + (size_t)t * 512 + (fb - 16) * 64 : (hf*)(P.ws + OFF_XBC) + (size_t)t * 1024 + (fb - 24) * 64) + pair_off(fq);
#pragma unroll
                        for (int mp = 0; mp < 2; ++mp) { h4 o0, o1;
#pragma unroll
                            for (int e = 0; e < 4; ++e) { o0[e] = (hf)v[2 * mp][e]; o1[e] = (hf)v[2 * mp + 1][e]; }
                            *(u4*)(dst + mp * 32) = pair16(o0, o1); }
                    } else {
                        *(f4*)((float*)(P.ws + OFF_DTR) + (size_t)t * 16 + fq * 4) = v[0];
                    }
                }
        }
    }
};

struct EpiRes {
    Params P; int layer; int which_g; const float* lng; const float* lnb;
    __device__ __forceinline__ void operator()(f4 (&acc)[2][2][4][2], int pm, int pn, int wr, int wc, int fr, int fq, char*) const {
        const float2* stats = (const float2*)(P.ws + OFF_STATS);
#pragma unroll
        for (int bj = 0; bj < 2; ++bj)
#pragma unroll
            for (int n = 0; n < 2; ++n) {
                const int t = pm * 256 + bj * 128 + wc * 32 + n * 16 + fr;
                float* xr = xr_row(P, t);
                const float* xin = lng ? xr : (t < NL ? P.x + (size_t)t * D : P.ctx + (size_t)(t - NL) * D);
                float2 st = make_float2(0.f, 1.f);
                if (lng) st = stats[t];
                const float* g = modv(P, layer, t >= NL ? 1 : 0, which_g);
#pragma unroll
                for (int ai = 0; ai < 2; ++ai)
#pragma unroll
                    for (int m = 0; m < 4; ++m) {
                        const int f = pn * 256 + ai * 128 + wr * 64 + m * 16 + fq * 4;
                        f4 xv = *(const f4*)(xin + f); const f4 gv = *(const f4*)(g + f);
                        if (lng) { const f4 lg4 = *(const f4*)(lng + f), lb4 = *(const f4*)(lnb + f); xv = (xv - st.x) * st.y * lg4 + lb4; }
                        *(f4*)(xr + f) = ALPHA * xv + gv * acc[ai][bj][m][n];
                    }
            }
    }
};

struct EpiResLN {
    Params P; int layer; int which_g; const float* lng_in; const float* lnb_in;
    const float* lng; const float* lnb; int modlayer, which_sh, which_sc; int final_out; int inst;
    __device__ __forceinline__ void operator()(f4 (&acc)[2][2][4][2], int pm, int pn, int wr, int wc, int fr, int fq, char* lds) const {
        const int tid = opaque_tid(), lane = tid & 63, wid = tid >> 6;
        float2* stats = (float2*)(P.ws + OFF_STATS);
        float2* part = (float2*)lds;
        float2* mr = (float2*)(lds + 4096);
        volatile LAS unsigned* flag = (volatile LAS unsigned*)(lds + 8192);
        unsigned long long* slots = (unsigned long long*)(P.ws + OFF_XSL);
        unsigned* cnt = (unsigned*)(P.ws + OFF_CNT) + inst * 65 + pm;
        const int wr1 = wid >> 2, wc1 = wid & 3, fr1 = lane & 15, fq1 = lane >> 4;
        const float* g = modv(P, layer, pm == 64 ? 1 : 0, which_g);
        float sa[2][2], qa[2][2];
#pragma unroll
        for (int bj = 0; bj < 2; ++bj)
#pragma unroll
            for (int n = 0; n < 2; ++n) { sa[bj][n] = 0.f; qa[bj][n] = 0.f; }
#pragma unroll
        for (int ai = 0; ai < 2; ++ai)
#pragma unroll
            for (int mp = 0; mp < 2; ++mp) {
                const int fp = pn * 256 + ai * 128 + wr1 * 64 + mp * 32;
                f4 gv[2], lg4[2], lb4[2];
#pragma unroll
                for (int mm = 0; mm < 2; ++mm) { const int f = fp + mm * 16 + fq1 * 4; gv[mm] = *(const f4*)(g + f);
                    if (lng_in) { lg4[mm] = *(const f4*)(lng_in + f); lb4[mm] = *(const f4*)(lnb_in + f); } }
#pragma unroll
                for (int bj = 0; bj < 2; ++bj)
#pragma unroll
                    for (int n = 0; n < 2; ++n) {
                        const int t = pm * 256 + bj * 128 + wc1 * 32 + n * 16 + fr1;
                        float2 st = make_float2(0.f, 1.f); if (lng_in) st = stats[t];
                        h4 x16[2];
                        if (lng_in) { const u4 wv = *(const u4*)(xr16_row(P, t, inst == 3) + fp + pair_off(fq1));
                            const auto r0 = __builtin_amdgcn_permlane16_swap(wv.x, wv.z, false, false); const auto r1 = __builtin_amdgcn_permlane16_swap(wv.y, wv.w, false, false);
                            u2 a2; a2.x = r0[0]; a2.y = r1[0]; u2 b2; b2.x = r0[1]; b2.y = r1[1];
                            x16[0] = __builtin_bit_cast(h4, a2); x16[1] = __builtin_bit_cast(h4, b2); }
                        h4 v16[2];
#pragma unroll
                        for (int mm = 0; mm < 2; ++mm) {
                            const int m = 2 * mp + mm;
                            const int f = fp + mm * 16 + fq1 * 4;
                            f4 xv;
                            if (lng_in) { xv[0] = (float)x16[mm][0]; xv[1] = (float)x16[mm][1]; xv[2] = (float)x16[mm][2]; xv[3] = (float)x16[mm][3];
                                xv = (xv - st.x) * st.y * lg4[mm] + lb4[mm]; }
                            else xv = *(const f4*)((t < NL ? P.x + (size_t)t * D : P.ctx + (size_t)(t - NL) * D) + f);
                            const f4 v = ALPHA * xv + gv[mm] * acc[ai][bj][m][n];
                            acc[ai][bj][m][n] = v;
                            v16[mm][0] = (hf)v[0]; v16[mm][1] = (hf)v[1]; v16[mm][2] = (hf)v[2]; v16[mm][3] = (hf)v[3];
                            sa[bj][n] += (v[0] + v[1]) + (v[2] + v[3]); qa[bj][n] += (v[0] * v[0] + v[1] * v[1]) + (v[2] * v[2] + v[3] * v[3]);
                        }
                        if (!final_out) *(u4*)(xr16_row(P, t, inst == 2) + fp + pair_off(fq1)) = pair16(v16[0], v16[1]);
                    }
            }
#pragma unroll
        for (int bj = 0; bj < 2; ++bj)
#pragma unroll
            for (int n = 0; n < 2; ++n) {
                float s = sa[bj][n], q = qa[bj][n];
                s += shflx(s, 16, lane); s += shflx(s, 32, lane); q += shflx(q, 16, lane); q += shflx(q, 32, lane);
                if (fq1 == 0) { const int t2 = opaque_tid();
                    part[(bj * 128 + ((t2 >> 6) & 3) * 32 + n * 16 + (t2 & 15)) * 2 + (t2 >> 8)] = make_float2(s, q); }
            }
        __syncthreads();
        if (tid < 256) { const float2 a = part[tid * 2], b = part[tid * 2 + 1];
            const unsigned long long wv = ((unsigned long long)__float_as_uint(a.y + b.y) << 32) | __float_as_uint(a.x + b.x);
            __hip_atomic_store(slots + (size_t)(pm * 256 + tid) * 4 + pn, wv, __ATOMIC_RELAXED, __HIP_MEMORY_SCOPE_AGENT); }
        asm volatile("s_waitcnt vmcnt(0)" ::: "memory");
        __syncthreads();
        if (wid == 0) {
            if (lane == 0) __hip_atomic_fetch_add(cnt, 1u, __ATOMIC_RELAXED, __HIP_MEMORY_SCOPE_AGENT);
            unsigned spins = 0; bool dead = false;
            while ((unsigned)__builtin_amdgcn_readfirstlane((int)__hip_atomic_load(cnt, __ATOMIC_RELAXED, __HIP_MEMORY_SCOPE_AGENT)) < 4u) {
                __builtin_amdgcn_s_sleep(2);
                if (++spins > (1u << 22)) { dead = true; break; }
            }
            __builtin_amdgcn_fence(__ATOMIC_ACQUIRE, "agent");
            asm volatile("s_waitcnt vmcnt(0)" ::: "memory");
            if (lane == 0) flag[0] = dead ? 1u : 0u;
        }
        __syncthreads();
        if (tid < 256) { const unsigned long long* sl = slots + (size_t)(pm * 256 + tid) * 4; float s = 0.f, q = 0.f;
#pragma unroll
            for (int k = 0; k < 4; ++k) { const unsigned long long wv = __hip_atomic_load(sl + k, __ATOMIC_RELAXED, __HIP_MEMORY_SCOPE_AGENT); s += __uint_as_float((unsigned)wv); q += __uint_as_float((unsigned)(wv >> 32)); }
            const float mean = s * (1.0f / 1024.0f);
            float var = q * (1.0f / 1024.0f) - mean * mean; var = var < 0.f ? 0.f : var;
            float2 o = make_float2(mean, 1.0f / sqrtf(var + 1e-5f));
            if (flag[0]) o = make_float2(__builtin_nanf(""), __builtin_nanf(""));
            mr[tid] = o;
            if (pn == 0) stats[pm * 256 + tid] = o; }
        __syncthreads();
        hf* H = (hf*)(P.ws + OFF_H16);
        const int t4 = opaque_tid(), wr4 = t4 >> 8, wc4 = (t4 >> 6) & 3, fr4 = t4 & 15, fq4 = (t4 >> 4) & 3;
        const float* sh = modv(P, modlayer, pm == 64 ? 1 : 0, which_sh); const float* sc = modv(P, modlayer, pm == 64 ? 1 : 0, which_sc);
#pragma unroll
        for (int ai = 0; ai < 2; ++ai)
#pragma unroll
            for (int mp = 0; mp < 2; ++mp) {
                const int fp = pn * 256 + ai * 128 + wr4 * 64 + mp * 32;
                f4 lg4[2], lb4[2], sc4[2], sh4[2];
#pragma unroll
                for (int mm = 0; mm < 2; ++mm) { const int f = fp + mm * 16 + fq4 * 4; lg4[mm] = *(const f4*)(lng + f); lb4[mm] = *(const f4*)(lnb + f);
                    if (!final_out) { sc4[mm] = *(const f4*)(sc + f); sh4[mm] = *(const f4*)(sh + f); } }
#pragma unroll
                for (int bj = 0; bj < 2; ++bj)
#pragma unroll
                    for (int n = 0; n < 2; ++n) {
                        const int tl = bj * 128 + wc4 * 32 + n * 16 + fr4, t = pm * 256 + tl;
                        const float2 st = mr[tl];
                        h4 o16[2];
#pragma unroll
                        for (int mm = 0; mm < 2; ++mm) {
                            const int m = 2 * mp + mm;
                            const f4 xn = (acc[ai][bj][m][n] - st.x) * st.y * lg4[mm] + lb4[mm];
                            if (final_out) { if (t < NL) *(f4*)(P.out + (size_t)t * D + fp + mm * 16 + fq4 * 4) = xn; }
                            else { const f4 y = xn * (1.0f + sc4[mm]) + sh4[mm];
                                o16[mm][0] = (hf)y[0]; o16[mm][1] = (hf)y[1]; o16[mm][2] = (hf)y[2]; o16[mm][3] = (hf)y[3]; }
                        }
                        if (!final_out) *(u4*)(H + (size_t)t * D + fp + pair_off(fq4)) = pair16(o16[0], o16[1]);
                    }
            }
        __syncthreads();
    }
};

struct EpiGU {
    Params P;
    __device__ __forceinline__ void operator()(f4 (&acc)[2][2][4][2], int pm, int pn, int, int, int, int, char*) const {
        hf* G = (hf*)(P.ws + OFF_G16);
        const int tq_ = opaque_tid_w(P.wv), wr = tq_ >> 8, wc = (tq_ >> 6) & 3, fr = tq_ & 15, fq = (tq_ >> 4) & 3;
        const int offe = pair_off(fq);
#pragma unroll
        for (int bj = 0; bj < 2; ++bj)
#pragma unroll
            for (int n = 0; n < 2; ++n) {
                const int t = pm * 256 + bj * 128 + wc * 32 + n * 16 + fr;
#pragma unroll
                for (int ai = 0; ai < 2; ++ai) {
                    u2 pk[2];
#pragma unroll
                    for (int mm = 0; mm < 2; ++mm) {
                        const f4 gt = acc[ai][bj][mm][n], up = acc[ai][bj][mm + 2][n];
                        h4 o;
#pragma unroll
                        for (int e = 0; e < 4; ++e) o[e] = (hf)(silu_f(gt[e]) * up[e]);
                        pk[mm] = __builtin_bit_cast(u2, o);
                    }
                    const auto r0 = __builtin_amdgcn_permlane16_swap(pk[0].x, pk[1].x, false, false);
                    const auto r1 = __builtin_amdgcn_permlane16_swap(pk[0].y, pk[1].y, false, false);
                    u4 w4; w4.x = r0[0]; w4.y = r1[0]; w4.z = r0[1]; w4.w = r1[1];
                    *(u4*)(G + (size_t)t * DFF + pn * 128 + (ai * 2 + wr) * 32 + offe) = w4;
                }
            }
    }
};

__device__ __forceinline__ void phase_prep(const Params& P, int layer, char* lds) {
    const int tid = opaque_tid();
    hf* raw = (hf*)lds;
    hf* outt = (hf*)(lds + 32768);
    const hf* XBC = (const hf*)(P.ws + OFF_XBC);
    hf* U = (hf*)(P.ws + OFF_U); hf* UT = (hf*)(P.ws + OFF_UT);
    u4 pre[3];
#define PREP_FETCH(uu) do { const int tb_ = (uu) >> 3, cb_ = (uu) & 7, t0_ = tb_ * 64, c0_ = cb_ * 128; const int s0_ = t0_ < NL ? 0 : NL, s1_ = t0_ < NL ? NL : NT; \
    _Pragma("unroll") for (int i_ = 0; i_ < 3; ++i_) { const int e_ = tid + i_ * 512, r_ = e_ >> 4, ch_ = e_ & 15, t_ = t0_ - 2 + r_; u4 v_ = {0u, 0u, 0u, 0u}; \
        if (e_ < 68 * 16 && t_ >= s0_ && t_ < s1_) v_ = *(const u4*)(XBC + (size_t)t_ * 1024 + c0_ + ch_ * 8); pre[i_] = v_; } } while (0)
    if (blockIdx.x < 260 * 8) PREP_FETCH(blockIdx.x);
    float wv[5] = {0.f, 0.f, 0.f, 0.f, 0.f}, bb = 0.f; int cbw = -1;
    for (int u = blockIdx.x; u < 260 * 8; u += gridDim.x) {
        const int tb = u >> 3, cb = u & 7, t0 = tb * 64, c0 = cb * 128;
#pragma unroll
        for (int i = 0; i < 3; ++i) { const int e = tid + i * 512; if (e < 68 * 16) *(u4*)(raw + (e >> 4) * 128 + (e & 15) * 8) = pre[i]; }
        __syncthreads();
        if (u + (int)gridDim.x < 260 * 8) PREP_FETCH(u + gridDim.x);
        {
            const int ch = tid & 127, tq = tid >> 7, gc = c0 + ch;
            if (cb != cbw) {
                cbw = cb;
#pragma unroll
                for (int k = 0; k < 5; ++k) wv[k] = P.conv_w[(size_t)layer * 5 * 1024 + k * 1024 + gc];
                bb = P.conv_b[layer * 1024 + gc];
            }
            float xin[20];
#pragma unroll
            for (int i = 0; i < 20; ++i) xin[i] = (float)raw[(tq * 16 + i) * 128 + ch];
            h8 o0, o1;
#pragma unroll
            for (int i = 0; i < 16; ++i) {
                float s = bb;
#pragma unroll
                for (int k = 0; k < 5; ++k) s += wv[k] * xin[i + k];
                const hf ov = (hf)silu_f(s);
                outt[(tq * 16 + i) * 128 + ch] = ov;
                if (i < 8) o0[i] = ov; else o1[i - 8] = ov;
            }
            if (gc < 768) { hf* d = UT + (size_t)gc * NT + t0 + tq * 16; *(h8*)d = o0; *(h8*)(d + 8) = o1; }
        }
        __syncthreads();
        for (int e = tid; e < 64 * 16; e += 512) { const int r = e >> 4, ch = e & 15; *(u4*)(U + (size_t)(t0 + r) * 1024 + c0 + ch * 8) = *(const u4*)(outt + r * 128 + ch * 8); }
        if (cb == 0) {
            const float* dr = (const float*)(P.ws + OFF_DTR); float* dp = (float*)(P.ws + OFF_DTP);
            for (int e = tid; e < 1024; e += 512) { const int j = e & 15; const float xv = dr[(size_t)t0 * 16 + e] + P.dt_bias[layer * 16 + j]; dp[(size_t)t0 * 16 + e] = xv > 20.f ? xv : log1pf(expf(xv)); }
        }
    }
#undef PREP_FETCH
    __syncthreads();
}

template <int NROWS>
__device__ __forceinline__ void stage_rows16(const hf* src, size_t ld, char* dst, int tid) {
#pragma unroll
    for (int i = 0; i < NROWS * 16 / 512; ++i) { const int e = tid + i * 512, r = e >> 4, c = e & 15;
        *(u4*)(dst + r * 256 + ((c ^ (r & 15)) << 4)) = *(const u4*)(src + (size_t)r * ld + c * 8); }
}
template <int NROWS>
__device__ __forceinline__ void stage_rows8(const hf* src, size_t ld, char* dst, int tid) {
    typedef unsigned u2 __attribute__((ext_vector_type(2)));
#pragma unroll
    for (int i = 0; i < NROWS * 16 / 512; ++i) { const int e = tid + i * 512, r = e >> 4, c = e & 15;
        const u4 v = *(const u4*)(src + (size_t)r * ld + c * 8);
        u2 lo; lo.x = v.x; lo.y = v.y; u2 hi; hi.x = v.z; hi.y = v.w;
        *(u2*)(dst + r * 256 + (((2 * c) ^ (r & 31)) << 3)) = lo; *(u2*)(dst + r * 256 + (((2 * c + 1) ^ (r & 31)) << 3)) = hi; }
}

__device__ __forceinline__ float wave_incl_scan(float v, int lane) {
#pragma unroll
    for (int d = 1; d < 64; d <<= 1) { const float t = __builtin_bit_cast(float, __builtin_amdgcn_ds_bpermute((lane - d) << 2, __builtin_bit_cast(int, v))); if (lane >= d) v += t; }
    return v;
}

__device__ __forceinline__ void phase_ssd_states(const Params& P, int layer, char* lds) {
    const int tid = opaque_tid(), lane = tid & 63, w = tid >> 6, hh = w & 3, dir = w >> 2, r31 = lane & 31, h = lane >> 5;
    float* wtab = (float*)lds + w * 128;
    char* XT = lds + 16384;
    char* BT = lds + 16384 + 65536;
    const hf* UT = (const hf*)(P.ws + OFF_UT); const float* DTP = (const float*)(P.ws + OFF_DTP);
    hf* CS = (hf*)(P.ws + OFF_CS); float* DEC = (float*)(P.ws + OFF_DEC);
    const int sw16 = r31 & 15;
    u4 pre[8]; float pdt0 = 0.f, pdt1 = 0.f;
#define ST_FETCH(uu) do { const int cid_ = (uu) >> 2, g_ = ((uu) >> 1) & 1, ph_ = (uu) & 1, t0_ = cid_ * 128; \
        _Pragma("unroll") for (int i_ = 0; i_ < 4; ++i_) { const int e_ = tid + i_ * 512, r_ = e_ >> 4, c_ = e_ & 15; \
            pre[i_] = *(const u4*)(UT + (size_t)(g_ * 256 + (r_ >> 5) * 64 + ph_ * 32 + (r_ & 31)) * NT + t0_ + c_ * 8); \
            pre[4 + i_] = *(const u4*)(UT + (size_t)(512 + g_ * 128 + r_) * NT + t0_ + c_ * 8); } \
        pdt0 = DTP[(size_t)(t0_ + 2 * lane) * 16 + dir * 8 + g_ * 4 + hh]; pdt1 = DTP[(size_t)(t0_ + 2 * lane + 1) * 16 + dir * 8 + g_ * 4 + hh]; } while (0)
    if ((int)blockIdx.x < NCHK * 4) ST_FETCH((int)blockIdx.x);
    for (int u = blockIdx.x; u < NCHK * 4; u += gridDim.x) {
        const int cid = u >> 2, g = (u >> 1) & 1, ph = u & 1, t0 = cid * 128, head = g * 4 + hh;
#pragma unroll
        for (int i = 0; i < 4; ++i) { const int e = tid + i * 512, r = e >> 4, c = e & 15;
            *(u4*)(XT + r * 256 + ((c ^ (r & 15)) << 4)) = pre[i]; *(u4*)(BT + r * 256 + ((c ^ (r & 15)) << 4)) = pre[4 + i]; }
        const float a = -expf(P.a_log[layer * 16 + dir * 8 + head]);
        const float dt0 = pdt0, dt1 = pdt1;
        if (u + (int)gridDim.x < NCHK * 4) ST_FETCH(u + (int)gridDim.x);
        const float d0 = dt0 * a, d1 = dt1 * a;
        const float inc1 = wave_incl_scan(d0 + d1, lane), inc0 = inc1 - d1;
        const float total = rdlane(inc1, 63);
        float w0, w1;
        if (dir == 0) { w0 = expf(total - inc0) * dt0; w1 = expf(total - inc1) * dt1; }
        else { w0 = expf(inc0 - d0) * dt0; w1 = expf(inc1 - d1) * dt1; }
        wtab[2 * lane] = w0; wtab[2 * lane + 1] = w1;
        if (lane == 0) DEC[(cid * 2 + dir) * 8 + head] = expf(total);
        __syncthreads();
        fx16 S[4];
#pragma unroll
        for (int b = 0; b < 4; ++b) S[b] = zero16();
#pragma unroll 4
        for (int kk = 0; kk < 8; ++kk) {
            const f4 wa = *(const f4*)(wtab + kk * 16 + 8 * h), wb = *(const f4*)(wtab + kk * 16 + 8 * h + 4);
            h8 w8; w8[0] = (hf)wa[0]; w8[1] = (hf)wa[1]; w8[2] = (hf)wa[2]; w8[3] = (hf)wa[3]; w8[4] = (hf)wb[0]; w8[5] = (hf)wb[1]; w8[6] = (hf)wb[2]; w8[7] = (hf)wb[3];
            const int co = ((2 * kk + h) ^ sw16) << 4;
            h8 bf[4];
            const h8 xf = *(const h8*)(XT + (hh * 32 + r31) * 256 + co) * w8;
#pragma unroll
            for (int nt = 0; nt < 4; ++nt) bf[nt] = *(const h8*)(BT + (nt * 32 + r31) * 256 + co);
#pragma unroll
            for (int nt = 0; nt < 4; ++nt) S[nt] = mfma16(bf[nt], xf, S[nt]);
        }
        hf* cs = CS + (size_t)((cid * 2 + dir) * 8 + head) * 8192 + (size_t)(ph * 32 + r31) * 128 + (h ? 8 : 0);
#pragma unroll
        for (int nt = 0; nt < 4; ++nt)
#pragma unroll
            for (int gp = 0; gp < 2; ++gp) {
                h4 a4, b4;
#pragma unroll
                for (int e = 0; e < 4; ++e) { a4[e] = (hf)S[nt][8 * gp + e]; b4[e] = (hf)S[nt][8 * gp + 4 + e]; }
                const u2 a = __builtin_bit_cast(u2, a4), b = __builtin_bit_cast(u2, b4);
                const auto r0 = __builtin_amdgcn_permlane32_swap(a.x, b.x, false, false);
                const auto r1 = __builtin_amdgcn_permlane32_swap(a.y, b.y, false, false);
                u4 w4; w4.x = r0[0]; w4.y = r1[0]; w4.z = r0[1]; w4.w = r1[1];
                *(u4*)(cs + nt * 32 + gp * 16) = w4;
            }
        __syncthreads();
    }
#undef ST_FETCH
}

__device__ __forceinline__ void phase_ssd_scan(const Params& P) {
    const hf* CS = (const hf*)(P.ws + OFF_CS); hf* HS = (hf*)(P.ws + OFF_HS); const float* DEC = (const float*)(P.ws + OFF_DEC);
    for (int e = blockIdx.x * 512 + opaque_tid(); e < 131072; e += gridDim.x * 512) {
        const int dir = e >> 16, head = (e >> 13) & 7, rest = e & 8191;
        float st = 0.f;
#pragma unroll 1
        for (int b0 = 0; b0 < NCHK; b0 += 26) {
            float cs[26], dc[26];
#pragma unroll
            for (int i = 0; i < 26; ++i) {
                const int step = b0 + i, cid = dir ? 129 - step : (step < 2 ? 128 + step : step - 2);
                cs[i] = (float)CS[(size_t)((cid * 2 + dir) * 8 + head) * 8192 + rest];
                dc[i] = DEC[(cid * 2 + dir) * 8 + head];
            }
#pragma unroll
            for (int i = 0; i < 26; ++i) {
                const int step = b0 + i, cid = dir ? 129 - step : (step < 2 ? 128 + step : step - 2);
                HS[(size_t)((cid * 2 + dir) * 8 + head) * 8192 + rest] = (hf)st;
                st = st * dc[i] + cs[i];
            }
        }
    }
}

struct AttnJob { const hf* Q0; const hf* Q1; const hf* K; const hf* VT; int qrow0; int ta0, na, tb0, nb; int use_sink; float sink0, sink1; int outcol; };

template <bool NOMAX>
__device__ __forceinline__ void attn_unit(const Params& P, const AttnJob& J, char* lds) {
    const int tid = opaque_tid(), lane = tid & 63, w = tid >> 6, r31 = lane & 31, h = lane >> 5, hsel = w >> 2;
    const int qbase = J.qrow0 + (w & 3) * 32;
    const int fsw = (r31 >> 1) & 7;
    const hf* Qp = (hsel ? J.Q1 : J.Q0) + (size_t)(qbase + r31) * 64 + h * 8;
    h8 qf[4];
#pragma unroll
    for (int kk = 0; kk < 4; ++kk) qf[kk] = *(const h8*)(Qp + kk * 16);
    asm volatile("" : "+v"(qf[0]), "+v"(qf[1]), "+v"(qf[2]), "+v"(qf[3]));
    fx16 o[2]; o[0] = zero16(); o[1] = zero16();
    float m = -1e30f, l = 0.f;
    fx16 ol = zero16();
    h8 ones; { const hf ov = (hf)((NOMAX && r31 == 0) ? 1.0f : 0.0f);
#pragma unroll
      for (int e = 0; e < 8; ++e) ones[e] = ov; }
    const int srow = tid >> 3, sc = tid & 7;
    const int kst = srow * 128 + ((sc ^ ((srow >> 1) & 7)) << 4);
    const int npairs = (J.na + J.nb) >> 1;
    u4 kr[2], vr[2];
#define TILE_OF(j) ((j) < J.na ? J.ta0 + (j) : J.tb0 + ((j) - J.na))
#pragma unroll
    for (int e = 0; e < 2; ++e) { const int tile = TILE_OF(e);
        kr[e] = *(const u4*)(J.K + (size_t)(tile * 64 + srow) * 64 + sc * 8); vr[e] = *(const u4*)(J.VT + (size_t)srow * NT + tile * 64 + sc * 8); }
#pragma unroll
    for (int e = 0; e < 2; ++e) { *(u4*)(lds + e * 16384 + kst) = kr[e]; *(u4*)(lds + e * 16384 + 8192 + kst) = vr[e]; }
    __syncthreads();
#pragma unroll 1
    for (int jp = 0; jp < npairs; ++jp) {
        const int cur = jp & 1;
        const bool more = jp + 1 < npairs;
        if (more) {
#pragma unroll
            for (int e = 0; e < 2; ++e) { const int tn = TILE_OF(2 * jp + 2 + e);
                kr[e] = *(const u4*)(J.K + (size_t)(tn * 64 + srow) * 64 + sc * 8); vr[e] = *(const u4*)(J.VT + (size_t)srow * NT + tn * 64 + sc * 8); }
        }
#pragma unroll
        for (int e2 = 0; e2 < 2; ++e2) {
        const int j = 2 * jp + e2;
        const int tile = TILE_OF(j);
        __builtin_amdgcn_sched_barrier(0);
        const char* lk = lds + cur * 32768 + e2 * 16384; const char* lv = lk + 8192;
        h8 kfr[2][4], vfr[4][2];
#pragma unroll
        for (int kk = 0; kk < 4; ++kk) {
            const int co = ((kk * 2 + h) ^ fsw) << 4;
#pragma unroll
            for (int kt = 0; kt < 2; ++kt) kfr[kt][kk] = *(const h8*)(lk + (kt * 32 + r31) * 128 + co);
        }
#pragma unroll
        for (int s4 = 0; s4 < 4; ++s4)
#pragma unroll
            for (int dt = 0; dt < 2; ++dt) {
                vfr[s4][dt] = *(const LAS h8*)((const LAS char*)lv + (dt * 32 + r31) * 128 + (((2 * s4 + h) ^ fsw) << 4));
            }
        __builtin_amdgcn_sched_barrier(0);
        fx16 s[2]; s[0] = zero16(); s[1] = zero16();
#pragma unroll
        for (int kk = 0; kk < 4; ++kk)
#pragma unroll
            for (int kt = 0; kt < 2; ++kt) s[kt] = mfma16(kfr[kt][kk], qf[kk], s[kt]);
        if (!NOMAX && j >= J.na) {
            const int qpos = qbase + r31;
#pragma unroll
            for (int kt = 0; kt < 2; ++kt)
#pragma unroll
                for (int i = 0; i < 16; ++i) { const int kpos = tile * 64 + kt * 32 + (i & 3) + 8 * (i >> 2) + 4 * h; const int dd = qpos - kpos; if (dd > 128 || dd < -128) s[kt][i] = -1e30f; }
        }
        float rs4[4] = {0.f, 0.f, 0.f, 0.f};
        if (NOMAX) {
#pragma unroll
            for (int kt = 0; kt < 2; ++kt)
#pragma unroll
                for (int i = 0; i < 16; ++i) s[kt][i] = __builtin_amdgcn_exp2f(s[kt][i]);
        } else {
            float mx = s[0][0];
#pragma unroll
            for (int kt = 0; kt < 2; ++kt)
#pragma unroll
                for (int i = 0; i < 16; ++i) mx = fmaxf(mx, s[kt][i]);
            mx = fmaxf(mx, shflx(mx, 32, lane));
            const float mn = fmaxf(m, mx);
            const float alpha = __builtin_amdgcn_exp2f(m - mn);
            m = mn;
#pragma unroll
            for (int kt = 0; kt < 2; ++kt)
#pragma unroll
                for (int i = 0; i < 16; ++i) { const float p = __builtin_amdgcn_exp2f(s[kt][i] - mn); s[kt][i] = p; rs4[i & 3] += p; }
            l = l * alpha + ((rs4[0] + rs4[1]) + (rs4[2] + rs4[3]));
            o[0] *= alpha; o[1] *= alpha;
        }
#pragma unroll
        for (int s4 = 0; s4 < 4; ++s4) {
            h8 pf;
#pragma unroll
            for (int e = 0; e < 8; ++e) pf[e] = (hf)s[s4 >> 1][8 * (s4 & 1) + e];
#pragma unroll
            for (int dt = 0; dt < 2; ++dt) o[dt] = mfma16(vfr[s4][dt], pf, o[dt]);
            if (NOMAX) ol = mfma16(ones, pf, ol);
        }
        }
        if (more) { char* lb = lds + (cur ^ 1) * 32768;
#pragma unroll
            for (int e = 0; e < 2; ++e) { *(u4*)(lb + e * 16384 + kst) = kr[e]; *(u4*)(lb + e * 16384 + 8192 + kst) = vr[e]; } }
        __syncthreads();
    }
#undef TILE_OF
    if (NOMAX) l = ol[0];
    l += shflx(l, 32, lane);
    if (!NOMAX && J.use_sink) l += __builtin_amdgcn_exp2f((hsel ? J.sink1 : J.sink0) * LOG2E - m);
    const float inv = 1.0f / l;
    hf* dst = (hf*)(P.ws + OFF_MIX) + (size_t)(qbase + r31) * 1024 + J.outcol + hsel * 64;
#pragma unroll
    for (int dt = 0; dt < 2; ++dt)
#pragma unroll
        for (int rg = 0; rg < 4; ++rg) { h4 ov;
#pragma unroll
            for (int e = 0; e < 4; ++e) ov[e] = (hf)(o[dt][rg * 4 + e] * inv);
            *(h4*)(dst + dt * 32 + rg * 8 + 4 * h) = ov; }
}

__device__ __forceinline__ fx16 neg4_16() { fx16 z; for (int i = 0; i < 16; ++i) z[i] = -4.0f; return z; }
__device__ __forceinline__ void attn_unit_pin(const Params& P, const AttnJob& J, char* lds) {
    const int tid = opaque_tid(), lane = tid & 63, w = tid >> 6, r31 = lane & 31, h = lane >> 5, kg = w >> 2;
    const int qbase = J.qrow0 + (w & 3) * 32;
    const int fsw = (r31 >> 1) & 7;
    h8 qf[2][4];
#pragma unroll
    for (int cb = 0; cb < 2; ++cb) { const hf* Qp = (cb ? J.Q1 : J.Q0) + (size_t)(qbase + r31) * 64 + h * 8;
#pragma unroll
        for (int kk = 0; kk < 4; ++kk) qf[cb][kk] = *(const h8*)(Qp + kk * 16); }
    asm volatile("" : "+v"(qf[0][0]), "+v"(qf[0][1]), "+v"(qf[0][2]), "+v"(qf[0][3]), "+v"(qf[1][0]), "+v"(qf[1][1]), "+v"(qf[1][2]), "+v"(qf[1][3]));
    fx16 o[4]; o[0] = zero16(); o[1] = zero16(); o[2] = zero16(); o[3] = zero16();
    float l0 = 0.f, l1 = 0.f;
    const int srow = tid >> 3, sc = tid & 7;
    const int kst = srow * 128 + ((sc ^ ((srow >> 1) & 7)) << 4);
    const int T = J.na;
    const char* kdp = (const char*)J.K + (size_t)J.ta0 * 8192 + kst;
    const int wb = __builtin_amdgcn_readfirstlane(w) * 1024;
    const char* vdp = (const char*)J.VT + (size_t)J.ta0 * 128 + (size_t)srow * (NT * 2) + ((sc ^ ((srow >> 1) & 7)) << 4);
#define PN_KDMA(t, S) __builtin_amdgcn_global_load_lds((const unsigned*)(kdp + (size_t)(t) * 8192), (LAS unsigned*)(lds + (S) * 16384 + wb), 16, 0, 0)
#define PN_VDMA(t, S) __builtin_amdgcn_global_load_lds((const unsigned*)(vdp + (size_t)(t) * 128), (LAS unsigned*)(lds + (S) * 16384 + 8192 + wb), 16, 0, 0)
    int ko[4], vo[2];
#pragma unroll
    for (int kk = 0; kk < 4; ++kk) ko[kk] = (kg * 32 + r31) * 128 + (((2 * kk + h) ^ fsw) << 4);
#pragma unroll
    for (int ks = 0; ks < 2; ++ks) vo[ks] = 8192 + r31 * 128 + (((2 * (2 * kg + ks) + h) ^ fsw) << 4);
    const LAS char* L3 = (const LAS char*)lds;
#define PN_KRD(j, S) do { kf[j] = *(const LAS h8*)(L3 + ko[j] + (S) * 16384); } while (0)
#define PN_VRD(v, S) do { vfr[v] = *(const LAS h8*)(L3 + vo[(v) >> 1] + (S) * 16384 + ((v) & 1) * 4096); } while (0)
#define PN_SB __builtin_amdgcn_sched_barrier(0)
#define PN_PIN(x) asm volatile("" : "+v"(x))
#define PN_BAR do { asm volatile("s_waitcnt lgkmcnt(0)" ::: "memory"); __builtin_amdgcn_s_barrier(); asm volatile("" ::: "memory"); } while (0)
#define PN_BAR8 do { asm volatile("s_waitcnt vmcnt(2)" ::: "memory"); __builtin_amdgcn_s_barrier(); asm volatile("" ::: "memory"); } while (0)
    PN_KDMA(0, 0); PN_KDMA(1, 1); PN_KDMA(2, 2); PN_VDMA(0, 0); PN_VDMA(1, 1);
    asm volatile("s_waitcnt vmcnt(0)" ::: "memory");
    PN_BAR;
    h8 kf[4], vfr[4]; unsigned pwe[16];
#pragma unroll
    for (int j = 0; j < 4; ++j) PN_KRD(j, 0);
    fx16 a0, a1, b0, b1;
    a0 = neg4_16(); a1 = neg4_16();
#pragma unroll
    for (int kk = 0; kk < 4; ++kk) { a0 = mfma16(kf[kk], qf[0][kk], a0); a1 = mfma16(kf[kk], qf[1][kk], a1); }
    PN_KDMA(3, 3); PN_VDMA(2, 2);
#pragma unroll
    for (int i = 0; i < 16; ++i) { a0[i] = __builtin_amdgcn_exp2f(a0[i]); if (i < 10) a1[i] = __builtin_amdgcn_exp2f(a1[i]); }
#pragma unroll
    for (int j = 0; j < 4; ++j) PN_KRD(j, 1);
    PN_BAR;
#define PN_PF(P0, P1, idx) ((idx) < 16 ? P0[(idx) & 15] : P1[(idx) & 15])
#define PN_PAIR(j) (__builtin_bit_cast(h2, (unsigned)pwe[2 * (j)]) + __builtin_bit_cast(h2, (unsigned)pwe[2 * (j) + 1]))
#define PN_GAPA(i, C0, C1, P0, P1, SP) do { if ((i) < 4) { PN_VRD(i, SP); } PN_SB; \
        if ((i) & 1) C1 = mfma16(kf[(i) >> 1], qf[1][(i) >> 1], C1); else C0 = mfma16(kf[(i) >> 1], qf[0][(i) >> 1], C0); PN_SB; \
        if ((i) < 6) { P1[10 + (i)] = __builtin_amdgcn_exp2f(P1[10 + (i)]); PN_PIN(P1); PN_SB; } \
          \
        h2 ps_; if ((i) > 0) { ps_ = PN_PAIR((i) - 1); PN_SB; } \
        pwe[2 * (i)] = pk2h(PN_PF(P0, P1, 4 * (i)), PN_PF(P0, P1, 4 * (i) + 1)); PN_PIN(pwe[2 * (i)]); PN_SB; \
        if ((i) == 1) hsA = ps_; else if ((i) > 1 && (i) <= 4) hsA = hsA + ps_; else if ((i) == 5) hsB = ps_; else if ((i) > 5) hsB = hsB + ps_; if ((i) > 0) { PN_SB; } \
        pwe[2 * (i) + 1] = pk2h(PN_PF(P0, P1, 4 * (i) + 2), PN_PF(P0, P1, 4 * (i) + 3)); PN_PIN(pwe[2 * (i) + 1]); PN_SB; } while (0)
#define PN_E1(C0, C1, idx) do { if ((idx) < 16) C0[(idx) & 15] = __builtin_amdgcn_exp2f(C0[(idx) & 15]); else C1[(idx) & 15] = __builtin_amdgcn_exp2f(C1[(idx) & 15]); } while (0)
#define PN_EXP4(C0, C1, i) do { if ((i) < 6) { PN_E1(C0, C1, 3 * (i)); PN_E1(C0, C1, 3 * (i) + 1); PN_E1(C0, C1, 3 * (i) + 2); } \
        else { PN_E1(C0, C1, 18 + 4 * ((i) - 6)); PN_E1(C0, C1, 19 + 4 * ((i) - 6)); PN_E1(C0, C1, 20 + 4 * ((i) - 6)); PN_E1(C0, C1, 21 + 4 * ((i) - 6)); } PN_PIN(C0); PN_PIN(C1); } while (0)
#define PN_PWV(s) ({ u4 q_; q_.x = pwe[4 * (s)]; q_.y = pwe[4 * (s) + 1]; q_.z = pwe[4 * (s) + 2]; q_.w = pwe[4 * (s) + 3]; __builtin_bit_cast(h8, q_); })
#define PN_PV(i) o[((i) >> 2) * 2 + ((i) & 1)] = mfma16(vfr[(((i) >> 1) & 1) * 2 + ((i) & 1)], PN_PWV((i) >> 1), o[((i) >> 2) * 2 + ((i) & 1)])
#define PN_GAPB(i, C0, C1) do { PN_PV(i); PN_EXP4(C0, C1, i); PN_SB; } while (0)
#define PN_STEP(C0, C1, P0, P1, t, S) do { PN_SB; \
        h2 hsA, hsB; C0 = neg4_16(); C1 = neg4_16(); \
        PN_GAPA(0, C0, C1, P0, P1, ((S) + 3) & 3); PN_GAPA(1, C0, C1, P0, P1, ((S) + 3) & 3); PN_GAPA(2, C0, C1, P0, P1, ((S) + 3) & 3); PN_GAPA(3, C0, C1, P0, P1, ((S) + 3) & 3); \
        PN_GAPA(4, C0, C1, P0, P1, ((S) + 3) & 3); PN_GAPA(5, C0, C1, P0, P1, ((S) + 3) & 3); PN_GAPA(6, C0, C1, P0, P1, ((S) + 3) & 3); PN_GAPA(7, C0, C1, P0, P1, ((S) + 3) & 3); \
        { const h2 ps7_ = PN_PAIR(7); hsB = hsB + ps7_; PN_SB; } l0 += (float)hsA[0] + (float)hsA[1]; l1 += (float)hsB[0] + (float)hsB[1]; \
        PN_KDMA((t) + 3, ((S) + 3) & 3); PN_VDMA((t) + 2, ((S) + 2) & 3); PN_SB; \
        PN_GAPB(0, C0, C1); PN_GAPB(1, C0, C1); \
        PN_KRD(0, ((S) + 1) & 3); PN_SB; PN_GAPB(2, C0, C1); PN_KRD(1, ((S) + 1) & 3); PN_SB; PN_GAPB(3, C0, C1); \
        PN_KRD(2, ((S) + 1) & 3); PN_SB; PN_GAPB(4, C0, C1); PN_KRD(3, ((S) + 1) & 3); PN_SB; PN_GAPB(5, C0, C1); \
        PN_GAPB(6, C0, C1); PN_GAPB(7, C0, C1); \
        PN_BAR8; } while (0)
    int t = 1;
#pragma unroll 1
    for (; t + 3 < T; t += 4) { PN_STEP(b0, b1, a0, a1, t, 1); PN_STEP(a0, a1, b0, b1, t + 1, 2); PN_STEP(b0, b1, a0, a1, t + 2, 3); PN_STEP(a0, a1, b0, b1, t + 3, 0); }
    PN_STEP(b0, b1, a0, a1, t, 1); PN_STEP(a0, a1, b0, b1, t + 1, 2); PN_STEP(b0, b1, a0, a1, t + 2, 3);
    {
#pragma unroll
        for (int i = 10; i < 16; ++i) b1[i] = __builtin_amdgcn_exp2f(b1[i]);
        float s0 = 0.f, s1 = 0.f;
#pragma unroll
        for (int i = 0; i < 16; ++i) { s0 += b0[i]; s1 += b1[i]; }
        l0 += s0; l1 += s1;
#pragma unroll
        for (int s4 = 0; s4 < 4; ++s4)
#pragma unroll
            for (int e = 0; e < 4; ++e) pwe[4 * s4 + e] = (s4 < 2) ? pk2h(b0[8 * s4 + 2 * e], b0[8 * s4 + 2 * e + 1]) : pk2h(b1[8 * (s4 - 2) + 2 * e], b1[8 * (s4 - 2) + 2 * e + 1]);
#pragma unroll
        for (int v = 0; v < 4; ++v) PN_VRD(v, 3);
        PN_PV(0); PN_PV(1); PN_PV(2); PN_PV(3); PN_PV(4); PN_PV(5); PN_PV(6); PN_PV(7);
    }
    asm volatile("s_waitcnt vmcnt(0)" ::: "memory");
    PN_BAR;
#undef PN_KDMA
#undef PN_VDMA
#undef PN_KRD
#undef PN_VRD
#undef PN_SB
#undef PN_PIN
#undef PN_BAR
#undef PN_BAR8
#undef PN_PF
#undef PN_GAPA
#undef PN_EXP4
#undef PN_E1
#undef PN_GAPB
#undef PN_PV
#undef PN_PAIR
#undef PN_PWV
#undef PN_STEP
    l0 += shflx(l0, 32, lane); l1 += shflx(l1, 32, lane);
    float* mg = (float*)lds;
    float* mgw = mg + (size_t)((w & 3) * 66) * 64 + lane;
    if (kg == 1) {
#pragma unroll
        for (int j = 0; j < 4; ++j)
#pragma unroll
            for (int i = 0; i < 16; ++i) mgw[(j * 16 + i) * 64] = o[j][i];
        mgw[64 * 64] = l0; mgw[65 * 64] = l1;
    }
    __syncthreads();
    if (kg == 0) {
#pragma unroll
        for (int j = 0; j < 4; ++j)
#pragma unroll
            for (int i = 0; i < 16; ++i) o[j][i] += mgw[(j * 16 + i) * 64];
        l0 += mgw[64 * 64]; l1 += mgw[65 * 64];
#pragma unroll
        for (int cb = 0; cb < 2; ++cb) {
            const float inv = 1.0f / (cb ? l1 : l0);
            hf* dst = (hf*)(P.ws + OFF_MIX) + (size_t)(qbase + r31) * 1024 + J.outcol + cb * 64;
#pragma unroll
            for (int dt = 0; dt < 2; ++dt)
#pragma unroll
                for (int rg = 0; rg < 4; ++rg) { h4 ov;
#pragma unroll
                    for (int e = 0; e < 4; ++e) ov[e] = (hf)(o[cb * 2 + dt][rg * 4 + e] * inv);
                    *(h4*)(dst + dt * 32 + rg * 8 + 4 * h) = ov; }
        }
    }
    __syncthreads();
}

__device__ __forceinline__ void ssd_out_unit(const Params& P, int layer, int cid, int g, int lh0, int lh1, char* lds) {
    const int tid = opaque_tid(), lane = tid & 63, w = tid >> 6, hh = w & 3, lt = w >> 2, r31 = lane & 31, h = lane >> 5;
    const int t0 = cid * 128, head = g * 4 + hh;
    float* tab = (float*)lds;
    float* sstab = (float*)(lds + 8192);
    char* Bm = lds + 16384;
    char* XT = lds + 49152;
    const hf* U = (const hf*)(P.ws + OFF_U); const hf* UT = (const hf*)(P.ws + OFF_UT); const hf* HS = (const hf*)(P.ws + OFF_HS);
    const hf* Z = (const hf*)(P.ws + OFF_Z); const float* DTP = (const float*)(P.ws + OFF_DTP);
    const int lq = lt * 32 + r31;
    stage_rows16<128>(U + (size_t)t0 * 1024 + 512 + g * 128, 1024, Bm, tid);
    stage_rows8<256>(UT + (size_t)(g * 256) * NT + t0, NT, XT, tid);
    if (w < 4) {
        const int hd = g * 4 + w;
        float* tbw = tab + w * 512;
#pragma unroll
        for (int dir = 0; dir < 2; ++dir) {
            const float a = -expf(P.a_log[layer * 16 + dir * 8 + hd]);
            const float dt0 = DTP[(size_t)(t0 + 2 * lane) * 16 + dir * 8 + hd], dt1 = DTP[(size_t)(t0 + 2 * lane + 1) * 16 + dir * 8 + hd];
            const float d0 = dt0 * a, d1 = dt1 * a;
            const float inc1 = wave_incl_scan(d0 + d1, lane), inc0 = inc1 - d1;
            const float total = rdlane(inc1, 63);
            const float c0 = (dir == 0 ? inc0 : total - inc0 + d0) * LOG2E, c1 = (dir == 0 ? inc1 : total - inc1 + d1) * LOG2E;
            tbw[dir * 128 + 2 * lane] = c0; tbw[dir * 128 + 2 * lane + 1] = c1;
            tbw[256 + dir * 128 + 2 * lane] = c0 - __builtin_amdgcn_logf(dt0); tbw[256 + dir * 128 + 2 * lane + 1] = c1 - __builtin_amdgcn_logf(dt1);
        }
    }
    __syncthreads();
    int lh = lh0;
    h8 cfn[8];
    { const int tid = opaque_tid(), lane = tid & 63, w = tid >> 6;
      const size_t row0 = (size_t)(t0 + lh0 * 64 + (w >> 2) * 32 + (lane & 31));
#pragma unroll
      for (int kk = 0; kk < 8; ++kk) cfn[kk] = *(const h8*)(U + row0 * 1024 + 768 + g * 128 + kk * 16 + 8 * (lane >> 5)); }
#pragma unroll 1
    do {
    const int tid = opaque_tid(), lane = tid & 63, w = tid >> 6, hh = w & 3, lt = w >> 2, r31 = lane & 31, h = lane >> 5;
    const int head = g * 4 + hh, lq = lt * 32 + r31;
    const int lloc = lh * 64 + lq;
    const size_t lrow = (size_t)(t0 + lloc);
    h8 cf[8];
#pragma unroll
    for (int kk = 0; kk < 8; ++kk) cf[kk] = cfn[kk];
    h8 hs0[2][8];
    { const hf* hp = HS + (size_t)((cid * 2 + 0) * 8 + head) * 8192 + (size_t)r31 * 128 + 8 * h;
#pragma unroll
      for (int pt = 0; pt < 2; ++pt)
#pragma unroll
          for (int kk = 0; kk < 8; ++kk) hs0[pt][kk] = *(const h8*)(hp + pt * 32 * 128 + kk * 16); }
    const float* tb = tab + hh * 512;
    fx16 Y[2]; Y[0] = zero16(); Y[1] = zero16();
    const float aFl = tb[lloc], aBl = tb[128 + lloc];
    const int sw16 = r31 & 15;
#pragma unroll
    for (int st = 0; st < 4; ++st) {
        h8 bf[8];
#pragma unroll
        for (int kk = 0; kk < 8; ++kk) bf[kk] = *(const h8*)(Bm + (st * 32 + r31) * 256 + (((2 * kk + h) ^ sw16) << 4));
        h8 xf[2][2];
#pragma unroll
        for (int sh = 0; sh < 2; ++sh)
#pragma unroll
            for (int pt = 0; pt < 2; ++pt) {
                const int q0 = 4 * (st * 2 + sh) + h;
                const LAS char* rowp = (const LAS char*)XT + (hh * 64 + pt * 32 + r31) * 256;
                const h4 v0 = *(const volatile LAS h4*)(rowp + ((q0 ^ r31) << 3)), v1 = *(const volatile LAS h4*)(rowp + (((q0 + 2) ^ r31) << 3));
                h8 x; x[0] = v0[0]; x[1] = v0[1]; x[2] = v0[2]; x[3] = v0[3]; x[4] = v1[0]; x[5] = v1[1]; x[6] = v1[2]; x[7] = v1[3];
                xf[sh][pt] = x;
            }
        __builtin_amdgcn_sched_barrier(0);
        fx16 T = zero16();
#pragma unroll
        for (int kk = 0; kk < 8; ++kk) T = mfma16(bf[kk], cf[kk], T);
#pragma unroll
        for (int rg = 0; rg < 4; ++rg) {
            const int s0 = st * 32 + rg * 8 + 4 * h;
            const f4 eFs = *(const f4*)(tb + 256 + s0), eBs = *(const f4*)(tb + 384 + s0);
#pragma unroll
            for (int e = 0; e < 4; ++e) {
                const int s = s0 + e;
                const float xf = s <= lloc ? aFl - eFs[e] : -INFINITY, xb = s >= lloc ? aBl - eBs[e] : -INFINITY;
                T[rg * 4 + e] *= __builtin_amdgcn_exp2f(xf) + __builtin_amdgcn_exp2f(xb);
            }
        }
#pragma unroll
        for (int sh = 0; sh < 2; ++sh) {
            h8 pf;
#pragma unroll
            for (int e = 0; e < 8; ++e) pf[e] = (hf)T[8 * sh + e];
#pragma unroll
            for (int pt = 0; pt < 2; ++pt) Y[pt] = mfma16(xf[sh][pt], pf, Y[pt]);
        }
    }
    h4 xsv[2][4], zzv[2][4];
    {
        h8 hs1[2][8];
        { const hf* hp = HS + (size_t)((cid * 2 + 1) * 8 + head) * 8192 + (size_t)r31 * 128 + 8 * h;
#pragma unroll
          for (int pt = 0; pt < 2; ++pt)
#pragma unroll
              for (int kk = 0; kk < 8; ++kk) hs1[pt][kk] = *(const h8*)(hp + pt * 32 * 128 + kk * 16); }
        __builtin_amdgcn_sched_barrier(0);
        const float exF = __builtin_amdgcn_exp2f(aFl), exB = __builtin_amdgcn_exp2f(aBl);
#pragma unroll
        for (int pt = 0; pt < 2; ++pt) {
            fx16 tmp = zero16();
#pragma unroll
            for (int kk = 0; kk < 8; ++kk) tmp = mfma16(hs0[pt][kk], cf[kk], tmp);
            Y[pt] += tmp * exF;
        }
        __builtin_amdgcn_sched_barrier(0);
#pragma unroll
        for (int pt = 0; pt < 2; ++pt)
#pragma unroll
            for (int rg = 0; rg < 4; ++rg) {
                const int p = pt * 32 + rg * 8 + 4 * h;
                xsv[pt][rg] = *(const h4*)(U + lrow * 1024 + head * 64 + p); zzv[pt][rg] = *(const h4*)(Z + lrow * 512 + head * 64 + p);
            }
        __builtin_amdgcn_sched_barrier(0);
#pragma unroll
        for (int pt = 0; pt < 2; ++pt) {
            fx16 tmp = zero16();
#pragma unroll
            for (int kk = 0; kk < 8; ++kk) tmp = mfma16(hs1[pt][kk], cf[kk], tmp);
            Y[pt] += tmp * exB;
        }
    }
    if (lh + 1 < lh1) {
#pragma unroll
        for (int kk = 0; kk < 8; ++kk) cfn[kk] = *(const h8*)(U + (lrow + 64) * 1024 + 768 + g * 128 + kk * 16 + 8 * h);
    }
    const float dsk = P.d_skip[layer * 8 + head];
    float ss = 0.f;
#pragma unroll
    for (int pt = 0; pt < 2; ++pt)
#pragma unroll
        for (int rg = 0; rg < 4; ++rg) {
            const h4 xs = xsv[pt][rg], zz = zzv[pt][rg];
#pragma unroll
            for (int e = 0; e < 4; ++e) { const float y = Y[pt][rg * 4 + e] + (float)xs[e] * dsk; const float gv = y * silu_f((float)zz[e]); Y[pt][rg * 4 + e] = gv; ss += gv * gv; }
        }
    ss += shflx(ss, 32, lane);
    if (h == 0) sstab[hh * 64 + lq] = ss;
    __syncthreads();
    {
        const float tot = (sstab[lq] + sstab[64 + lq]) + (sstab[128 + lq] + sstab[192 + lq]);
        const float rstd = 1.0f / sqrtf(tot * (1.0f / 256.0f) + 1e-6f);
        hf* dst = (hf*)(P.ws + OFF_MIX) + lrow * 1024 + 512 + head * 64;
#pragma unroll
        for (int pt = 0; pt < 2; ++pt)
#pragma unroll
            for (int rg = 0; rg < 4; ++rg) {
                const int p = pt * 32 + rg * 8 + 4 * h;
                const f4 gw = *(const f4*)(P.gnorm_w + layer * 512 + head * 64 + p);
                h4 ov;
#pragma unroll
                for (int e = 0; e < 4; ++e) ov[e] = (hf)(Y[pt][rg * 4 + e] * rstd * gw[e]);
                *(h4*)(dst + p) = ov;
            }
    }
    __syncthreads();
    } while (++lh < lh1);
}

#if defined(DBG_NAIVE_ATTN)
__device__ __forceinline__ void naive_attn(const Params& P, int layer, char* lds) {
    const int tid = opaque_tid(), lane = tid & 63, w = tid >> 6;
    const hf* qkv = (const hf*)(P.ws + OFF_QKV);
    float* qs = (float*)lds + w * 64;
    const int nrows = layer == 0 ? NT : NL;
    for (int item = blockIdx.x * 8 + w; item < nrows * 8; item += gridDim.x * 8) {
        const int row = item >> 3, hd8 = item & 7, isB = hd8 >> 2, head = hd8 & 3, kvh = head >> 1, base = isB ? 8 : 0;
        const hf* Q = qkv + (size_t)(base + head) * HT + (size_t)row * 64;
        const hf* K = qkv + (size_t)(base + 4 + kvh) * HT;
        const hf* VT = qkv + (size_t)(base + 6 + kvh) * HT;
        qs[lane] = (float)Q[lane];
        __builtin_amdgcn_s_waitcnt(0);
        float m = -1e30f, l = 0.f, o = 0.f;
        int r0a, r1a, r0b = 0, r1b = 0;
        if (row >= NL) { r0a = NL; r1a = NT; }
        else if (isB) { r0a = 0; r1a = NT; }
        else { r0a = NL; r1a = NT; r0b = row - 128 < 0 ? 0 : row - 128; r1b = row + 129 > NL ? NL : row + 129; }
        for (int rng = 0; rng < 2; ++rng) {
            const int k0 = rng ? r0b : r0a, k1 = rng ? r1b : r1a;
            for (int kb = k0; kb < k1; kb += 64) {
                const int key = kb + lane; const bool ok = key < k1;
                float s = -1e30f;
                if (ok) { s = 0.f; const hf* kp = K + (size_t)key * 64; for (int d = 0; d < 64; ++d) s += qs[d] * (float)kp[d]; }
                float mx = s;
                for (int dd = 32; dd >= 1; dd >>= 1) mx = fmaxf(mx, __shfl_xor(mx, dd));
                const float mn = fmaxf(m, mx), alpha = exp2f(m - mn);
                const float p = ok ? exp2f(s - mn) : 0.f;
                float ps = p;
                for (int dd = 32; dd >= 1; dd >>= 1) ps += __shfl_xor(ps, dd);
                l = l * alpha + ps; o *= alpha; m = mn;
                const int cnt = k1 - kb < 64 ? k1 - kb : 64;
                for (int j = 0; j < cnt; ++j) { const float pj = __shfl(p, j); o += pj * (float)VT[(size_t)lane * NT + kb + j]; }
            }
        }
        if (!isB) l += exp2f(P.sink[layer * 4 + head] * LOG2E - m);
        ((hf*)(P.ws + OFF_MIX))[(size_t)row * 1024 + (isB ? 256 : 0) + head * 64 + lane] = (hf)(o / l);
    }
}
#endif
#if defined(DBG_NAIVE_SSD)
__device__ __forceinline__ void naive_ssd_scan(const Params& P, int layer) {
    const int tid = opaque_tid(), lane = tid & 63, w = tid >> 6;
    const hf* U = (const hf*)(P.ws + OFF_U); const float* DTP = (const float*)(P.ws + OFF_DTP);
    float* Y = (float*)(P.ws + OFF_HS);
    for (int item = blockIdx.x * 8 + w; item < 512; item += gridDim.x * 8) {
        const int head = item >> 6, p = item & 63, g = head >> 2;
        for (int dir = 0; dir < 2; ++dir) {
            const float a = -expf(P.a_log[layer * 16 + dir * 8 + head]);
            float s0 = 0.f, s1 = 0.f;
            for (int step = 0; step < NT; ++step) {
                int t;
                if (dir == 0) t = step < NCX ? NL + step : step - NCX;
                else t = step < NCX ? NT - 1 - step : NL - 1 - (step - NCX);
                const float dt = DTP[(size_t)t * 16 + dir * 8 + head];
                const float x = (float)U[(size_t)t * 1024 + head * 64 + p];
                const float b0 = (float)U[(size_t)t * 1024 + 512 + g * 128 + lane], b1 = (float)U[(size_t)t * 1024 + 512 + g * 128 + 64 + lane];
                const float c0 = (float)U[(size_t)t * 1024 + 768 + g * 128 + lane], c1 = (float)U[(size_t)t * 1024 + 768 + g * 128 + 64 + lane];
                const float dec = expf(a * dt);
                s0 = s0 * dec + dt * b0 * x; s1 = s1 * dec + dt * b1 * x;
                float y = c0 * s0 + c1 * s1;
                for (int dd = 32; dd >= 1; dd >>= 1) y += __shfl_xor(y, dd);
                if (lane == 0) { float* yp = Y + (size_t)t * 512 + head * 64 + p; *yp = dir == 0 ? y : *yp + y; }
            }
        }
    }
}
__device__ __forceinline__ void naive_ssd_finish(const Params& P, int layer) {
    const int tid = opaque_tid(), lane = tid & 63, w = tid >> 6;
    const hf* U = (const hf*)(P.ws + OFF_U); const hf* Z = (const hf*)(P.ws + OFF_Z); const float* Y = (const float*)(P.ws + OFF_HS);
    const int nrows = layer == 0 ? NT : NL;
    for (int item = blockIdx.x * 8 + w; item < nrows * 2; item += gridDim.x * 8) {
        const int t = item >> 1, g = item & 1;
        float gv[4]; float ss = 0.f;
        for (int i = 0; i < 4; ++i) { const int ch = g * 256 + i * 64 + lane; const float y = Y[(size_t)t * 512 + ch] + (float)U[(size_t)t * 1024 + ch] * P.d_skip[layer * 8 + (ch >> 6)];
            const float z = (float)Z[(size_t)t * 512 + ch]; gv[i] = y * (z / (1.0f + expf(-z))); ss += gv[i] * gv[i]; }
        for (int dd = 32; dd >= 1; dd >>= 1) ss += __shfl_xor(ss, dd);
        const float rstd = 1.0f / sqrtf(ss / 256.0f + 1e-6f);
        for (int i = 0; i < 4; ++i) { const int ch = g * 256 + i * 64 + lane; ((hf*)(P.ws + OFF_MIX))[(size_t)t * 1024 + 512 + ch] = (hf)(gv[i] * rstd * P.gnorm_w[layer * 512 + ch]); }
    }
}
#endif
#if defined(DBG_NAIVE_INPROJ)
__device__ __forceinline__ void naive_inproj(const Params& P, int layer) {
    const int tid = opaque_tid(), lane = tid & 63, w = tid >> 6;
    const hf* H = (const hf*)(P.ws + OFF_H16); const hf* W = (const hf*)(P.ws + OFF_WIN) + (size_t)layer * INP * D;
    hf* qkv = (hf*)(P.ws + OFF_QKV);
    for (int item = blockIdx.x * 8 + w; item < NT * 16; item += gridDim.x * 8) {
        const int t = item >> 4, fb = item & 15, sub = fb & 7;
        const hf* hp = H + (size_t)t * D; const hf* wp = W + (size_t)(fb * 64 + lane) * D;
        float acc = 0.f;
        for (int k = 0; k < D; k += 8) { const h8 a = *(const h8*)(hp + k), b = *(const h8*)(wp + k); for (int j = 0; j < 8; ++j) acc += (float)a[j] * (float)b[j]; }
        float v = acc;
        if (sub < 6) {
            if (fb >= 8) { float ss = v * v; for (int dd = 32; dd >= 1; dd >>= 1) ss += __shfl_xor(ss, dd); v = v * (1.0f / sqrtf(ss / 64.0f + 1e-6f)) * (sub < 4 ? P.q_gain : P.k_gain)[layer * 64 + lane]; }
            if (t < NL) {
                const int axis = lane >> 5, half = (lane >> 4) & 1, f = lane & 15;
                const float pos = (float)(axis == 0 ? (t >> 6) : (t & 63));
                const float inv = powf(10000.0f, -(float)f / 16.0f); const float ang = pos * inv;
                const float other = __shfl_xor(v, 16);
                const float cs = cosf(ang), sn = sinf(ang);
                v = half == 0 ? v * cs - other * sn : other * sn + v * cs;
            }
            if (sub < 4) v *= 0.125f * LOG2E;
            qkv[(size_t)fb * HT + (size_t)t * 64 + lane] = (hf)v;
        } else qkv[(size_t)fb * HT + (size_t)lane * NT + t] = (hf)v;
    }
}
#endif


#if defined(DBG_NAIVE_INPROJ2)
__device__ __forceinline__ void naive_inproj2(const Params& P, int layer) {
    const int tid = opaque_tid(), lane = tid & 63, w = tid >> 6;
    const hf* H = (const hf*)(P.ws + OFF_H16); const hf* W = (const hf*)(P.ws + OFF_WIN) + (size_t)layer * INP * D;
    for (int item = blockIdx.x * 8 + w; item < NT * 25; item += gridDim.x * 8) {
        const int t = item / 25, fb = 16 + item % 25;
        const hf* hp = H + (size_t)t * D; const hf* wp = W + (size_t)(fb * 64 + lane) * D;
        float acc = 0.f;
        for (int k = 0; k < D; k += 8) { const h8 a = *(const h8*)(hp + k), b = *(const h8*)(wp + k); for (int j = 0; j < 8; ++j) acc += (float)a[j] * (float)b[j]; }
        if (fb < 24) ((hf*)(P.ws + OFF_Z))[(size_t)t * 512 + (fb - 16) * 64 + lane] = (hf)acc;
        else if (fb < 40) ((hf*)(P.ws + OFF_XBC))[(size_t)t * 1024 + (fb - 24) * 64 + lane] = (hf)acc;
        else if (lane < 16) ((float*)(P.ws + OFF_DTR))[(size_t)t * 16 + lane] = acc;
    }
}
#endif
#if defined(DBG_NAIVE_PREP)
__device__ __forceinline__ void naive_prep(const Params& P, int layer) {
    const hf* XBC = (const hf*)(P.ws + OFF_XBC); hf* U = (hf*)(P.ws + OFF_U); hf* UT = (hf*)(P.ws + OFF_UT);
    for (size_t e = (size_t)blockIdx.x * 512 + opaque_tid(); e < (size_t)NT * 1024; e += (size_t)gridDim.x * 512) {
        const int t = (int)(e >> 10), ch = (int)(e & 1023);
        const int seg0 = t < NL ? 0 : NL, seg1 = t < NL ? NL : NT;
        float s = P.conv_b[layer * 1024 + ch];
        for (int k = 0; k < 5; ++k) { const int tt = t + k - 2; if (tt >= seg0 && tt < seg1) s += P.conv_w[(size_t)layer * 5120 + k * 1024 + ch] * (float)XBC[(size_t)tt * 1024 + ch]; }
        const hf o = (hf)(s / (1.0f + expf(-s)));
        U[e] = o; if (ch < 768) UT[(size_t)ch * NT + t] = o;
    }
    const float* dr = (const float*)(P.ws + OFF_DTR); float* dp = (float*)(P.ws + OFF_DTP);
    for (int e = blockIdx.x * 512 + opaque_tid(); e < NT * 16; e += gridDim.x * 512) { const float xv = dr[e] + P.dt_bias[layer * 16 + (e & 15)]; dp[e] = xv > 20.f ? xv : log1pf(expf(xv)); }
}
#endif
#if defined(DBG_NAIVE_GEMM)
__device__ __forceinline__ void naive_res_gemm(const Params& P, const hf* A, const hf* Wt, int K, int nrows, int layer, int which_g, char* lds) {
    const int tid = opaque_tid(); float* ar = (float*)lds;
    for (int t = blockIdx.x; t < nrows; t += gridDim.x) {
        for (int k = tid; k < K; k += 512) ar[k] = (float)A[(size_t)t * K + k];
        __syncthreads();
        float* xr = xr_row(P, t); const float* g = modv(P, layer, t >= NL ? 1 : 0, which_g);
        for (int n = tid; n < D; n += 512) { const hf* wp = Wt + (size_t)n * K; float acc = 0.f;
            for (int k = 0; k < K; k += 8) { const h8 b = *(const h8*)(wp + k); for (int j = 0; j < 8; ++j) acc += ar[k + j] * (float)b[j]; }
            xr[n] = ALPHA * xr[n] + g[n] * acc; }
        __syncthreads();
    }
}
__device__ __forceinline__ void naive_gu_gemm(const Params& P, int layer, int nrows, char* lds) {
    const int tid = opaque_tid(); float* ar = (float*)lds;
    const hf* A = (const hf*)(P.ws + OFF_H16); hf* G = (hf*)(P.ws + OFF_G16);
    for (int t = blockIdx.x; t < nrows; t += gridDim.x) {
        for (int k = tid; k < D; k += 512) ar[k] = (float)A[(size_t)t * D + k];
        __syncthreads();
        for (int j = tid; j < DFF; j += 512) { float ag = 0.f, au = 0.f;
            for (int k = 0; k < D; ++k) { const float a = ar[k]; ag += a * (float)(hf)P.w_gu[(size_t)layer * D * NGU + (size_t)k * NGU + j]; au += a * (float)(hf)P.w_gu[(size_t)layer * D * NGU + (size_t)k * NGU + DFF + j]; }
            G[(size_t)t * DFF + j] = (hf)((ag / (1.0f + expf(-ag))) * au); }
        __syncthreads();
    }
}
#endif

__device__ __forceinline__ void phase_mix(const Params& P, int layer, char* lds) {
    const hf* qkv = (const hf*)(P.ws + OFF_QKV);
    const int ssd_end = 512 + (layer == 0 ? 264 : 256);
    const int nunits = ssd_end + (layer == 0 ? 8 : 0);
    float gq = 0.f, gk = 0.f;
    for (int i = 0; i < 64; ++i) { gq = fmaxf(gq, fabsf(P.q_gain[layer * 64 + i])); gk = fmaxf(gk, fabsf(P.k_gain[layer * 64 + i])); }
    const bool nomax_ok = 0.125f * LOG2E * 64.0f * gq * gk * 1.01f <= 14.0f;
#if defined(DBG_NAIVE_INPROJ)
    naive_inproj(P, layer); cg::this_grid().sync();
#endif
#if defined(DBG_NAIVE_ATTN)
    naive_attn(P, layer, lds); __syncthreads();
#endif
#if defined(DBG_NAIVE_SSD)
    naive_ssd_scan(P, layer); cg::this_grid().sync(); naive_ssd_finish(P, layer);
#endif
#pragma unroll 1
    for (int u = blockIdx.x; u < nunits; u += gridDim.x) {
#if defined(DBG_NAIVE_SSD)
        if (u >= 512 && u < ssd_end) continue;
#endif
#if defined(DBG_NAIVE_ATTN)
        if (u < 512 || u >= ssd_end) continue;
#endif
        if (u >= 512 && u < ssd_end) { const int i = u - 512;
            int cid = i >> 1, g = i & 1, l0 = 0, l1 = 2;
            if (i >= 256) { const int j = i - 256; cid = 128 + (j >> 2); g = (j >> 1) & 1; l0 = j & 1; l1 = l0 + 1; }
            ssd_out_unit(P, layer, cid, g, l0, l1, lds);
            continue; }
        int base, kvh, qrow0, ta0, na, tb0 = 0, nb = 0, use_sink, outcol;
        if (u < 256) {
            kvh = u & 1; base = 8; qrow0 = (u >> 1) * 128; ta0 = 0; na = 260; use_sink = 0; outcol = 256 + kvh * 128;
        } else if (u < 512) {
            const int i = u - 256, qb = i >> 1; kvh = i & 1; base = 0; qrow0 = qb * 128; ta0 = 256; na = 4;
            const int lo = 2 * qb - 2 < 0 ? 0 : 2 * qb - 2, hi = 2 * qb + 4 > 256 ? 256 : 2 * qb + 4;
            tb0 = lo; nb = hi - lo; use_sink = 1; outcol = kvh * 128;
        } else {
            const int i = u - ssd_end, isB = i >> 2, cq = i & 1; kvh = (i >> 1) & 1; base = isB ? 8 : 0;
            qrow0 = NL + cq * 128; ta0 = 256; na = 4; use_sink = isB ? 0 : 1; outcol = (isB ? 256 : 0) + kvh * 128;
        }
        AttnJob J; J.Q0 = qkv + (size_t)(base + 2 * kvh) * HT; J.Q1 = qkv + (size_t)(base + 1 + 2 * kvh) * HT; J.K = qkv + (size_t)(base + 4 + kvh) * HT; J.VT = qkv + (size_t)(base + 6 + kvh) * HT;
        J.qrow0 = qrow0; J.ta0 = ta0; J.na = na; J.tb0 = tb0; J.nb = nb; J.use_sink = use_sink; J.sink0 = P.sink[layer * 4 + 2 * kvh]; J.sink1 = P.sink[layer * 4 + 2 * kvh + 1]; J.outcol = outcol;
        if (u < 256 && nomax_ok) attn_unit_pin(P, J, lds); else attn_unit<false>(P, J, lds);
#if defined(PROBE_MIX_A)
        if (u >= 256) attn_unit<false>(P, J, lds);
#endif
#if defined(PROBE_MIX_B)
        if (u < 256) attn_unit<true>(P, J, lds);
#endif
    }
}

constexpr int PPL = 8;
constexpr int NPHASES = 3 + PPL * 2;

__device__ __forceinline__ void run_phase(const Params& P, int ph, char* lds) {
    if (ph == 0) { phase_p0(P, lds); return; }
    if (ph == 1) { phase_modfin(P); return; }
    if (ph == 2) { phase_rows(P, 0, NT, nullptr, nullptr, 0, 0, 1); return; }
    const int layer = (ph - 3) / PPL, sub0 = (ph - 3) % PPL;
    const bool pre_out = layer == 0 && sub0 == 6, pre_dn = layer == 1 && sub0 == 0;
    const int nsteps = (pre_out || pre_dn) ? 2 : 1;
    const int layer_ = layer;
#pragma unroll 1
    for (int step = 0; step < nsteps; ++step) {
        const bool ctxout = pre_out && step == 0, ctxdn = pre_dn && step == 0;
        const int sub = ctxout ? 5 : ctxdn ? 7 : sub0;
        const int layer = ctxdn ? 0 : layer_;
        const int mt = ctxdn ? 65 : (layer == 0 ? (sub == 7 ? 64 : 65) : 64);
        switch (sub) {
            case 0: { EpiIn e{P, layer}; gemm_phase(( const hf*)(P.ws + OFF_H16), (const hf*)(P.ws + OFF_WIN) + (size_t)layer * INP * D, 65, 11, D, e, lds, layer == 1 ? 4 : 0); } break;
            case 1: phase_prep(P, layer, lds); break;
            case 2: phase_ssd_states(P, layer, lds); break;
            case 3: phase_ssd_scan(P); break;
            case 4: phase_mix(P, layer, lds); break;
            case 5: { EpiResLN e{P, layer, 2, layer == 0 ? nullptr : P.ln2_g + (layer - 1) * D, layer == 0 ? nullptr : P.ln2_b + (layer - 1) * D,
                                 P.ln1_g + layer * D, P.ln1_b + layer * D, layer, 3, 4, 0, layer * 2};
                      gemm_phase((const hf*)(P.ws + OFF_MIX), (const hf*)(P.ws + OFF_WOUT) + (size_t)layer * D * D, ctxout ? 1 : 64, 4, D, e, lds, ctxout ? 1 : 0); } break;
            case 6: { EpiGU e{P}; gemm_phase((const hf*)(P.ws + OFF_H16), (const hf*)(P.ws + OFF_WGU) + (size_t)layer * NGU * D, mt, 22, D, e, lds, layer == 0 ? 2 : 0); } break;
            case 7: { EpiResLN e{P, layer, 5, P.ln1_g + layer * D, P.ln1_b + layer * D,
                                 P.ln2_g + layer * D, P.ln2_b + layer * D, layer == 0 ? 1 : 0, 0, 1, layer == 1 ? 1 : 0, layer * 2 + 1};
                      gemm_phase((const hf*)(P.ws + OFF_G16), (const hf*)(P.ws + OFF_WDN) + (size_t)layer * D * DFF, ctxdn ? 1 : mt, 4, DFF, e, lds, ctxdn ? 3 : 0); } break;
        }
    }
}

__global__ void __launch_bounds__(512) fwd_kernel(Params P) {
    extern __shared__ __attribute__((aligned(16))) char lds[];
    P.wv = __builtin_amdgcn_readfirstlane((int)(threadIdx.x >> 6));
    volatile LAS unsigned* st = (volatile LAS unsigned*)(lds + 131072);
    if (threadIdx.x < 4) st[threadIdx.x] = 0u;
    __syncthreads();
    const XcdBarrier xb = xcd_barrier_post((unsigned*)(P.ws + OFF_BAR), st);
#pragma unroll 1
    for (int ph = P.ph_lo; ph < P.ph_hi; ++ph) {
        run_phase(P, ph, lds);
#if defined(PROBE_REPEAT_SUB)
        { const int sub_ = ph >= 3 ? (ph - 3) % PPL : -1 - ph; if ((PROBE_REPEAT_MASK >> (sub_ + 3)) & 1) { xcd_barrier(xb); run_phase(P, ph, lds); } }
#endif
        if (ph + 1 < P.ph_hi) { if (ph == P.ph_lo) cg::this_grid().sync(); else xcd_barrier(xb); }
    }
}

constexpr int LDS_BYTES = 131072 + 256;

extern "C" void kernel_launch(void* const* d_in, const int* in_sizes, int n_in, void* d_out, int out_size, void* d_ws, size_t ws_size, hipStream_t stream) {
    static int grid = 0;
    if (grid == 0) {
        if (n_in != 23 || out_size != NL * D || ws_size < OFF_END) { fprintf(stderr, "kernel_launch: unexpected shapes (n_in %d out %d ws %zu need %zu)\n", n_in, out_size, ws_size, (size_t)OFF_END); grid = -1; return; }
        int dev = 0, cus = 0, per_cu = 0;
        hipGetDevice(&dev); hipDeviceGetAttribute(&cus, hipDeviceAttributeMultiprocessorCount, dev);
        hipFuncSetAttribute((const void*)fwd_kernel, hipFuncAttributeMaxDynamicSharedMemorySize, LDS_BYTES);
        hipOccupancyMaxActiveBlocksPerMultiprocessor(&per_cu, (const void*)fwd_kernel, 512, LDS_BYTES);
        if (per_cu < 1) { fprintf(stderr, "kernel_launch: occupancy query says %d blocks/CU\n", per_cu); }
        (void)hipGetLastError();
        grid = cus > 0 ? cus : 256;
    }
    if (grid < 0) return;
    Params p{};
    const float** pp = (const float**)&p;
    for (int i = 0; i < 23; ++i) pp[i] = (const float*)d_in[i];
    p.out = (float*)d_out; p.ws = (unsigned char*)d_ws;
#if MULTI_LAUNCH
    for (int ph = 0; ph < NPHASES; ++ph) { p.ph_lo = ph; p.ph_hi = ph + 1; hipLaunchKernelGGL(fwd_kernel, dim3(grid), dim3(512), LDS_BYTES, stream, p); }
#else
    p.ph_lo = 0; p.ph_hi = NPHASES;
    if (hipMemsetAsync((char*)d_ws + OFF_BAR, 0, 16384, stream) != hipSuccess) fprintf(stderr, "memset of barrier words failed\n");
    void* args[] = {&p};
    hipError_t e = hipLaunchCooperativeKernel((const void*)fwd_kernel, dim3(grid), dim3(512), args, LDS_BYTES, stream);
    if (e != hipSuccess) fprintf(stderr, "cooperative launch failed: %s (grid %d)\n", hipGetErrorString(e), grid);
#endif
}
```

```cpp
#include <hip/hip_runtime.h>
#include <hip/hip_cooperative_groups.h>
#include <cstdio>
#include <cstdint>
namespace cg = cooperative_groups;

#ifndef MULTI_LAUNCH
#define MULTI_LAUNCH 0
#endif

typedef _Float16 hf;
typedef hf h2 __attribute__((ext_vector_type(2)));
typedef hf h4 __attribute__((ext_vector_type(4)));
typedef hf h8 __attribute__((ext_vector_type(8)));
typedef float f4 __attribute__((ext_vector_type(4)));
typedef float fx16 __attribute__((ext_vector_type(16)));
typedef unsigned u4 __attribute__((ext_vector_type(4)));
typedef unsigned u2 __attribute__((ext_vector_type(2)));

constexpr int NL = 16384, NCX = 256, NT = 16640, D = 1024, INC = 2576, INP = 2816, DFF = 2816, NGU = 5632;
constexpr int NCHK = 130;
constexpr size_t HT = (size_t)NT * 64;
constexpr float LOG2E = 1.4426950408889634f;
constexpr float ALPHA = 1.4142135623730951f;

constexpr size_t OFF_WIN = 0;
constexpr size_t OFF_WOUT = OFF_WIN + (size_t)2 * INP * D * 2;
constexpr size_t OFF_WGU = OFF_WOUT + (size_t)2 * D * D * 2;
constexpr size_t OFF_WDN = OFF_WGU + (size_t)2 * NGU * D * 2;
constexpr size_t OFF_H16 = OFF_WDN + (size_t)2 * D * DFF * 2;
constexpr size_t OFF_SMALL = OFF_H16 + (size_t)NT * D * 2;
constexpr size_t OFF_MODP = OFF_SMALL;
constexpr size_t OFF_MOD = OFF_MODP + (size_t)8 * 2 * 2 * 6144 * 4;
constexpr size_t OFF_ROPE = OFF_MOD + (size_t)2 * 2 * 6144 * 4;
constexpr size_t OFF_XRC = OFF_ROPE + (size_t)256 * 16 * 2 * 4;
constexpr size_t OFF_DTR = OFF_XRC + (size_t)NCX * D * 4;
constexpr size_t OFF_DTP = OFF_DTR + (size_t)NT * 16 * 4;
constexpr size_t OFF_DEC = OFF_DTP + (size_t)NT * 16 * 4;
constexpr size_t OFF_BAR = OFF_DEC + 16384;
constexpr size_t OFF_CNT = OFF_BAR + 13824;
constexpr size_t OFF_STATS = OFF_BAR + 16384;
constexpr size_t OFF_BIG = OFF_SMALL + (size_t)4 * 1024 * 1024 + 262144;
constexpr size_t OFF_QKV = OFF_BIG;
constexpr size_t OFF_Z = OFF_QKV + 16 * HT * 2;
constexpr size_t OFF_XBC = OFF_Z + (size_t)NT * 512 * 2;
constexpr size_t OFF_HS = OFF_XBC;
constexpr size_t OFF_U = OFF_XBC + (size_t)NT * 1024 * 2;
constexpr size_t OFF_UT = OFF_U + (size_t)NT * 1024 * 2;
constexpr size_t OFF_XSL = OFF_UT;
constexpr size_t OFF_CS = OFF_UT + (size_t)768 * NT * 2;
constexpr size_t OFF_MIX = OFF_CS;
constexpr size_t OFF_G16 = OFF_BIG;
constexpr size_t OFF_END = OFF_CS + (size_t)NCHK * 2 * 8 * 64 * 128 * 2;
constexpr int XRB_SPLIT = 12288;
constexpr size_t OFF_XRB_A = ((OFF_G16 + (size_t)NT * DFF * 2 + 4095) / 4096) * 4096;
constexpr size_t OFF_XRB_B = OFF_UT + (size_t)1024 * 1024;
static_assert(OFF_XRB_A + (size_t)XRB_SPLIT * D * 2 <= OFF_UT && (size_t)NT * 32 <= (size_t)1024 * 1024 && OFF_XRB_B + (size_t)(NL - XRB_SPLIT) * D * 2 <= OFF_CS, "XRB overflow");
static_assert(NCHK * 2 * 8 * 4 <= 16384 && 3456 * 4 <= 16384 && OFF_STATS + (size_t)NT * 8 <= OFF_BIG, "small region overflow");
static_assert(OFF_G16 + (size_t)NT * DFF * 2 <= OFF_END, "G16 overflow");
static_assert(OFF_END <= (size_t)256 * 1024 * 1024, "workspace too large");

struct Params {
    const float* x; const float* c; const float* ctx; const float* c_ctx; const float* w_ada; const float* b_ada; const float* w_in;
    const float* sink; const float* q_gain; const float* k_gain; const float* conv_w; const float* conv_b; const float* a_log;
    const float* dt_bias; const float* d_skip; const float* gnorm_w; const float* w_out; const float* ln1_g; const float* ln1_b;
    const float* ln2_g; const float* ln2_b; const float* w_gu; const float* w_down;
    float* out; unsigned char* ws; int ph_lo, ph_hi; int wv;
};

__device__ __forceinline__ float silu_f(float x) { return x * __builtin_amdgcn_rcpf(1.0f + __builtin_amdgcn_exp2f(-x * LOG2E)); }
__device__ __forceinline__ hf* xr16_row(const Params& P, int row, bool in_ws) {
    if (row >= NL) return (hf*)(P.ws + OFF_XRC) + (size_t)(row - NL) * D;
    if (in_ws) return row < XRB_SPLIT ? (hf*)(P.ws + OFF_XRB_A) + (size_t)row * D : (hf*)(P.ws + OFF_XRB_B) + (size_t)(row - XRB_SPLIT) * D;
    return (hf*)P.out + (size_t)row * D;
}
__device__ __forceinline__ float* xr_row(const Params& P, int row) { return row < NL ? P.out + (size_t)row * D : (float*)(P.ws + OFF_XRC) + (size_t)(row - NL) * D; }
__device__ __forceinline__ const float* modv(const Params& P, int layer, int set, int which) { return (const float*)(P.ws + OFF_MOD) + (size_t)((layer * 2 + set) * 6 + which) * 1024; }
__device__ __forceinline__ u4 pair16(h4 a_, h4 b_) {
    const u2 a = __builtin_bit_cast(u2, a_), b = __builtin_bit_cast(u2, b_);
    const auto r0 = __builtin_amdgcn_permlane16_swap(a.x, b.x, false, false);
    const auto r1 = __builtin_amdgcn_permlane16_swap(a.y, b.y, false, false);
    u4 w; w.x = r0[0]; w.y = r1[0]; w.z = r0[1]; w.w = r1[1]; return w;
}
__device__ __forceinline__ int pair_off(int fq) { return (fq & 1) ? 16 + (fq - 1) * 4 : fq * 4; }
__device__ __forceinline__ fx16 mfma16(h8 a, h8 b, fx16 c) { return __builtin_amdgcn_mfma_f32_32x32x16_f16(a, b, c, 0, 0, 0); }
__device__ __forceinline__ int opaque_tid_w(int wv) { int z = 0; asm volatile("" : "+v"(z)); const int lane = __builtin_amdgcn_mbcnt_hi(-1, __builtin_amdgcn_mbcnt_lo(-1, z)); return (wv << 6) | lane; }
#define opaque_tid() opaque_tid_w(P.wv)
__device__ __forceinline__ float shflx(float v, int mask, int lane) { return __builtin_bit_cast(float, __builtin_amdgcn_ds_bpermute((lane ^ mask) << 2, __builtin_bit_cast(int, v))); }
__device__ __forceinline__ float rdlane(float v, int l) { return __builtin_bit_cast(float, __builtin_amdgcn_readlane(__builtin_bit_cast(int, v), l)); }
__device__ __forceinline__ fx16 zero16() { fx16 z; for (int i = 0; i < 16; ++i) z[i] = 0.f; return z; }


#define XB_TMO      128
#define XB_XCNT(j)  (256  + 64 * (j))
#define XB_XSUB(j)  (1280 + 64 * (j))
#define XB_XGEN(j)  (2304 + 64 * (j))
#define XB_TOP      3328
#define XB_TOPGEN   3392
#define XCD_BAR_WORDS 3456
#define XB_SPIN_CAP (1u << 22)
#define LAS __attribute__((address_space(3)))
__device__ __forceinline__ unsigned xb_ld(unsigned* p)              { return __hip_atomic_load(p, __ATOMIC_RELAXED, __HIP_MEMORY_SCOPE_AGENT); }
__device__ __forceinline__ unsigned xb_add(unsigned* p, unsigned v) { return __hip_atomic_fetch_add(p, v, __ATOMIC_RELAXED, __HIP_MEMORY_SCOPE_AGENT); }
__device__ __forceinline__ unsigned xb_xcc_id() { return (unsigned)__builtin_amdgcn_s_getreg((3 << 11) | 20) & 0xFu; }
#define XB_SPIN(cond, bar) do { unsigned _sp = 0; while (cond) { __builtin_amdgcn_s_sleep(1); \
    if ((++_sp & 255u) == 0u) { if (xb_ld(&(bar)[XB_TMO])) break; if (_sp > XB_SPIN_CAP) { atomicAdd(&(bar)[XB_TMO], 1u); break; } } } } while (0)
struct XcdBarrier { unsigned* bar; unsigned x; volatile LAS unsigned* st; };
__device__ __forceinline__ XcdBarrier xcd_barrier_post(unsigned* bar, volatile LAS unsigned* st) {
    XcdBarrier b; b.bar = bar; b.x = xb_xcc_id(); b.st = st;
    if (threadIdx.x == 0) (void)xb_add(&bar[XB_XCNT(b.x)], 1u);
    return b;
}
__device__ __forceinline__ void xcd_barrier_complete(unsigned* bar, unsigned x, unsigned& nloc, unsigned& nx) {
    const unsigned G = gridDim.x * gridDim.y * gridDim.z;
    unsigned sum, cnt, mine, sp = 0u;
    for (;;) {
        sum = 0u; cnt = 0u; mine = 0u;
#pragma unroll
        for (unsigned j = 0; j < 16; ++j) { const unsigned c = xb_ld(&bar[XB_XCNT(j)]); sum += c; cnt += (c > 0u) ? 1u : 0u; mine = (j == x) ? c : mine; }
        if (sum == G) break;
        __builtin_amdgcn_s_sleep(1);
        if ((++sp & 255u) == 0u) { if (xb_ld(&bar[XB_TMO])) break; if (sp > XB_SPIN_CAP) { atomicAdd(&bar[XB_TMO], 1u); break; } }
    }
    nloc = mine > 0u ? mine : 1u; nx = cnt > 0u ? cnt : 1u;
}
__device__ __forceinline__ void xcd_barrier(const XcdBarrier& b) {
    asm volatile("s_waitcnt vmcnt(0)" ::: "memory");
    __syncthreads();
    if (threadIdx.x == 0) {
        unsigned* bar = b.bar;
        __builtin_amdgcn_s_waitcnt(0);
        unsigned nloc = b.st[0], nx = b.st[1];
        if (nloc == 0u) { xcd_barrier_complete(bar, b.x, nloc, nx); b.st[0] = nloc; b.st[1] = nx; }
        const unsigned old = xb_add(&bar[XB_XSUB(b.x)], 1u);
        const unsigned gen = old / nloc;
        if (old + 1u == (gen + 1u) * nloc) {
            __builtin_amdgcn_fence(__ATOMIC_RELEASE, "agent");
            asm volatile("s_waitcnt vmcnt(0)" ::: "memory");
            const unsigned og = xb_add(&bar[XB_TOP], 1u);
            const unsigned tg = og / nx;
            if (og + 1u == (tg + 1u) * nx) xb_add(&bar[XB_TOPGEN], 1u);
            else XB_SPIN(xb_ld(&bar[XB_TOPGEN]) == tg, bar);
            __builtin_amdgcn_fence(__ATOMIC_ACQUIRE, "agent");
            xb_add(&bar[XB_XGEN(b.x)], 1u);
            asm volatile("s_waitcnt vmcnt(0)" ::: "memory");
        } else {
            XB_SPIN(xb_ld(&bar[XB_XGEN(b.x)]) == gen, bar);
            __builtin_amdgcn_fence(__ATOMIC_ACQUIRE, "agent");
            asm volatile("s_waitcnt vmcnt(0)" ::: "memory");
        }
    }
    __syncthreads();
}

__device__ __forceinline__ void phase_p0(const Params& P, char* lds) {
    const int tid = opaque_tid();
    float* tile = (float*)lds;
    for (int u = blockIdx.x; u < 1536 + 192 + 8; u += gridDim.x) {
        if (u < 1536) {
            const float* src; hf* dst; int ld, K, r0, k0, kind;
            if (u < 352) { const int l = u / 176, rem = u % 176; r0 = (rem / 16) * 256; k0 = (rem % 16) * 64; ld = INC; K = D; kind = 0; src = P.w_in + (size_t)l * D * INC; dst = (hf*)(P.ws + OFF_WIN) + (size_t)l * INP * D; }
            else if (u < 480) { const int i = u - 352, l = i / 64, rem = i % 64; r0 = (rem / 16) * 256; k0 = (rem % 16) * 64; ld = D; K = D; kind = 1; src = P.w_out + (size_t)l * D * D; dst = (hf*)(P.ws + OFF_WOUT) + (size_t)l * D * D; }
            else if (u < 1184) { const int i = u - 480, l = i / 352, rem = i % 352; r0 = (rem / 16) * 256; k0 = (rem % 16) * 64; ld = NGU; K = D; kind = 2; src = P.w_gu + (size_t)l * D * NGU; dst = (hf*)(P.ws + OFF_WGU) + (size_t)l * NGU * D; }
            else { const int i = u - 1184, l = i / 176, rem = i % 176; r0 = (rem / 44) * 256; k0 = (rem % 44) * 64; ld = D; K = DFF; kind = 3; src = P.w_down + (size_t)l * DFF * D; dst = (hf*)(P.ws + OFF_WDN) + (size_t)l * D * DFF; }
            const int c4 = (tid & 63) * 4, kq = tid >> 6;
            int scol = r0 + c4; bool valid = true;
            if (kind == 2) scol = c4 < 128 ? (r0 >> 1) + c4 : DFF + (r0 >> 1) + (c4 - 128);
            else if (kind == 0 && scol >= INC) valid = false;
            f4 v[8];
#pragma unroll
            for (int i = 0; i < 8; ++i) v[i] = valid ? *(const f4*)(src + (size_t)(k0 + kq + 8 * i) * ld + scol) : (f4){0.f, 0.f, 0.f, 0.f};
#pragma unroll
            for (int i = 0; i < 8; ++i) { float* tp = tile + (kq + 8 * i) * 257 + c4; tp[0] = v[i][0]; tp[1] = v[i][1]; tp[2] = v[i][2]; tp[3] = v[i][3]; }
            __syncthreads();
            const int kc = tid & 7;
#pragma unroll
            for (int p = 0; p < 4; ++p) {
                const int rr = (tid >> 3) + 64 * p;
                const int c = kind == 2 ? ((rr >> 5) & 1) * 128 + (rr >> 6) * 32 + (rr & 31) : rr;
                h8 o;
#pragma unroll
                for (int j = 0; j < 8; ++j) o[j] = (hf)tile[(kc * 8 + j) * 257 + c];
                *(h8*)(dst + (size_t)(r0 + rr) * K + k0 + kc * 8) = o;
            }
            __syncthreads();
        } else if (u < 1536 + 192) {
            const int i = u - 1536, l = i / 96, rem = i % 96, cc = rem / 8, ks = rem % 8;
            float* sv = (float*)lds;
            if (tid < 256) { const int set = tid >> 7, k = tid & 127; const float v = set ? P.c_ctx[ks * 128 + k] : P.c[ks * 128 + k]; sv[tid] = v / (1.0f + expf(-v)); }
            __syncthreads();
            const int n = cc * 512 + tid;
            const float* w = P.w_ada + (size_t)l * D * 6144 + (size_t)(ks * 128) * 6144 + n;
            float a0 = 0.f, a1 = 0.f;
#pragma unroll 16
            for (int k = 0; k < 128; ++k) { const float wv = w[(size_t)k * 6144]; a0 += sv[k] * wv; a1 += sv[128 + k] * wv; }
            float* mp = (float*)(P.ws + OFF_MODP);
            mp[(size_t)((ks * 2 + l) * 2 + 0) * 6144 + n] = a0;
            mp[(size_t)((ks * 2 + l) * 2 + 1) * 6144 + n] = a1;
            __syncthreads();
        } else {
            const int e = (u - 1728) * 512 + tid, pos = e >> 4, f = e & 15;
            const float inv = exp2f(-(float)f * (13.287712379549449f / 16.0f));
            const float ang = (float)pos * inv;
            float sn, cs; sincosf(ang, &sn, &cs);
            float2* rt = (float2*)(P.ws + OFF_ROPE);
            rt[e] = make_float2(cs, sn);
        }
    }
}

__device__ __forceinline__ void phase_modfin(const Params& P) {
    const float* mp = (const float*)(P.ws + OFF_MODP);
    float* mo = (float*)(P.ws + OFF_MOD);
    for (int e = blockIdx.x * 512 + opaque_tid(); e < 2 * 2 * 6144; e += gridDim.x * 512) {
        const int l = e / 12288, rem = e % 12288, set = rem / 6144, n = rem % 6144;
        float s = P.b_ada[l * 6144 + n];
#pragma unroll
        for (int ks = 0; ks < 8; ++ks) s += mp[(size_t)((ks * 2 + l) * 2 + set) * 6144 + n];
        mo[e] = s;
    }
}

__device__ __forceinline__ void phase_rows(const Params& P, int mode, int nrows, const float* lg, const float* lb, int modlayer, int which_sh, int which_sc) {
    const int tid = opaque_tid(), lane = tid & 63, w = tid >> 6;
    hf* H = (hf*)(P.ws + OFF_H16);
    float2* stats = (float2*)(P.ws + OFF_STATS);
    const int half = nrows >> 1;
    for (int r0 = blockIdx.x * 8 + w; r0 < half; r0 += gridDim.x * 8) {
        f4 v[2][4];
#pragma unroll
        for (int k = 0; k < 2; ++k) {
            const int row = r0 + k * half;
            const float* src = mode == 0 ? (row < NL ? P.x + (size_t)row * D : P.ctx + (size_t)(row - NL) * D) : xr_row(P, row);
#pragma unroll
            for (int i = 0; i < 4; ++i) v[k][i] = *(const f4*)(src + (lane + 64 * i) * 4);
        }
#pragma unroll
        for (int k = 0; k < 2; ++k) {
            const int row = r0 + k * half;
            const int set = row >= NL ? 1 : 0;
            if (mode != 0) {
                float s = 0.f;
#pragma unroll
                for (int i = 0; i < 4; ++i) s += (v[k][i][0] + v[k][i][1]) + (v[k][i][2] + v[k][i][3]);
#pragma unroll
                for (int d = 32; d >= 1; d >>= 1) s += shflx(s, d, lane);
                const float mean = s * (1.0f / 1024.0f);
                float q = 0.f;
#pragma unroll
                for (int i = 0; i < 4; ++i) { const f4 dd = v[k][i] - mean; q += (dd[0] * dd[0] + dd[1] * dd[1]) + (dd[2] * dd[2] + dd[3] * dd[3]); }
#pragma unroll
                for (int d = 32; d >= 1; d >>= 1) q += shflx(q, d, lane);
                const float rstd = 1.0f / sqrtf(q * (1.0f / 1024.0f) + 1e-5f);
                if (lane == 0) stats[row] = make_float2(mean, rstd);
#pragma unroll
                for (int i = 0; i < 4; ++i) { const int col = (lane + 64 * i) * 4; const f4 g = *(const f4*)(lg + col), b = *(const f4*)(lb + col); v[k][i] = (v[k][i] - mean) * rstd * g + b; }
            }
            if (mode == 2) {
                float* dst = xr_row(P, row);
#pragma unroll
                for (int i = 0; i < 4; ++i) *(f4*)(dst + (lane + 64 * i) * 4) = v[k][i];
            } else {
                const float* sh = modv(P, modlayer, set, which_sh); const float* sc = modv(P, modlayer, set, which_sc);
#pragma unroll
                for (int i = 0; i < 4; ++i) { const int col = (lane + 64 * i) * 4; const f4 a = *(const f4*)(sc + col), b = *(const f4*)(sh + col); const f4 y = v[k][i] * (1.0f + a) + b;
                    h4 o; o[0] = (hf)y[0]; o[1] = (hf)y[1]; o[2] = (hf)y[2]; o[3] = (hf)y[3]; *(h4*)(H + (size_t)row * D + col) = o; }
            }
        }
    }
}

__device__ __forceinline__ int lds_byte(int r, int c) { const int st = (r >> 4) * 2 + (c >> 5), rr = r & 15, cc = c & 31, ob = rr * 64 + cc * 2; return st * 1024 + (ob ^ (((ob >> 9) & 1) << 5)); }
__device__ __forceinline__ void stage_rc(int b, int& R, int& C) { const int st = b / 1024, sb = b % 1024, swz = sb ^ (((sb >> 9) & 1) << 5); R = (st >> 1) * 16 + swz / 64; C = (st & 1) * 32 + (swz % 64) / 2; }

template <class Epi>
__device__ __forceinline__ void gemm_phase(const hf* X, const hf* Wt, int Mtiles, int Ntiles, int K, const Epi& epi, char* lds, int mode) {
    constexpr int BK = 64, HALF = 128, HTB = HALF * BK * 2;
    const int tid = opaque_tid_w(epi.P.wv), lane = tid & 63, wid = tid >> 6, wr = wid >> 2, wc = wid & 3, fr = lane & 15, fq = lane >> 4;
#define SA(b, h) (lds + ((b) * 2 + (h)) * HTB)
#define SB(b, h) (lds + (4 + (b) * 2 + (h)) * HTB)
#define STAGE(Pp, BASE, br, kt) do { const int so_ = ((br) * K + (kt) * BK) * 2; \
      __builtin_amdgcn_raw_ptr_buffer_load_lds(rs_##BASE, (LAS void*)((LAS char*)(Pp) + wbase), 16, (int)soff, so_, 0, 0); \
      __builtin_amdgcn_raw_ptr_buffer_load_lds(rs_##BASE, (LAS void*)((LAS char*)(Pp) + wbase + 8192), 16, (int)soff, so_ + 128 * K, 0, 0); } while (0)
#define LDA(dst, b, h) _Pragma("unroll") for (int m = 0; m < 4; ++m) _Pragma("unroll") for (int k = 0; k < 2; ++k) \
    dst[m][k] = *reinterpret_cast<const h8*>(SA(b, h) + lds_byte(wr * 64 + m * 16 + fr, k * 32 + fq * 8))
#define LDB(dst, b, h) _Pragma("unroll") for (int n = 0; n < 2; ++n) _Pragma("unroll") for (int k = 0; k < 2; ++k) \
    dst[n][k] = *reinterpret_cast<const h8*>(SB(b, h) + lds_byte(wc * 32 + n * 16 + fr, k * 32 + fq * 8))
#define MMA(ai, bj, At_, Bt_) do { __builtin_amdgcn_s_setprio(1); \
    _Pragma("unroll") for (int m = 0; m < 4; ++m) _Pragma("unroll") for (int n = 0; n < 2; ++n) _Pragma("unroll") for (int k = 0; k < 2; ++k) \
      acc[ai][bj][m][n] = __builtin_amdgcn_mfma_f32_16x16x32_f16(At_[m][k], Bt_[n][k], acc[ai][bj][m][n], 0, 0, 0); \
    __builtin_amdgcn_s_setprio(0); } while (0)
#define WAIT_V(n) asm volatile("s_waitcnt vmcnt(" #n ")" ::: "memory")
#define WAIT_L(n) asm volatile("s_waitcnt lgkmcnt(" #n ")" ::: "memory")
#define BAR __builtin_amdgcn_s_barrier()
#define SCHED __builtin_amdgcn_sched_barrier(0)
    const int nt = K / BK;
    const int wbase = __builtin_amdgcn_readfirstlane(wid) * 1024;
    const __amdgpu_buffer_rsrc_t rs_X = __builtin_amdgcn_make_buffer_rsrc((void*)X, 0, 0x7fffffff, 0x00020000);
    const __amdgpu_buffer_rsrc_t rs_Wt = __builtin_amdgcn_make_buffer_rsrc((void*)Wt, 0, 0x7fffffff, 0x00020000);
    unsigned soff; { int r0, c0; stage_rc(tid * 16, r0, c0); soff = (unsigned)(r0 * K + c0) * 2u; }
    const int G = gridDim.x, per = (G & 7) == 0 ? G >> 3 : 0, total = Mtiles * Ntiles;
#pragma unroll 1
    for (int it = 0;; ++it) {
        int v = per ? (it * 8 + (blockIdx.x & 7)) * per + (blockIdx.x >> 3) : it * G + blockIdx.x;
        if (mode == 1 || mode == 3) v = (it == 0 && (int)(blockIdx.x & 7) == (mode == 1 ? 5 : 7) && (blockIdx.x >> 3) < 4) ? (int)(blockIdx.x >> 3) : total;
        if (mode == 4 && (blockIdx.x & 7) == 7) {
            const int j = blockIdx.x >> 3;
            if (j < 4 && it >= 1) v = total; else if (j >= 4 && j < 8 && it == 2) v = 480 + (j - 4);
        }
        if (v >= total) break;
        const int grp = v / (4 * Ntiles), rem = v - grp * 4 * Ntiles, rows = Mtiles - 4 * grp < 4 ? Mtiles - 4 * grp : 4;
        int pn = rem / rows, pm = 4 * grp + rem % rows;
        if (mode == 1 || mode == 3) { pn = v; pm = 64; }
        unsigned* ctxready = (unsigned*)(epi.P.ws + OFF_CNT) + (mode >= 3 ? 301 : 300);
        if ((mode == 2 || mode == 4) && pm == 64) {
            if (opaque_tid_w(epi.P.wv) == 0) {
                unsigned spins = 0;
                while (__hip_atomic_load(ctxready, __ATOMIC_RELAXED, __HIP_MEMORY_SCOPE_AGENT) < 4u) { __builtin_amdgcn_s_sleep(2); if (++spins > (1u << 22)) break; }
                __builtin_amdgcn_fence(__ATOMIC_ACQUIRE, "agent");
                asm volatile("s_waitcnt vmcnt(0)" ::: "memory");
            }
            __syncthreads();
        }
        const int brow = pn * 256, bcol = pm * 256;
        f4 acc[2][2][4][2];
#pragma unroll
        for (int a = 0; a < 2; ++a)
#pragma unroll
            for (int b = 0; b < 2; ++b)
#pragma unroll
                for (int m = 0; m < 4; ++m)
#pragma unroll
                    for (int n = 0; n < 2; ++n) acc[a][b][m][n] = (f4){0.f, 0.f, 0.f, 0.f};
        h8 At[4][2], B0[2][2], B1[2][2];
        STAGE(SB(0, 0), X, bcol, 0); STAGE(SA(0, 0), Wt, brow, 0);
        STAGE(SB(0, 1), X, bcol + HALF, 0); STAGE(SA(0, 1), Wt, brow + HALF, 0);
        if (wr == 1) BAR;
        WAIT_V(4); BAR;
        STAGE(SB(1, 0), X, bcol, 1); STAGE(SA(1, 0), Wt, brow, 1); STAGE(SB(1, 1), X, bcol + HALF, 1);
        WAIT_V(6); BAR;
#pragma unroll 1
        for (int t = 0; t < nt - 2; t += 2) {
            LDB(B0, 0, 0); SCHED; LDA(At, 0, 0); STAGE(SA(1, 1), Wt, brow + HALF, t + 1);
            WAIT_L(8); BAR; WAIT_L(0); MMA(0, 0, At, B0); BAR; SCHED;
            LDB(B1, 0, 1); STAGE(SB(0, 0), X, bcol, t + 2);
            BAR; WAIT_L(0); MMA(0, 1, At, B1); BAR;
            LDA(At, 0, 1); STAGE(SA(0, 0), Wt, brow, t + 2);
            BAR; WAIT_L(0); MMA(1, 0, At, B0); BAR; SCHED;
            STAGE(SB(0, 1), X, bcol + HALF, t + 2);
            WAIT_V(6); BAR; MMA(1, 1, At, B1); BAR;
            LDB(B0, 1, 0); SCHED; LDA(At, 1, 0); STAGE(SA(0, 1), Wt, brow + HALF, t + 2);
            WAIT_L(8); BAR; WAIT_L(0); MMA(0, 0, At, B0); BAR; SCHED;
            LDB(B1, 1, 1); STAGE(SB(1, 0), X, bcol, t + 3);
            BAR; WAIT_L(0); MMA(0, 1, At, B1); BAR;
            LDA(At, 1, 1); STAGE(SA(1, 0), Wt, brow, t + 3);
            BAR; WAIT_L(0); MMA(1, 0, At, B0); BAR; SCHED;
            STAGE(SB(1, 1), X, bcol + HALF, t + 3);
            WAIT_V(6); BAR; MMA(1, 1, At, B1); BAR;
        }
        { LDB(B0, 0, 0); LDA(At, 0, 0); STAGE(SA(1, 1), Wt, brow + HALF, nt - 1);
          BAR; WAIT_L(0); MMA(0, 0, At, B0); BAR;
          LDB(B1, 0, 1); BAR; WAIT_L(0); MMA(0, 1, At, B1); BAR;
          LDA(At, 0, 1); WAIT_V(4); BAR; WAIT_L(0); MMA(1, 0, At, B0); MMA(1, 1, At, B1); BAR; }
        { LDB(B0, 1, 0); LDA(At, 1, 0); WAIT_V(2); BAR; WAIT_L(0); MMA(0, 0, At, B0); BAR;
          LDB(B1, 1, 1); WAIT_V(0); BAR; WAIT_L(0); MMA(0, 1, At, B1); BAR;
          LDA(At, 1, 1); BAR; WAIT_L(0); MMA(1, 0, At, B0); MMA(1, 1, At, B1); BAR; }
        if (wr == 0) BAR;
        epi(acc, pm, pn, wr, wc, fr, fq, lds);
        if (mode == 1 || mode == 3) {
            asm volatile("s_waitcnt vmcnt(0)" ::: "memory");
            __syncthreads();
            if (opaque_tid_w(epi.P.wv) == 0) {
                __builtin_amdgcn_fence(__ATOMIC_RELEASE, "agent");
                asm volatile("s_waitcnt vmcnt(0)" ::: "memory");
                __hip_atomic_fetch_add(ctxready, 1u, __ATOMIC_RELAXED, __HIP_MEMORY_SCOPE_AGENT);
            }
        }
    }
#undef SA
#undef SB
#undef STAGE
#undef LDA
#undef LDB
#undef MMA
#undef WAIT_V
#undef WAIT_L
#undef BAR
#undef SCHED
}

__device__ __forceinline__ unsigned pk2h(float lo, float hi) { h2 v; v[0] = (hf)lo; v[1] = (hf)hi; return __builtin_bit_cast(unsigned, v); }
struct EpiIn {
    Params P; int layer;
    __device__ __forceinline__ void operator()(f4 (&acc)[2][2][4][2], int pm, int pn, int, int, int, int, char*) const {
        hf* qkv = (hf*)(P.ws + OFF_QKV);
        const float2* rope = (const float2*)(P.ws + OFF_ROPE);
        const int tq_ = opaque_tid_w(P.wv), lane = tq_ & 63, wr = tq_ >> 8, wc = (tq_ >> 6) & 3, fr = lane & 15, fq = lane >> 4;
#pragma unroll
        for (int ai = 0; ai < 2; ++ai) {
            const int fb = pn * 4 + ai * 2 + wr;
            if (fb > 40) continue;
#pragma unroll
            for (int bj = 0; bj < 2; ++bj)
#pragma unroll
                for (int n = 0; n < 2; ++n) {
                    const int t = pm * 256 + bj * 128 + wc * 32 + n * 16 + fr;
                    f4 v[4];
#pragma unroll
                    for (int m = 0; m < 4; ++m) v[m] = acc[ai][bj][m][n];
                    if (fb < 16) {
                        const int sub = fb & 7;
                        if (sub < 6) {
                            if (fb >= 8) {
                                float ss = 0.f;
#pragma unroll
                                for (int m = 0; m < 4; ++m) ss += (v[m][0] * v[m][0] + v[m][1] * v[m][1]) + (v[m][2] * v[m][2] + v[m][3] * v[m][3]);
                                ss += shflx(ss, 16, lane); ss += shflx(ss, 32, lane);
                                const float rs = 1.0f / sqrtf(ss * (1.0f / 64.0f) + 1e-6f);
                                const float* gn = (sub < 4 ? P.q_gain : P.k_gain) + layer * 64;
#pragma unroll
                                for (int m = 0; m < 4; ++m) { const f4 g = *(const f4*)(gn + m * 16 + fq * 4); v[m] = v[m] * rs * g; }
                            }
                            if (t < NL) {
#pragma unroll
                                for (int ax = 0; ax < 2; ++ax) {
                                    const int pos = ax == 0 ? (t >> 6) : (t & 63);
                                    const f4* rp4 = (const f4*)(rope + pos * 16 + fq * 4);
                                    const f4 c01 = rp4[0], c23 = rp4[1];
#pragma unroll
                                    for (int j = 0; j < 4; ++j) { float2 cs; cs.x = (j < 2 ? c01 : c23)[(j & 1) * 2]; cs.y = (j < 2 ? c01 : c23)[(j & 1) * 2 + 1]; const float u1 = v[2 * ax][j], u2 = v[2 * ax + 1][j];
                                        v[2 * ax][j] = u1 * cs.x - u2 * cs.y; v[2 * ax + 1][j] = u1 * cs.y + u2 * cs.x; }
                                }
                            }
                            const float sc = sub < 4 ? 0.125f * LOG2E : 1.0f;
                            hf* dst = qkv + (size_t)fb * HT + (size_t)t * 64 + pair_off(fq);
#pragma unroll
                            for (int mp = 0; mp < 2; ++mp) { h4 o0, o1;
#pragma unroll
                                for (int e = 0; e < 4; ++e) { o0[e] = (hf)(v[2 * mp][e] * sc); o1[e] = (hf)(v[2 * mp + 1][e] * sc); }
                                *(u4*)(dst + mp * 32) = pair16(o0, o1); }
                        } else {
                            const int tp = (t & ~12) | (((t >> 2) & 1) << 3) | (((t >> 3) & 1) << 2);
                            const int q4 = fr & 3; const bool b0 = q4 & 1, b1 = (q4 & 2) != 0;
                            const int qd = fr >> 2, qpos = ((qd & 1) << 1) | (qd >> 1);
                            __attribute__((address_space(1))) hf* dst = (__attribute__((address_space(1))) hf*)(qkv + (size_t)fb * HT + (t & ~15) + 4 * qpos + (size_t)(4 * fq + q4) * NT);
#pragma unroll
                            for (int m = 0; m < 4; ++m) {
                                const float x0 = v[m][0], x1 = v[m][1], x2 = v[m][2], x3 = v[m][3];
                                const float r01 = __builtin_bit_cast(float, __builtin_amdgcn_update_dpp(0, __builtin_bit_cast(int, b0 ? x0 : x1), 0xB1, 0xf, 0xf, false));
                                const float r23 = __builtin_bit_cast(float, __builtin_amdgcn_update_dpp(0, __builtin_bit_cast(int, b0 ? x2 : x3), 0xB1, 0xf, 0xf, false));
                                const unsigned A0 = b0 ? pk2h(r01, x1) : pk2h(x0, r01), A1 = b0 ? pk2h(r23, x3) : pk2h(x2, r23);
                                const unsigned rB = (unsigned)__builtin_amdgcn_update_dpp(0, (int)(b1 ? A0 : A1), 0x4E, 0xf, 0xf, false);
                                u2 w2; w2.x = b1 ? rB : A0; w2.y = b1 ? A1 : rB;
                                *(__attribute__((address_space(1))) u2*)(dst + (size_t)(m * 16) * NT) = w2;
                            }
                        }
                    } else if (fb < 40) {
                        hf* dst = (fb < 24 ? (hf*)(P.ws + OFF_Z) + (size_t)t * 512 + (fb - 16) * 64 : (hf*)(P.ws + OFF_XBC) + (size_t)t * 1024 + (fb - 24) * 64) + pair_off(fq);
#pragma unroll
                        for (int mp = 0; mp < 2; ++mp) { h4 o0, o1;
#pragma unroll
                            for (int e = 0; e < 4; ++e) { o0[e] = (hf)v[2 * mp][e]; o1[e] = (hf)v[2 * mp + 1][e]; }
                            *(u4*)(dst + mp * 32) = pair16(o0, o1); }
                    } else {
                        *(f4*)((float*)(P.ws + OFF_DTR) + (size_t)t * 16 + fq * 4) = v[0];
                    }
                }
        }
    }
};

struct EpiRes {
    Params P; int layer; int which_g; const float* lng; const float* lnb;
    __device__ __forceinline__ void operator()(f4 (&acc)[2][2][4][2], int pm, int pn, int wr, int wc, int fr, int fq, char*) const {
        const float2* stats = (const float2*)(P.ws + OFF_STATS);
#pragma unroll
        for (int bj = 0; bj < 2; ++bj)
#pragma unroll
            for (int n = 0; n < 2; ++n) {
                const int t = pm * 256 + bj * 128 + wc * 32 + n * 16 + fr;
                float* xr = xr_row(P, t);
                const float* xin = lng ? xr : (t < NL ? P.x + (size_t)t * D : P.ctx + (size_t)(t - NL) * D);
                float2 st = make_float2(0.f, 1.f);
                if (lng) st = stats[t];
                const float* g = modv(P, layer, t >= NL ? 1 : 0, which_g);
#pragma unroll
                for (int ai = 0; ai < 2; ++ai)
#pragma unroll
                    for (int m = 0; m < 4; ++m) {
                        const int f = pn * 256 + ai * 128 + wr * 64 + m * 16 + fq * 4;
                        f4 xv = *(const f4*)(xin + f); const f4 gv = *(const f4*)(g + f);
                        if (lng) { const f4 lg4 = *(const f4*)(lng + f), lb4 = *(const f4*)(lnb + f); xv = (xv - st.x) * st.y * lg4 + lb4; }
                        *(f4*)(xr + f) = ALPHA * xv + gv * acc[ai][bj][m][n];
                    }
            }
    }
};

struct EpiResLN {
    Params P; int layer; int which_g; const float* lng_in; const float* lnb_in;
    const float* lng; const float* lnb; int modlayer, which_sh, which_sc; int final_out; int inst;
    __device__ __forceinline__ void operator()(f4 (&acc)[2][2][4][2], int pm, int pn, int wr, int wc, int fr, int fq, char* lds) const {
        const int tid = opaque_tid(), lane = tid & 63, wid = tid >> 6;
        float2* stats = (float2*)(P.ws + OFF_STATS);
        float2* part = (float2*)lds;
        float2* mr = (float2*)(lds + 4096);
        volatile LAS unsigned* flag = (volatile LAS unsigned*)(lds + 8192);
        unsigned long long* slots = (unsigned long long*)(P.ws + OFF_XSL);
        unsigned* cnt = (unsigned*)(P.ws + OFF_CNT) + inst * 65 + pm;
        const int wr1 = wid >> 2, wc1 = wid & 3, fr1 = lane & 15, fq1 = lane >> 4;
        const float* g = modv(P, layer, pm == 64 ? 1 : 0, which_g);
        float sa[2][2], qa[2][2];
#pragma unroll
        for (int bj = 0; bj < 2; ++bj)
#pragma unroll
            for (int n = 0; n < 2; ++n) { sa[bj][n] = 0.f; qa[bj][n] = 0.f; }
#pragma unroll
        for (int ai = 0; ai < 2; ++ai)
#pragma unroll
            for (int mp = 0; mp < 2; ++mp) {
                const int fp = pn * 256 + ai * 128 + wr1 * 64 + mp * 32;
                f4 gv[2], lg4[2], lb4[2];
#pragma unroll
                for (int mm = 0; mm < 2; ++mm) { const int f = fp + mm * 16 + fq1 * 4; gv[mm] = *(const f4*)(g + f);
                    if (lng_in) { lg4[mm] = *(const f4*)(lng_in + f); lb4[mm] = *(const f4*)(lnb_in + f); } }
#pragma unroll
                for (int bj = 0; bj < 2; ++bj)
#pragma unroll
                    for (int n = 0; n < 2; ++n) {
                        const int t = pm * 256 + bj * 128 + wc1 * 32 + n * 16 + fr1;
                        float2 st = make_float2(0.f, 1.f); if (lng_in) st = stats[t];
                        h4 x16[2];
                        if (lng_in) { const u4 wv = *(const u4*)(xr16_row(P, t, inst == 3) + fp + pair_off(fq1));
                            const auto r0 = __builtin_amdgcn_permlane16_swap(wv.x, wv.z, false, false); const auto r1 = __builtin_amdgcn_permlane16_swap(wv.y, wv.w, false, false);
                            u2 a2; a2.x = r0[0]; a2.y = r1[0]; u2 b2; b2.x = r0[1]; b2.y = r1[1];
                            x16[0] = __builtin_bit_cast(h4, a2); x16[1] = __builtin_bit_cast(h4, b2); }
                        h4 v16[2];
#pragma unroll
                        for (int mm = 0; mm < 2; ++mm) {
                            const int m = 2 * mp + mm;
                            const int f = fp + mm * 16 + fq1 * 4;
                            f4 xv;
                            if (lng_in) { xv[0] = (float)x16[mm][0]; xv[1] = (float)x16[mm][1]; xv[2] = (float)x16[mm][2]; xv[3] = (float)x16[mm][3];
                                xv = (xv - st.x) * st.y * lg4[mm] + lb4[mm]; }
                            else xv = *(const f4*)((t < NL ? P.x + (size_t)t * D : P.ctx + (size_t)(t - NL) * D) + f);
                            const f4 v = ALPHA * xv + gv[mm] * acc[ai][bj][m][n];
                            acc[ai][bj][m][n] = v;
                            v16[mm][0] = (hf)v[0]; v16[mm][1] = (hf)v[1]; v16[mm][2] = (hf)v[2]; v16[mm][3] = (hf)v[3];
                            sa[bj][n] += (v[0] + v[1]) + (v[2] + v[3]); qa[bj][n] += (v[0] * v[0] + v[1] * v[1]) + (v[2] * v[2] + v[3] * v[3]);
                        }
                        if (!final_out) *(u4*)(xr16_row(P, t, inst == 2) + fp + pair_off(fq1)) = pair16(v16[0], v16[1]);
                    }
            }
#pragma unroll
        for (int bj = 0; bj < 2; ++bj)
#pragma unroll
            for (int n = 0; n < 2; ++n) {
                float s = sa[bj][n], q = qa[bj][n];
                s += shflx(s, 16, lane); s += shflx(s, 32, lane); q += shflx(q, 16, lane); q += shflx(q, 32, lane);
                if (fq1 == 0) { const int t2 = opaque_tid();
                    part[(bj * 128 + ((t2 >> 6) & 3) * 32 + n * 16 + (t2 & 15)) * 2 + (t2 >> 8)] = make_float2(s, q); }
            }
        __syncthreads();
        if (tid < 256) { const float2 a = part[tid * 2], b = part[tid * 2 + 1];
            const unsigned long long wv = ((unsigned long long)__float_as_uint(a.y + b.y) << 32) | __float_as_uint(a.x + b.x);
            __hip_atomic_store(slots + (size_t)(pm * 256 + tid) * 4 + pn, wv, __ATOMIC_RELAXED, __HIP_MEMORY_SCOPE_AGENT); }
        asm volatile("s_waitcnt vmcnt(0)" ::: "memory");
        __syncthreads();
        if (wid == 0) {
            if (lane == 0) __hip_atomic_fetch_add(cnt, 1u, __ATOMIC_RELAXED, __HIP_MEMORY_SCOPE_AGENT);
            unsigned spins = 0; bool dead = false;
            while ((unsigned)__builtin_amdgcn_readfirstlane((int)__hip_atomic_load(cnt, __ATOMIC_RELAXED, __HIP_MEMORY_SCOPE_AGENT)) < 4u) {
                __builtin_amdgcn_s_sleep(2);
                if (++spins > (1u << 22)) { dead = true; break; }
            }
            __builtin_amdgcn_fence(__ATOMIC_ACQUIRE, "agent");
            asm volatile("s_waitcnt vmcnt(0)" ::: "memory");
            if (lane == 0) flag[0] = dead ? 1u : 0u;
        }
        __syncthreads();
        if (tid < 256) { const unsigned long long* sl = slots + (size_t)(pm * 256 + tid) * 4; float s = 0.f, q = 0.f;
#pragma unroll
            for (int k = 0; k < 4; ++k) { const unsigned long long wv = __hip_atomic_load(sl + k, __ATOMIC_RELAXED, __HIP_MEMORY_SCOPE_AGENT); s += __uint_as_float((unsigned)wv); q += __uint_as_float((unsigned)(wv >> 32)); }
            const float mean = s * (1.0f / 1024.0f);
            float var = q * (1.0f / 1024.0f) - mean * mean; var = var < 0.f ? 0.f : var;
            float2 o = make_float2(mean, 1.0f / sqrtf(var + 1e-5f));
            if (flag[0]) o = make_float2(__builtin_nanf(""), __builtin_nanf(""));
            mr[tid] = o;
            if (pn == 0) stats[pm * 256 + tid] = o; }
        __syncthreads();
        hf* H = (hf*)(P.ws + OFF_H16);
        const int t4 = opaque_tid(), wr4 = t4 >> 8, wc4 = (t4 >> 6) & 3, fr4 = t4 & 15, fq4 = (t4 >> 4) & 3;
        const float* sh = modv(P, modlayer, pm == 64 ? 1 : 0, which_sh); const float* sc = modv(P, modlayer, pm == 64 ? 1 : 0, which_sc);
#pragma unroll
        for (int ai = 0; ai < 2; ++ai)
#pragma unroll
            for (int mp = 0; mp < 2; ++mp) {
                const int fp = pn * 256 + ai * 128 + wr4 * 64 + mp * 32;
                f4 lg4[2], lb4[2], sc4[2], sh4[2];
#pragma unroll
                for (int mm = 0; mm < 2; ++mm) { const int f = fp + mm * 16 + fq4 * 4; lg4[mm] = *(const f4*)(lng + f); lb4[mm] = *(const f4*)(lnb + f);
                    if (!final_out) { sc4[mm] = *(const f4*)(sc + f); sh4[mm] = *(const f4*)(sh + f); } }
#pragma unroll
                for (int bj = 0; bj < 2; ++bj)
#pragma unroll
                    for (int n = 0; n < 2; ++n) {
                        const int tl = bj * 128 + wc4 * 32 + n * 16 + fr4, t = pm * 256 + tl;
                        const float2 st = mr[tl];
                        h4 o16[2];
#pragma unroll
                        for (int mm = 0; mm < 2; ++mm) {
                            const int m = 2 * mp + mm;
                            const f4 xn = (acc[ai][bj][m][n] - st.x) * st.y * lg4[mm] + lb4[mm];
                            if (final_out) { if (t < NL) *(f4*)(P.out + (size_t)t * D + fp + mm * 16 + fq4 * 4) = xn; }
                            else { const f4 y = xn * (1.0f + sc4[mm]) + sh4[mm];
                                o16[mm][0] = (hf)y[0]; o16[mm][1] = (hf)y[1]; o16[mm][2] = (hf)y[2]; o16[mm][3] = (hf)y[3]; }
                        }
                        if (!final_out) *(u4*)(H + (size_t)t * D + fp + pair_off(fq4)) = pair16(o16[0], o16[1]);
                    }
            }
        __syncthreads();
    }
};

struct EpiGU {
    Params P;
    __device__ __forceinline__ void operator()(f4 (&acc)[2][2][4][2], int pm, int pn, int, int, int, int, char*) const {
        hf* G = (hf*)(P.ws + OFF_G16);
        const int tq_ = opaque_tid_w(P.wv), wr = tq_ >> 8, wc = (tq_ >> 6) & 3, fr = tq_ & 15, fq = (tq_ >> 4) & 3;
        const int offe = pair_off(fq);
#pragma unroll
        for (int bj = 0; bj < 2; ++bj)
#pragma unroll
            for (int n = 0; n < 2; ++n) {
                const int t = pm * 256 + bj * 128 + wc * 32 + n * 16 + fr;
#pragma unroll
                for (int ai = 0; ai < 2; ++ai) {
                    u2 pk[2];
#pragma unroll
                    for (int mm = 0; mm < 2; ++mm) {
                        const f4 gt = acc[ai][bj][mm][n], up = acc[ai][bj][mm + 2][n];
                        h4 o;
#pragma unroll
                        for (int e = 0; e < 4; ++e) o[e] = (hf)(silu_f(gt[e]) * up[e]);
                        pk[mm] = __builtin_bit_cast(u2, o);
                    }
                    const auto r0 = __builtin_amdgcn_permlane16_swap(pk[0].x, pk[1].x, false, false);
                    const auto r1 = __builtin_amdgcn_permlane16_swap(pk[0].y, pk[1].y, false, false);
                    u4 w4; w4.x = r0[0]; w4.y = r1[0]; w4.z = r0[1]; w4.w = r1[1];
                    *(u4*)(G + (size_t)t * DFF + pn * 128 + (ai * 2 + wr) * 32 + offe) = w4;
                }
            }
    }
};

__device__ __forceinline__ void phase_prep(const Params& P, int layer, char* lds) {
    const int tid = opaque_tid();
    hf* raw = (hf*)lds;
    hf* outt = (hf*)(lds + 32768);
    const hf* XBC = (const hf*)(P.ws + OFF_XBC);
    hf* U = (hf*)(P.ws + OFF_U); hf* UT = (hf*)(P.ws + OFF_UT);
    u4 pre[3];
#define PREP_FETCH(uu) do { const int tb_ = (uu) >> 3, cb_ = (uu) & 7, t0_ = tb_ * 64, c0_ = cb_ * 128; const int s0_ = t0_ < NL ? 0 : NL, s1_ = t0_ < NL ? NL : NT; \
    _Pragma("unroll") for (int i_ = 0; i_ < 3; ++i_) { const int e_ = tid + i_ * 512, r_ = e_ >> 4, ch_ = e_ & 15, t_ = t0_ - 2 + r_; u4 v_ = {0u, 0u, 0u, 0u}; \
        if (e_ < 68 * 16 && t_ >= s0_ && t_ < s1_) v_ = *(const u4*)(XBC + (size_t)t_ * 1024 + c0_ + ch_ * 8); pre[i_] = v_; } } while (0)
    if (blockIdx.x < 260 * 8) PREP_FETCH(blockIdx.x);
    float wv[5] = {0.f, 0.f, 0.f, 0.f, 0.f}, bb = 0.f; int cbw = -1;
    for (int u = blockIdx.x; u < 260 * 8; u += gridDim.x) {
        const int tb = u >> 3, cb = u & 7, t0 = tb * 64, c0 = cb * 128;
#pragma unroll
        for (int i = 0; i < 3; ++i) { const int e = tid + i * 512; if (e < 68 * 16) *(u4*)(raw + (e >> 4) * 128 + (e & 15) * 8) = pre[i]; }
        __syncthreads();
        if (u + (int)gridDim.x < 260 * 8) PREP_FETCH(u + gridDim.x);
        {
            const int ch = tid & 127, tq = tid >> 7, gc = c0 + ch;
            if (cb != cbw) {
                cbw = cb;
#pragma unroll
                for (int k = 0; k < 5; ++k) wv[k] = P.conv_w[(size_t)layer * 5 * 1024 + k * 1024 + gc];
                bb = P.conv_b[layer * 1024 + gc];
            }
            float xin[20];
#pragma unroll
            for (int i = 0; i < 20; ++i) xin[i] = (float)raw[(tq * 16 + i) * 128 + ch];
            h8 o0, o1;
#pragma unroll
            for (int i = 0; i < 16; ++i) {
                float s = bb;
#pragma unroll
                for (int k = 0; k < 5; ++k) s += wv[k] * xin[i + k];
                const hf ov = (hf)silu_f(s);
                outt[(tq * 16 + i) * 128 + ch] = ov;
                if (i < 8) o0[i] = ov; else o1[i - 8] = ov;
            }
            if (gc < 768) { hf* d = UT + (size_t)gc * NT + t0 + tq * 16; *(h8*)d = o0; *(h8*)(d + 8) = o1; }
        }
        __syncthreads();
        for (int e = tid; e < 64 * 16; e += 512) { const int r = e >> 4, ch = e & 15; *(u4*)(U + (size_t)(t0 + r) * 1024 + c0 + ch * 8) = *(const u4*)(outt + r * 128 + ch * 8); }
        if (cb == 0) {
            const float* dr = (const float*)(P.ws + OFF_DTR); float* dp = (float*)(P.ws + OFF_DTP);
            for (int e = tid; e < 1024; e += 512) { const int j = e & 15; const float xv = dr[(size_t)t0 * 16 + e] + P.dt_bias[layer * 16 + j]; dp[(size_t)t0 * 16 + e] = xv > 20.f ? xv : log1pf(expf(xv)); }
        }
    }
#undef PREP_FETCH
    __syncthreads();
}

template <int NROWS>
__device__ __forceinline__ void stage_rows16(const hf* src, size_t ld, char* dst, int tid) {
#pragma unroll
    for (int i = 0; i < NROWS * 16 / 512; ++i) { const int e = tid + i * 512, r = e >> 4, c = e & 15;
        *(u4*)(dst + r * 256 + ((c ^ (r & 15)) << 4)) = *(const u4*)(src + (size_t)r * ld + c * 8); }
}
template <int NROWS>
__device__ __forceinline__ void stage_rows8(const hf* src, size_t ld, char* dst, int tid) {
    typedef unsigned u2 __attribute__((ext_vector_type(2)));
#pragma unroll
    for (int i = 0; i < NROWS * 16 / 512; ++i) { const int e = tid + i * 512, r = e >> 4, c = e & 15;
        const u4 v = *(const u4*)(src + (size_t)r * ld + c * 8);
        u2 lo; lo.x = v.x; lo.y = v.y; u2 hi; hi.x = v.z; hi.y = v.w;
        *(u2*)(dst + r * 256 + (((2 * c) ^ (r & 31)) << 3)) = lo; *(u2*)(dst + r * 256 + (((2 * c + 1) ^ (r & 31)) << 3)) = hi; }
}

__device__ __forceinline__ float wave_incl_scan(float v, int lane) {
#pragma unroll
    for (int d = 1; d < 64; d <<= 1) { const float t = __builtin_bit_cast(float, __builtin_amdgcn_ds_bpermute((lane - d) << 2, __builtin_bit_cast(int, v))); if (lane >= d) v += t; }
    return v;
}

__device__ __forceinline__ void phase_ssd_states(const Params& P, int layer, char* lds) {
    const int tid = opaque_tid(), lane = tid & 63, w = tid >> 6, hh = w & 3, dir = w >> 2, r31 = lane & 31, h = lane >> 5;
    float* wtab = (float*)lds + w * 128;
    char* XT = lds + 16384;
    char* BT = lds + 16384 + 65536;
    const hf* UT = (const hf*)(P.ws + OFF_UT); const float* DTP = (const float*)(P.ws + OFF_DTP);
    hf* CS = (hf*)(P.ws + OFF_CS); float* DEC = (float*)(P.ws + OFF_DEC);
    const int sw16 = r31 & 15;
    u4 pre[8]; float pdt0 = 0.f, pdt1 = 0.f;
#define ST_FETCH(uu) do { const int cid_ = (uu) >> 2, g_ = ((uu) >> 1) & 1, ph_ = (uu) & 1, t0_ = cid_ * 128; \
        _Pragma("unroll") for (int i_ = 0; i_ < 4; ++i_) { const int e_ = tid + i_ * 512, r_ = e_ >> 4, c_ = e_ & 15; \
            pre[i_] = *(const u4*)(UT + (size_t)(g_ * 256 + (r_ >> 5) * 64 + ph_ * 32 + (r_ & 31)) * NT + t0_ + c_ * 8); \
            pre[4 + i_] = *(const u4*)(UT + (size_t)(512 + g_ * 128 + r_) * NT + t0_ + c_ * 8); } \
        pdt0 = DTP[(size_t)(t0_ + 2 * lane) * 16 + dir * 8 + g_ * 4 + hh]; pdt1 = DTP[(size_t)(t0_ + 2 * lane + 1) * 16 + dir * 8 + g_ * 4 + hh]; } while (0)
    if ((int)blockIdx.x < NCHK * 4) ST_FETCH((int)blockIdx.x);
    for (int u = blockIdx.x; u < NCHK * 4; u += gridDim.x) {
        const int cid = u >> 2, g = (u >> 1) & 1, ph = u & 1, t0 = cid * 128, head = g * 4 + hh;
#pragma unroll
        for (int i = 0; i < 4; ++i) { const int e = tid + i * 512, r = e >> 4, c = e & 15;
            *(u4*)(XT + r * 256 + ((c ^ (r & 15)) << 4)) = pre[i]; *(u4*)(BT + r * 256 + ((c ^ (r & 15)) << 4)) = pre[4 + i]; }
        const float a = -expf(P.a_log[layer * 16 + dir * 8 + head]);
        const float dt0 = pdt0, dt1 = pdt1;
        if (u + (int)gridDim.x < NCHK * 4) ST_FETCH(u + (int)gridDim.x);
        const float d0 = dt0 * a, d1 = dt1 * a;
        const float inc1 = wave_incl_scan(d0 + d1, lane), inc0 = inc1 - d1;
        const float total = rdlane(inc1, 63);
        float w0, w1;
        if (dir == 0) { w0 = expf(total - inc0) * dt0; w1 = expf(total - inc1) * dt1; }
        else { w0 = expf(inc0 - d0) * dt0; w1 = expf(inc1 - d1) * dt1; }
        wtab[2 * lane] = w0; wtab[2 * lane + 1] = w1;
        if (lane == 0) DEC[(cid * 2 + dir) * 8 + head] = expf(total);
        __syncthreads();
        fx16 S[4];
#pragma unroll
        for (int b = 0; b < 4; ++b) S[b] = zero16();
#pragma unroll 4
        for (int kk = 0; kk < 8; ++kk) {
            const f4 wa = *(const f4*)(wtab + kk * 16 + 8 * h), wb = *(const f4*)(wtab + kk * 16 + 8 * h + 4);
            h8 w8; w8[0] = (hf)wa[0]; w8[1] = (hf)wa[1]; w8[2] = (hf)wa[2]; w8[3] = (hf)wa[3]; w8[4] = (hf)wb[0]; w8[5] = (hf)wb[1]; w8[6] = (hf)wb[2]; w8[7] = (hf)wb[3];
            const int co = ((2 * kk + h) ^ sw16) << 4;
            h8 bf[4];
            const h8 xf = *(const h8*)(XT + (hh * 32 + r31) * 256 + co) * w8;
#pragma unroll
            for (int nt = 0; nt < 4; ++nt) bf[nt] = *(const h8*)(BT + (nt * 32 + r31) * 256 + co);
#pragma unroll
            for (int nt = 0; nt < 4; ++nt) S[nt] = mfma16(bf[nt], xf, S[nt]);
        }
        hf* cs = CS + (size_t)((cid * 2 + dir) * 8 + head) * 8192 + (size_t)(ph * 32 + r31) * 128 + (h ? 8 : 0);
#pragma unroll
        for (int nt = 0; nt < 4; ++nt)
#pragma unroll
            for (int gp = 0; gp < 2; ++gp) {
                h4 a4, b4;
#pragma unroll
                for (int e = 0; e < 4; ++e) { a4[e] = (hf)S[nt][8 * gp + e]; b4[e] = (hf)S[nt][8 * gp + 4 + e]; }
                const u2 a = __builtin_bit_cast(u2, a4), b = __builtin_bit_cast(u2, b4);
                const auto r0 = __builtin_amdgcn_permlane32_swap(a.x, b.x, false, false);
                const auto r1 = __builtin_amdgcn_permlane32_swap(a.y, b.y, false, false);
                u4 w4; w4.x = r0[0]; w4.y = r1[0]; w4.z = r0[1]; w4.w = r1[1];
                *(u4*)(cs + nt * 32 + gp * 16) = w4;
            }
        __syncthreads();
    }
#undef ST_FETCH
}

__device__ __forceinline__ void phase_ssd_scan(const Params& P) {
    const hf* CS = (const hf*)(P.ws + OFF_CS); hf* HS = (hf*)(P.ws + OFF_HS); const float* DEC = (const float*)(P.ws + OFF_DEC);
    for (int e = blockIdx.x * 512 + opaque_tid(); e < 131072; e += gridDim.x * 512) {
        const int dir = e >> 16, head = (e >> 13) & 7, rest = e & 8191;
        float st = 0.f;
#pragma unroll 1
        for (int b0 = 0; b0 < NCHK; b0 += 26) {
            float cs[26], dc[26];
#pragma unroll
            for (int i = 0; i < 26; ++i) {
                const int step = b0 + i, cid = dir ? 129 - step : (step < 2 ? 128 + step : step - 2);
                cs[i] = (float)CS[(size_t)((cid * 2 + dir) * 8 + head) * 8192 + rest];
                dc[i] = DEC[(cid * 2 + dir) * 8 + head];
            }
#pragma unroll
            for (int i = 0; i < 26; ++i) {
                const int step = b0 + i, cid = dir ? 129 - step : (step < 2 ? 128 + step : step - 2);
                HS[(size_t)((cid * 2 + dir) * 8 + head) * 8192 + rest] = (hf)st;
                st = st * dc[i] + cs[i];
            }
        }
    }
}

struct AttnJob { const hf* Q0; const hf* Q1; const hf* K; const hf* VT; int qrow0; int ta0, na, tb0, nb; int use_sink; float sink0, sink1; int outcol; };

template <bool NOMAX>
__device__ __forceinline__ void attn_unit(const Params& P, const AttnJob& J, char* lds) {
    const int tid = opaque_tid(), lane = tid & 63, w = tid >> 6, r31 = lane & 31, h = lane >> 5, hsel = w >> 2;
    const int qbase = J.qrow0 + (w & 3) * 32;
    const int fsw = (r31 >> 1) & 7;
    const hf* Qp = (hsel ? J.Q1 : J.Q0) + (size_t)(qbase + r31) * 64 + h * 8;
    h8 qf[4];
#pragma unroll
    for (int kk = 0; kk < 4; ++kk) qf[kk] = *(const h8*)(Qp + kk * 16);
    asm volatile("" : "+v"(qf[0]), "+v"(qf[1]), "+v"(qf[2]), "+v"(qf[3]));
    fx16 o[2]; o[0] = zero16(); o[1] = zero16();
    float m = -1e30f, l = 0.f;
    fx16 ol = zero16();
    h8 ones; { const hf ov = (hf)((NOMAX && r31 == 0) ? 1.0f : 0.0f);
#pragma unroll
      for (int e = 0; e < 8; ++e) ones[e] = ov; }
    const int srow = tid >> 3, sc = tid & 7;
    const int kst = srow * 128 + ((sc ^ ((srow >> 1) & 7)) << 4);
    const int npairs = (J.na + J.nb) >> 1;
    u4 kr[2], vr[2];
#define TILE_OF(j) ((j) < J.na ? J.ta0 + (j) : J.tb0 + ((j) - J.na))
#pragma unroll
    for (int e = 0; e < 2; ++e) { const int tile = TILE_OF(e);
        kr[e] = *(const u4*)(J.K + (size_t)(tile * 64 + srow) * 64 + sc * 8); vr[e] = *(const u4*)(J.VT + (size_t)srow * NT + tile * 64 + sc * 8); }
#pragma unroll
    for (int e = 0; e < 2; ++e) { *(u4*)(lds + e * 16384 + kst) = kr[e]; *(u4*)(lds + e * 16384 + 8192 + kst) = vr[e]; }
    __syncthreads();
#pragma unroll 1
    for (int jp = 0; jp < npairs; ++jp) {
        const int cur = jp & 1;
        const bool more = jp + 1 < npairs;
        if (more) {
#pragma unroll
            for (int e = 0; e < 2; ++e) { const int tn = TILE_OF(2 * jp + 2 + e);
                kr[e] = *(const u4*)(J.K + (size_t)(tn * 64 + srow) * 64 + sc * 8); vr[e] = *(const u4*)(J.VT + (size_t)srow * NT + tn * 64 + sc * 8); }
        }
#pragma unroll
        for (int e2 = 0; e2 < 2; ++e2) {
        const int j = 2 * jp + e2;
        const int tile = TILE_OF(j);
        __builtin_amdgcn_sched_barrier(0);
        const char* lk = lds + cur * 32768 + e2 * 16384; const char* lv = lk + 8192;
        h8 kfr[2][4], vfr[4][2];
#pragma unroll
        for (int kk = 0; kk < 4; ++kk) {
            const int co = ((kk * 2 + h) ^ fsw) << 4;
#pragma unroll
            for (int kt = 0; kt < 2; ++kt) kfr[kt][kk] = *(const h8*)(lk + (kt * 32 + r31) * 128 + co);
        }
#pragma unroll
        for (int s4 = 0; s4 < 4; ++s4)
#pragma unroll
            for (int dt = 0; dt < 2; ++dt) {
                vfr[s4][dt] = *(const LAS h8*)((const LAS char*)lv + (dt * 32 + r31) * 128 + (((2 * s4 + h) ^ fsw) << 4));
            }
        __builtin_amdgcn_sched_barrier(0);
        fx16 s[2]; s[0] = zero16(); s[1] = zero16();
#pragma unroll
        for (int kk = 0; kk < 4; ++kk)
#pragma unroll
            for (int kt = 0; kt < 2; ++kt) s[kt] = mfma16(kfr[kt][kk], qf[kk], s[kt]);
        if (!NOMAX && j >= J.na) {
            const int qpos = qbase + r31;
#pragma unroll
            for (int kt = 0; kt < 2; ++kt)
#pragma unroll
                for (int i = 0; i < 16; ++i) { const int kpos = tile * 64 + kt * 32 + (i & 3) + 8 * (i >> 2) + 4 * h; const int dd = qpos - kpos; if (dd > 128 || dd < -128) s[kt][i] = -1e30f; }
        }
        float rs4[4] = {0.f, 0.f, 0.f, 0.f};
        if (NOMAX) {
#pragma unroll
            for (int kt = 0; kt < 2; ++kt)
#pragma unroll
                for (int i = 0; i < 16; ++i) s[kt][i] = __builtin_amdgcn_exp2f(s[kt][i]);
        } else {
            float mx = s[0][0];
#pragma unroll
            for (int kt = 0; kt < 2; ++kt)
#pragma unroll
                for (int i = 0; i < 16; ++i) mx = fmaxf(mx, s[kt][i]);
            mx = fmaxf(mx, shflx(mx, 32, lane));
            const float mn = fmaxf(m, mx);
            const float alpha = __builtin_amdgcn_exp2f(m - mn);
            m = mn;
#pragma unroll
            for (int kt = 0; kt < 2; ++kt)
#pragma unroll
                for (int i = 0; i < 16; ++i) { const float p = __builtin_amdgcn_exp2f(s[kt][i] - mn); s[kt][i] = p; rs4[i & 3] += p; }
            l = l * alpha + ((rs4[0] + rs4[1]) + (rs4[2] + rs4[3]));
            o[0] *= alpha; o[1] *= alpha;
        }
#pragma unroll
        for (int s4 = 0; s4 < 4; ++s4) {
            h8 pf;
#pragma unroll
            for (int e = 0; e < 8; ++e) pf[e] = (hf)s[s4 >> 1][8 * (s4 & 1) + e];
#pragma unroll
            for (int dt = 0; dt < 2; ++dt) o[dt] = mfma16(vfr[s4][dt], pf, o[dt]);
            if (NOMAX) ol = mfma16(ones, pf, ol);
        }
        }
        if (more) { char* lb = lds + (cur ^ 1) * 32768;
#pragma unroll
            for (int e = 0; e < 2; ++e) { *(u4*)(lb + e * 16384 + kst) = kr[e]; *(u4*)(lb + e * 16384 + 8192 + kst) = vr[e]; } }
        __syncthreads();
    }
#undef TILE_OF
    if (NOMAX) l = ol[0];
    l += shflx(l, 32, lane);
    if (!NOMAX && J.use_sink) l += __builtin_amdgcn_exp2f((hsel ? J.sink1 : J.sink0) * LOG2E - m);
    const float inv = 1.0f / l;
    hf* dst = (hf*)(P.ws + OFF_MIX) + (size_t)(qbase + r31) * 1024 + J.outcol + hsel * 64;
#pragma unroll
    for (int dt = 0; dt < 2; ++dt)
#pragma unroll
        for (int rg = 0; rg < 4; ++rg) { h4 ov;
#pragma unroll
            for (int e = 0; e < 4; ++e) ov[e] = (hf)(o[dt][rg * 4 + e] * inv);
            *(h4*)(dst + dt * 32 + rg * 8 + 4 * h) = ov; }
}

__device__ __forceinline__ fx16 neg4_16() { fx16 z; for (int i = 0; i < 16; ++i) z[i] = -4.0f; return z; }
__device__ __forceinline__ void attn_unit_pin(const Params& P, const AttnJob& J, char* lds) {
    const int tid = opaque_tid(), lane = tid & 63, w = tid >> 6, r31 = lane & 31, h = lane >> 5, kg = w >> 2;
    const int qbase = J.qrow0 + (w & 3) * 32;
    const int fsw = (r31 >> 1) & 7;
    h8 qf[2][4];
#pragma unroll
    for (int cb = 0; cb < 2; ++cb) { const hf* Qp = (cb ? J.Q1 : J.Q0) + (size_t)(qbase + r31) * 64 + h * 8;
#pragma unroll
        for (int kk = 0; kk < 4; ++kk) qf[cb][kk] = *(const h8*)(Qp + kk * 16); }
    asm volatile("" : "+v"(qf[0][0]), "+v"(qf[0][1]), "+v"(qf[0][2]), "+v"(qf[0][3]), "+v"(qf[1][0]), "+v"(qf[1][1]), "+v"(qf[1][2]), "+v"(qf[1][3]));
    fx16 o[4]; o[0] = zero16(); o[1] = zero16(); o[2] = zero16(); o[3] = zero16();
    float l0 = 0.f, l1 = 0.f;
    const int srow = tid >> 3, sc = tid & 7;
    const int kst = srow * 128 + ((sc ^ ((srow >> 1) & 7)) << 4);
    const int T = J.na;
    const __amdgpu_buffer_rsrc_t rsK = __builtin_amdgcn_make_buffer_rsrc((void*)J.K, 0, 0x7fffffff, 0x00020000), rsV = __builtin_amdgcn_make_buffer_rsrc((void*)J.VT, 0, 0x7fffffff, 0x00020000);
    const int ks0 = J.ta0 * 8192, vs0 = J.ta0 * 128;
    const int wb = __builtin_amdgcn_readfirstlane(w) * 1024;
    const int vlo = srow * (NT * 2) + ((sc ^ ((srow >> 1) & 7)) << 4);
#define PN_KDMA(t, S) __builtin_amdgcn_raw_ptr_buffer_load_lds(rsK, (LAS void*)((LAS char*)lds + (S) * 16384 + wb), 16, kst, ks0 + (t) * 8192, 0, 0)
#define PN_VDMA(t, S) __builtin_amdgcn_raw_ptr_buffer_load_lds(rsV, (LAS void*)((LAS char*)lds + (S) * 16384 + 8192 + wb), 16, vlo, vs0 + (t) * 128, 0, 0)
    int ko[4], vo[2];
#pragma unroll
    for (int kk = 0; kk < 4; ++kk) ko[kk] = (kg * 32 + r31) * 128 + (((2 * kk + h) ^ fsw) << 4);
#pragma unroll
    for (int ks = 0; ks < 2; ++ks) vo[ks] = 8192 + r31 * 128 + (((2 * (2 * kg + ks) + h) ^ fsw) << 4);
    const LAS char* L3 = (const LAS char*)lds;
#define PN_KRD(j, S) do { kf[j] = *(const LAS h8*)(L3 + ko[j] + (S) * 16384); } while (0)
#define PN_VRD(v, S) do { vfr[v] = *(const LAS h8*)(L3 + vo[(v) >> 1] + (S) * 16384 + ((v) & 1) * 4096); } while (0)
#define PN_SB __builtin_amdgcn_sched_barrier(0)
#define PN_PIN(x) asm volatile("" : "+v"(x))
#define PN_BAR do { asm volatile("s_waitcnt lgkmcnt(0)" ::: "memory"); __builtin_amdgcn_s_barrier(); asm volatile("" ::: "memory"); } while (0)
#define PN_BAR8 do { asm volatile("s_waitcnt vmcnt(2)" ::: "memory"); __builtin_amdgcn_s_barrier(); asm volatile("" ::: "memory"); } while (0)
    PN_KDMA(0, 0); PN_KDMA(1, 1); PN_KDMA(2, 2); PN_VDMA(0, 0); PN_VDMA(1, 1);
    asm volatile("s_waitcnt vmcnt(0)" ::: "memory");
    PN_BAR;
    h8 kf[4], vfr[4]; unsigned pwe[16];
#pragma unroll
    for (int j = 0; j < 4; ++j) PN_KRD(j, 0);
    fx16 a0, a1, b0, b1;
    a0 = neg4_16(); a1 = neg4_16();
#pragma unroll
    for (int kk = 0; kk < 4; ++kk) { a0 = mfma16(kf[kk], qf[0][kk], a0); a1 = mfma16(kf[kk], qf[1][kk], a1); }
    PN_KDMA(3, 3); PN_VDMA(2, 2);
#pragma unroll
    for (int i = 0; i < 16; ++i) { a0[i] = __builtin_amdgcn_exp2f(a0[i]); if (i < 10) a1[i] = __builtin_amdgcn_exp2f(a1[i]); }
#pragma unroll
    for (int j = 0; j < 4; ++j) PN_KRD(j, 1);
    PN_BAR;
#define PN_PF(P0, P1, idx) ((idx) < 16 ? P0[(idx) & 15] : P1[(idx) & 15])
#define PN_PAIR(j) (__builtin_bit_cast(h2, (unsigned)pwe[2 * (j)]) + __builtin_bit_cast(h2, (unsigned)pwe[2 * (j) + 1]))
#define PN_GAPA(i, C0, C1, P0, P1, SP) do { if ((i) < 4) { PN_VRD(i, SP); } PN_SB; \
        if ((i) & 1) C1 = mfma16(kf[(i) >> 1], qf[1][(i) >> 1], C1); else C0 = mfma16(kf[(i) >> 1], qf[0][(i) >> 1], C0); PN_SB; \
        if ((i) < 6) { P1[10 + (i)] = __builtin_amdgcn_exp2f(P1[10 + (i)]); PN_PIN(P1); PN_SB; } \
          \
        h2 ps_; if ((i) > 0) { ps_ = PN_PAIR((i) - 1); PN_SB; } \
        pwe[2 * (i)] = pk2h(PN_PF(P0, P1, 4 * (i)), PN_PF(P0, P1, 4 * (i) + 1)); PN_PIN(pwe[2 * (i)]); PN_SB; \
        if ((i) == 1) hsA = ps_; else if ((i) > 1 && (i) <= 4) hsA = hsA + ps_; else if ((i) == 5) hsB = ps_; else if ((i) > 5) hsB = hsB + ps_; if ((i) > 0) { PN_SB; } \
        pwe[2 * (i) + 1] = pk2h(PN_PF(P0, P1, 4 * (i) + 2), PN_PF(P0, P1, 4 * (i) + 3)); PN_PIN(pwe[2 * (i) + 1]); PN_SB; } while (0)
#define PN_E1(C0, C1, idx) do { if ((idx) < 16) C0[(idx) & 15] = __builtin_amdgcn_exp2f(C0[(idx) & 15]); else C1[(idx) & 15] = __builtin_amdgcn_exp2f(C1[(idx) & 15]); } while (0)
#define PN_EXP4(C0, C1, i) do { if ((i) < 6) { PN_E1(C0, C1, 3 * (i)); PN_E1(C0, C1, 3 * (i) + 1); PN_E1(C0, C1, 3 * (i) + 2); } \
        else { PN_E1(C0, C1, 18 + 4 * ((i) - 6)); PN_E1(C0, C1, 19 + 4 * ((i) - 6)); PN_E1(C0, C1, 20 + 4 * ((i) - 6)); PN_E1(C0, C1, 21 + 4 * ((i) - 6)); } PN_PIN(C0); PN_PIN(C1); } while (0)
#define PN_PWV(s) ({ u4 q_; q_.x = pwe[4 * (s)]; q_.y = pwe[4 * (s) + 1]; q_.z = pwe[4 * (s) + 2]; q_.w = pwe[4 * (s) + 3]; __builtin_bit_cast(h8, q_); })
#define PN_PV(i) o[((i) >> 2) * 2 + ((i) & 1)] = mfma16(vfr[(((i) >> 1) & 1) * 2 + ((i) & 1)], PN_PWV((i) >> 1), o[((i) >> 2) * 2 + ((i) & 1)])
#define PN_GAPB(i, C0, C1) do { PN_PV(i); PN_EXP4(C0, C1, i); PN_SB; } while (0)
#define PN_STEP(C0, C1, P0, P1, t, S) do { PN_SB; \
        h2 hsA, hsB; C0 = neg4_16(); C1 = neg4_16(); \
        PN_GAPA(0, C0, C1, P0, P1, ((S) + 3) & 3); PN_GAPA(1, C0, C1, P0, P1, ((S) + 3) & 3); PN_GAPA(2, C0, C1, P0, P1, ((S) + 3) & 3); PN_GAPA(3, C0, C1, P0, P1, ((S) + 3) & 3); \
        PN_GAPA(4, C0, C1, P0, P1, ((S) + 3) & 3); PN_GAPA(5, C0, C1, P0, P1, ((S) + 3) & 3); PN_GAPA(6, C0, C1, P0, P1, ((S) + 3) & 3); PN_GAPA(7, C0, C1, P0, P1, ((S) + 3) & 3); \
        { const h2 ps7_ = PN_PAIR(7); hsB = hsB + ps7_; PN_SB; } l0 += (float)hsA[0] + (float)hsA[1]; l1 += (float)hsB[0] + (float)hsB[1]; \
        PN_KDMA((t) + 3, ((S) + 3) & 3); PN_VDMA((t) + 2, ((S) + 2) & 3); PN_SB; \
        PN_GAPB(0, C0, C1); PN_GAPB(1, C0, C1); \
        PN_KRD(0, ((S) + 1) & 3); PN_SB; PN_GAPB(2, C0, C1); PN_KRD(1, ((S) + 1) & 3); PN_SB; PN_GAPB(3, C0, C1); \
        PN_KRD(2, ((S) + 1) & 3); PN_SB; PN_GAPB(4, C0, C1); PN_KRD(3, ((S) + 1) & 3); PN_SB; PN_GAPB(5, C0, C1); \
        PN_GAPB(6, C0, C1); PN_GAPB(7, C0, C1); \
        PN_BAR8; } while (0)
    int t = 1;
#pragma unroll 1
    for (; t + 3 < T; t += 4) { PN_STEP(b0, b1, a0, a1, t, 1); PN_STEP(a0, a1, b0, b1, t + 1, 2); PN_STEP(b0, b1, a0, a1, t + 2, 3); PN_STEP(a0, a1, b0, b1, t + 3, 0); }
    PN_STEP(b0, b1, a0, a1, t, 1); PN_STEP(a0, a1, b0, b1, t + 1, 2); PN_STEP(b0, b1, a0, a1, t + 2, 3);
    {
#pragma unroll
        for (int i = 10; i < 16; ++i) b1[i] = __builtin_amdgcn_exp2f(b1[i]);
        float s0 = 0.f, s1 = 0.f;
#pragma unroll
        for (int i = 0; i < 16; ++i) { s0 += b0[i]; s1 += b1[i]; }
        l0 += s0; l1 += s1;
#pragma unroll
        for (int s4 = 0; s4 < 4; ++s4)
#pragma unroll
            for (int e = 0; e < 4; ++e) pwe[4 * s4 + e] = (s4 < 2) ? pk2h(b0[8 * s4 + 2 * e], b0[8 * s4 + 2 * e + 1]) : pk2h(b1[8 * (s4 - 2) + 2 * e], b1[8 * (s4 - 2) + 2 * e + 1]);
#pragma unroll
        for (int v = 0; v < 4; ++v) PN_VRD(v, 3);
        PN_PV(0); PN_PV(1); PN_PV(2); PN_PV(3); PN_PV(4); PN_PV(5); PN_PV(6); PN_PV(7);
    }
    asm volatile("s_waitcnt vmcnt(0)" ::: "memory");
    PN_BAR;
#undef PN_KDMA
#undef PN_VDMA
#undef PN_KRD
#undef PN_VRD
#undef PN_SB
#undef PN_PIN
#undef PN_BAR
#undef PN_BAR8
#undef PN_PF
#undef PN_GAPA
#undef PN_EXP4
#undef PN_E1
#undef PN_GAPB
#undef PN_PV
#undef PN_PAIR
#undef PN_PWV
#undef PN_STEP
    l0 += shflx(l0, 32, lane); l1 += shflx(l1, 32, lane);
    float* mg = (float*)lds;
    float* mgw = mg + (size_t)((w & 3) * 66) * 64 + lane;
    if (kg == 1) {
#pragma unroll
        for (int j = 0; j < 4; ++j)
#pragma unroll
            for (int i = 0; i < 16; ++i) mgw[(j * 16 + i) * 64] = o[j][i];
        mgw[64 * 64] = l0; mgw[65 * 64] = l1;
    }
    __syncthreads();
    if (kg == 0) {
#pragma unroll
        for (int j = 0; j < 4; ++j)
#pragma unroll
            for (int i = 0; i < 16; ++i) o[j][i] += mgw[(j * 16 + i) * 64];
        l0 += mgw[64 * 64]; l1 += mgw[65 * 64];
#pragma unroll
        for (int cb = 0; cb < 2; ++cb) {
            const float inv = 1.0f / (cb ? l1 : l0);
            hf* dst = (hf*)(P.ws + OFF_MIX) + (size_t)(qbase + r31) * 1024 + J.outcol + cb * 64;
#pragma unroll
            for (int dt = 0; dt < 2; ++dt)
#pragma unroll
                for (int rg = 0; rg < 4; ++rg) { h4 ov;
#pragma unroll
                    for (int e = 0; e < 4; ++e) ov[e] = (hf)(o[cb * 2 + dt][rg * 4 + e] * inv);
                    *(h4*)(dst + dt * 32 + rg * 8 + 4 * h) = ov; }
        }
    }
    __syncthreads();
}

__device__ __forceinline__ void ssd_out_unit(const Params& P, int layer, int cid, int g, int lh0, int lh1, char* lds) {
    const int tid = opaque_tid(), lane = tid & 63, w = tid >> 6, hh = w & 3, lt = w >> 2, r31 = lane & 31, h = lane >> 5;
    const int t0 = cid * 128, head = g * 4 + hh;
    float* tab = (float*)lds;
    float* sstab = (float*)(lds + 8192);
    char* Bm = lds + 16384;
    char* XT = lds + 49152;
    const hf* U = (const hf*)(P.ws + OFF_U); const hf* UT = (const hf*)(P.ws + OFF_UT); const hf* HS = (const hf*)(P.ws + OFF_HS);
    const hf* Z = (const hf*)(P.ws + OFF_Z); const float* DTP = (const float*)(P.ws + OFF_DTP);
    const int lq = lt * 32 + r31;
    stage_rows16<128>(U + (size_t)t0 * 1024 + 512 + g * 128, 1024, Bm, tid);
    stage_rows8<256>(UT + (size_t)(g * 256) * NT + t0, NT, XT, tid);
    if (w < 4) {
        const int hd = g * 4 + w;
        float* tbw = tab + w * 512;
#pragma unroll
        for (int dir = 0; dir < 2; ++dir) {
            const float a = -expf(P.a_log[layer * 16 + dir * 8 + hd]);
            const float dt0 = DTP[(size_t)(t0 + 2 * lane) * 16 + dir * 8 + hd], dt1 = DTP[(size_t)(t0 + 2 * lane + 1) * 16 + dir * 8 + hd];
            const float d0 = dt0 * a, d1 = dt1 * a;
            const float inc1 = wave_incl_scan(d0 + d1, lane), inc0 = inc1 - d1;
            const float total = rdlane(inc1, 63);
            const float c0 = (dir == 0 ? inc0 : total - inc0 + d0) * LOG2E, c1 = (dir == 0 ? inc1 : total - inc1 + d1) * LOG2E;
            tbw[dir * 128 + 2 * lane] = c0; tbw[dir * 128 + 2 * lane + 1] = c1;
            tbw[256 + dir * 128 + 2 * lane] = c0 - __builtin_amdgcn_logf(dt0); tbw[256 + dir * 128 + 2 * lane + 1] = c1 - __builtin_amdgcn_logf(dt1);
        }
    }
    __syncthreads();
    int lh = lh0;
    h8 cfn[8];
    { const int tid = opaque_tid(), lane = tid & 63, w = tid >> 6;
      const size_t row0 = (size_t)(t0 + lh0 * 64 + (w >> 2) * 32 + (lane & 31));
#pragma unroll
      for (int kk = 0; kk < 8; ++kk) cfn[kk] = *(const h8*)(U + row0 * 1024 + 768 + g * 128 + kk * 16 + 8 * (lane >> 5)); }
#pragma unroll 1
    do {
    const int tid = opaque_tid(), lane = tid & 63, w = tid >> 6, hh = w & 3, lt = w >> 2, r31 = lane & 31, h = lane >> 5;
    const int head = g * 4 + hh, lq = lt * 32 + r31;
    const int lloc = lh * 64 + lq;
    const size_t lrow = (size_t)(t0 + lloc);
    h8 cf[8];
#pragma unroll
    for (int kk = 0; kk < 8; ++kk) cf[kk] = cfn[kk];
    h8 hs0[2][8];
    { const hf* hp = HS + (size_t)((cid * 2 + 0) * 8 + head) * 8192 + (size_t)r31 * 128 + 8 * h;
#pragma unroll
      for (int pt = 0; pt < 2; ++pt)
#pragma unroll
          for (int kk = 0; kk < 8; ++kk) hs0[pt][kk] = *(const h8*)(hp + pt * 32 * 128 + kk * 16); }
    const float* tb = tab + hh * 512;
    fx16 Y[2]; Y[0] = zero16(); Y[1] = zero16();
    const float aFl = tb[lloc], aBl = tb[128 + lloc];
    const int sw16 = r31 & 15;
#pragma unroll
    for (int st = 0; st < 4; ++st) {
        h8 bf[8];
#pragma unroll
        for (int kk = 0; kk < 8; ++kk) bf[kk] = *(const h8*)(Bm + (st * 32 + r31) * 256 + (((2 * kk + h) ^ sw16) << 4));
        h8 xf[2][2];
#pragma unroll
        for (int sh = 0; sh < 2; ++sh)
#pragma unroll
            for (int pt = 0; pt < 2; ++pt) {
                const int q0 = 4 * (st * 2 + sh) + h;
                const LAS char* rowp = (const LAS char*)XT + (hh * 64 + pt * 32 + r31) * 256;
                const h4 v0 = *(const volatile LAS h4*)(rowp + ((q0 ^ r31) << 3)), v1 = *(const volatile LAS h4*)(rowp + (((q0 + 2) ^ r31) << 3));
                h8 x; x[0] = v0[0]; x[1] = v0[1]; x[2] = v0[2]; x[3] = v0[3]; x[4] = v1[0]; x[5] = v1[1]; x[6] = v1[2]; x[7] = v1[3];
                xf[sh][pt] = x;
            }
        __builtin_amdgcn_sched_barrier(0);
        fx16 T = zero16();
#pragma unroll
        for (int kk = 0; kk < 8; ++kk) T = mfma16(bf[kk], cf[kk], T);
#pragma unroll
        for (int rg = 0; rg < 4; ++rg) {
            const int s0 = st * 32 + rg * 8 + 4 * h;
            const f4 eFs = *(const f4*)(tb + 256 + s0), eBs = *(const f4*)(tb + 384 + s0);
#pragma unroll
            for (int e = 0; e < 4; ++e) {
                const int s = s0 + e;
                const float xf = s <= lloc ? aFl - eFs[e] : -INFINITY, xb = s >= lloc ? aBl - eBs[e] : -INFINITY;
                T[rg * 4 + e] *= __builtin_amdgcn_exp2f(xf) + __builtin_amdgcn_exp2f(xb);
            }
        }
#pragma unroll
        for (int sh = 0; sh < 2; ++sh) {
            h8 pf;
#pragma unroll
            for (int e = 0; e < 8; ++e) pf[e] = (hf)T[8 * sh + e];
#pragma unroll
            for (int pt = 0; pt < 2; ++pt) Y[pt] = mfma16(xf[sh][pt], pf, Y[pt]);
        }
    }
    h4 xsv[2][4], zzv[2][4];
    {
        h8 hs1[2][8];
        { const hf* hp = HS + (size_t)((cid * 2 + 1) * 8 + head) * 8192 + (size_t)r31 * 128 + 8 * h;
#pragma unroll
          for (int pt = 0; pt < 2; ++pt)
#pragma unroll
              for (int kk = 0; kk < 8; ++kk) hs1[pt][kk] = *(const h8*)(hp + pt * 32 * 128 + kk * 16); }
        __builtin_amdgcn_sched_barrier(0);
        const float exF = __builtin_amdgcn_exp2f(aFl), exB = __builtin_amdgcn_exp2f(aBl);
#pragma unroll
        for (int pt = 0; pt < 2; ++pt) {
            fx16 tmp = zero16();
#pragma unroll
            for (int kk = 0; kk < 8; ++kk) tmp = mfma16(hs0[pt][kk], cf[kk], tmp);
            Y[pt] += tmp * exF;
        }
        __builtin_amdgcn_sched_barrier(0);
#pragma unroll
        for (int pt = 0; pt < 2; ++pt)
#pragma unroll
            for (int rg = 0; rg < 4; ++rg) {
                const int p = pt * 32 + rg * 8 + 4 * h;
                xsv[pt][rg] = *(const h4*)(U + lrow * 1024 + head * 64 + p); zzv[pt][rg] = *(const h4*)(Z + lrow * 512 + head * 64 + p);
            }
        __builtin_amdgcn_sched_barrier(0);
#pragma unroll
        for (int pt = 0; pt < 2; ++pt) {
            fx16 tmp = zero16();
#pragma unroll
            for (int kk = 0; kk < 8; ++kk) tmp = mfma16(hs1[pt][kk], cf[kk], tmp);
            Y[pt] += tmp * exB;
        }
    }
    if (lh + 1 < lh1) {
#pragma unroll
        for (int kk = 0; kk < 8; ++kk) cfn[kk] = *(const h8*)(U + (lrow + 64) * 1024 + 768 + g * 128 + kk * 16 + 8 * h);
    }
    const float dsk = P.d_skip[layer * 8 + head];
    float ss = 0.f;
#pragma unroll
    for (int pt = 0; pt < 2; ++pt)
#pragma unroll
        for (int rg = 0; rg < 4; ++rg) {
            const h4 xs = xsv[pt][rg], zz = zzv[pt][rg];
#pragma unroll
            for (int e = 0; e < 4; ++e) { const float y = Y[pt][rg * 4 + e] + (float)xs[e] * dsk; const float gv = y * silu_f((float)zz[e]); Y[pt][rg * 4 + e] = gv; ss += gv * gv; }
        }
    ss += shflx(ss, 32, lane);
    if (h == 0) sstab[hh * 64 + lq] = ss;
    __syncthreads();
    {
        const float tot = (sstab[lq] + sstab[64 + lq]) + (sstab[128 + lq] + sstab[192 + lq]);
        const float rstd = 1.0f / sqrtf(tot * (1.0f / 256.0f) + 1e-6f);
        hf* dst = (hf*)(P.ws + OFF_MIX) + lrow * 1024 + 512 + head * 64;
#pragma unroll
        for (int pt = 0; pt < 2; ++pt)
#pragma unroll
            for (int rg = 0; rg < 4; ++rg) {
                const int p = pt * 32 + rg * 8 + 4 * h;
                const f4 gw = *(const f4*)(P.gnorm_w + layer * 512 + head * 64 + p);
                h4 ov;
#pragma unroll
                for (int e = 0; e < 4; ++e) ov[e] = (hf)(Y[pt][rg * 4 + e] * rstd * gw[e]);
                *(h4*)(dst + p) = ov;
            }
    }
    __syncthreads();
    } while (++lh < lh1);
}

#if defined(DBG_NAIVE_ATTN)
__device__ __forceinline__ void naive_attn(const Params& P, int layer, char* lds) {
    const int tid = opaque_tid(), lane = tid & 63, w = tid >> 6;
    const hf* qkv = (const hf*)(P.ws + OFF_QKV);
    float* qs = (float*)lds + w * 64;
    const int nrows = layer == 0 ? NT : NL;
    for (int item = blockIdx.x * 8 + w; item < nrows * 8; item += gridDim.x * 8) {
        const int row = item >> 3, hd8 = item & 7, isB = hd8 >> 2, head = hd8 & 3, kvh = head >> 1, base = isB ? 8 : 0;
        const hf* Q = qkv + (size_t)(base + head) * HT + (size_t)row * 64;
        const hf* K = qkv + (size_t)(base + 4 + kvh) * HT;
        const hf* VT = qkv + (size_t)(base + 6 + kvh) * HT;
        qs[lane] = (float)Q[lane];
        __builtin_amdgcn_s_waitcnt(0);
        float m = -1e30f, l = 0.f, o = 0.f;
        int r0a, r1a, r0b = 0, r1b = 0;
        if (row >= NL) { r0a = NL; r1a = NT; }
        else if (isB) { r0a = 0; r1a = NT; }
        else { r0a = NL; r1a = NT; r0b = row - 128 < 0 ? 0 : row - 128; r1b = row + 129 > NL ? NL : row + 129; }
        for (int rng = 0; rng < 2; ++rng) {
            const int k0 = rng ? r0b : r0a, k1 = rng ? r1b : r1a;
            for (int kb = k0; kb < k1; kb += 64) {
                const int key = kb + lane; const bool ok = key < k1;
                float s = -1e30f;
                if (ok) { s = 0.f; const hf* kp = K + (size_t)key * 64; for (int d = 0; d < 64; ++d) s += qs[d] * (float)kp[d]; }
                float mx = s;
                for (int dd = 32; dd >= 1; dd >>= 1) mx = fmaxf(mx, __shfl_xor(mx, dd));
                const float mn = fmaxf(m, mx), alpha = exp2f(m - mn);
                const float p = ok ? exp2f(s - mn) : 0.f;
                float ps = p;
                for (int dd = 32; dd >= 1; dd >>= 1) ps += __shfl_xor(ps, dd);
                l = l * alpha + ps; o *= alpha; m = mn;
                const int cnt = k1 - kb < 64 ? k1 - kb : 64;
                for (int j = 0; j < cnt; ++j) { const float pj = __shfl(p, j); o += pj * (float)VT[(size_t)lane * NT + kb + j]; }
            }
        }
        if (!isB) l += exp2f(P.sink[layer * 4 + head] * LOG2E - m);
        ((hf*)(P.ws + OFF_MIX))[(size_t)row * 1024 + (isB ? 256 : 0) + head * 64 + lane] = (hf)(o / l);
    }
}
#endif
#if defined(DBG_NAIVE_SSD)
__device__ __forceinline__ void naive_ssd_scan(const Params& P, int layer) {
    const int tid = opaque_tid(), lane = tid & 63, w = tid >> 6;
    const hf* U = (const hf*)(P.ws + OFF_U); const float* DTP = (const float*)(P.ws + OFF_DTP);
    float* Y = (float*)(P.ws + OFF_HS);
    for (int item = blockIdx.x * 8 + w; item < 512; item += gridDim.x * 8) {
        const int head = item >> 6, p = item & 63, g = head >> 2;
        for (int dir = 0; dir < 2; ++dir) {
            const float a = -expf(P.a_log[layer * 16 + dir * 8 + head]);
            float s0 = 0.f, s1 = 0.f;
            for (int step = 0; step < NT; ++step) {
                int t;
                if (dir == 0) t = step < NCX ? NL + step : step - NCX;
                else t = step < NCX ? NT - 1 - step : NL - 1 - (step - NCX);
                const float dt = DTP[(size_t)t * 16 + dir * 8 + head];
                const float x = (float)U[(size_t)t * 1024 + head * 64 + p];
                const float b0 = (float)U[(size_t)t * 1024 + 512 + g * 128 + lane], b1 = (float)U[(size_t)t * 1024 + 512 + g * 128 + 64 + lane];
                const float c0 = (float)U[(size_t)t * 1024 + 768 + g * 128 + lane], c1 = (float)U[(size_t)t * 1024 + 768 + g * 128 + 64 + lane];
                const float dec = expf(a * dt);
                s0 = s0 * dec + dt * b0 * x; s1 = s1 * dec + dt * b1 * x;
                float y = c0 * s0 + c1 * s1;
                for (int dd = 32; dd >= 1; dd >>= 1) y += __shfl_xor(y, dd);
                if (lane == 0) { float* yp = Y + (size_t)t * 512 + head * 64 + p; *yp = dir == 0 ? y : *yp + y; }
            }
        }
    }
}
__device__ __forceinline__ void naive_ssd_finish(const Params& P, int layer) {
    const int tid = opaque_tid(), lane = tid & 63, w = tid >> 6;
    const hf* U = (const hf*)(P.ws + OFF_U); const hf* Z = (const hf*)(P.ws + OFF_Z); const float* Y = (const float*)(P.ws + OFF_HS);
    const int nrows = layer == 0 ? NT : NL;
    for (int item = blockIdx.x * 8 + w; item < nrows * 2; item += gridDim.x * 8) {
        const int t = item >> 1, g = item & 1;
        float gv[4]; float ss = 0.f;
        for (int i = 0; i < 4; ++i) { const int ch = g * 256 + i * 64 + lane; const float y = Y[(size_t)t * 512 + ch] + (float)U[(size_t)t * 1024 + ch] * P.d_skip[layer * 8 + (ch >> 6)];
            const float z = (float)Z[(size_t)t * 512 + ch]; gv[i] = y * (z / (1.0f + expf(-z))); ss += gv[i] * gv[i]; }
        for (int dd = 32; dd >= 1; dd >>= 1) ss += __shfl_xor(ss, dd);
        const float rstd = 1.0f / sqrtf(ss / 256.0f + 1e-6f);
        for (int i = 0; i < 4; ++i) { const int ch = g * 256 + i * 64 + lane; ((hf*)(P.ws + OFF_MIX))[(size_t)t * 1024 + 512 + ch] = (hf)(gv[i] * rstd * P.gnorm_w[layer * 512 + ch]); }
    }
}
#endif
#if defined(DBG_NAIVE_INPROJ)
__device__ __forceinline__ void naive_inproj(const Params& P, int layer) {
    const int tid = opaque_tid(), lane = tid & 63, w = tid >> 6;
    const hf* H = (const hf*)(P.ws + OFF_H16); const hf* W = (const hf*)(P.ws + OFF_WIN) + (size_t)layer * INP * D;
    hf* qkv = (hf*)(P.ws + OFF_QKV);
    for (int item = blockIdx.x * 8 + w; item < NT * 16; item += gridDim.x * 8) {
        const int t = item >> 4, fb = item & 15, sub = fb & 7;
        const hf* hp = H + (size_t)t * D; const hf* wp = W + (size_t)(fb * 64 + lane) * D;
        float acc = 0.f;
        for (int k = 0; k < D; k += 8) { const h8 a = *(const h8*)(hp + k), b = *(const h8*)(wp + k); for (int j = 0; j < 8; ++j) acc += (float)a[j] * (float)b[j]; }
        float v = acc;
        if (sub < 6) {
            if (fb >= 8) { float ss = v * v; for (int dd = 32; dd >= 1; dd >>= 1) ss += __shfl_xor(ss, dd); v = v * (1.0f / sqrtf(ss / 64.0f + 1e-6f)) * (sub < 4 ? P.q_gain : P.k_gain)[layer * 64 + lane]; }
            if (t < NL) {
                const int axis = lane >> 5, half = (lane >> 4) & 1, f = lane & 15;
                const float pos = (float)(axis == 0 ? (t >> 6) : (t & 63));
                const float inv = powf(10000.0f, -(float)f / 16.0f); const float ang = pos * inv;
                const float other = __shfl_xor(v, 16);
                const float cs = cosf(ang), sn = sinf(ang);
                v = half == 0 ? v * cs - other * sn : other * sn + v * cs;
            }
            if (sub < 4) v *= 0.125f * LOG2E;
            qkv[(size_t)fb * HT + (size_t)t * 64 + lane] = (hf)v;
        } else qkv[(size_t)fb * HT + (size_t)lane * NT + t] = (hf)v;
    }
}
#endif


#if defined(DBG_NAIVE_INPROJ2)
__device__ __forceinline__ void naive_inproj2(const Params& P, int layer) {
    const int tid = opaque_tid(), lane = tid & 63, w = tid >> 6;
    const hf* H = (const hf*)(P.ws + OFF_H16); const hf* W = (const hf*)(P.ws + OFF_WIN) + (size_t)layer * INP * D;
    for (int item = blockIdx.x * 8 + w; item < NT * 25; item += gridDim.x * 8) {
        const int t = item / 25, fb = 16 + item % 25;
        const hf* hp = H + (size_t)t * D; const hf* wp = W + (size_t)(fb * 64 + lane) * D;
        float acc = 0.f;
        for (int k = 0; k < D; k += 8) { const h8 a = *(const h8*)(hp + k), b = *(const h8*)(wp + k); for (int j = 0; j < 8; ++j) acc += (float)a[j] * (float)b[j]; }
        if (fb < 24) ((hf*)(P.ws + OFF_Z))[(size_t)t * 512 + (fb - 16) * 64 + lane] = (hf)acc;
        else if (fb < 40) ((hf*)(P.ws + OFF_XBC))[(size_t)t * 1024 + (fb - 24) * 64 + lane] = (hf)acc;
        else if (lane < 16) ((float*)(P.ws + OFF_DTR))[(size_t)t * 16 + lane] = acc;
    }
}
#endif
#if defined(DBG_NAIVE_PREP)
__device__ __forceinline__ void naive_prep(const Params& P, int layer) {
    const hf* XBC = (const hf*)(P.ws + OFF_XBC); hf* U = (hf*)(P.ws + OFF_U); hf* UT = (hf*)(P.ws + OFF_UT);
    for (size_t e = (size_t)blockIdx.x * 512 + opaque_tid(); e < (size_t)NT * 1024; e += (size_t)gridDim.x * 512) {
        const int t = (int)(e >> 10), ch = (int)(e & 1023);
        const int seg0 = t < NL ? 0 : NL, seg1 = t < NL ? NL : NT;
        float s = P.conv_b[layer * 1024 + ch];
        for (int k = 0; k < 5; ++k) { const int tt = t + k - 2; if (tt >= seg0 && tt < seg1) s += P.conv_w[(size_t)layer * 5120 + k * 1024 + ch] * (float)XBC[(size_t)tt * 1024 + ch]; }
        const hf o = (hf)(s / (1.0f + expf(-s)));
        U[e] = o; if (ch < 768) UT[(size_t)ch * NT + t] = o;
    }
    const float* dr = (const float*)(P.ws + OFF_DTR); float* dp = (float*)(P.ws + OFF_DTP);
    for (int e = blockIdx.x * 512 + opaque_tid(); e < NT * 16; e += gridDim.x * 512) { const float xv = dr[e] + P.dt_bias[layer * 16 + (e & 15)]; dp[e] = xv > 20.f ? xv : log1pf(expf(xv)); }
}
#endif
#if defined(DBG_NAIVE_GEMM)
__device__ __forceinline__ void naive_res_gemm(const Params& P, const hf* A, const hf* Wt, int K, int nrows, int layer, int which_g, char* lds) {
    const int tid = opaque_tid(); float* ar = (float*)lds;
    for (int t = blockIdx.x; t < nrows; t += gridDim.x) {
        for (int k = tid; k < K; k += 512) ar[k] = (float)A[(size_t)t * K + k];
        __syncthreads();
        float* xr = xr_row(P, t); const float* g = modv(P, layer, t >= NL ? 1 : 0, which_g);
        for (int n = tid; n < D; n += 512) { const hf* wp = Wt + (size_t)n * K; float acc = 0.f;
            for (int k = 0; k < K; k += 8) { const h8 b = *(const h8*)(wp + k); for (int j = 0; j < 8; ++j) acc += ar[k + j] * (float)b[j]; }
            xr[n] = ALPHA * xr[n] + g[n] * acc; }
        __syncthreads();
    }
}
__device__ __forceinline__ void naive_gu_gemm(const Params& P, int layer, int nrows, char* lds) {
    const int tid = opaque_tid(); float* ar = (float*)lds;
    const hf* A = (const hf*)(P.ws + OFF_H16); hf* G = (hf*)(P.ws + OFF_G16);
    for (int t = blockIdx.x; t < nrows; t += gridDim.x) {
        for (int k = tid; k < D; k += 512) ar[k] = (float)A[(size_t)t * D + k];
        __syncthreads();
        for (int j = tid; j < DFF; j += 512) { float ag = 0.f, au = 0.f;
            for (int k = 0; k < D; ++k) { const float a = ar[k]; ag += a * (float)(hf)P.w_gu[(size_t)layer * D * NGU + (size_t)k * NGU + j]; au += a * (float)(hf)P.w_gu[(size_t)layer * D * NGU + (size_t)k * NGU + DFF + j]; }
            G[(size_t)t * DFF + j] = (hf)((ag / (1.0f + expf(-ag))) * au); }
        __syncthreads();
    }
}
#endif

__device__ __forceinline__ void phase_mix(const Params& P, int layer, char* lds) {
    const hf* qkv = (const hf*)(P.ws + OFF_QKV);
    const int ssd_end = 512 + (layer == 0 ? 264 : 256);
    const int nunits = ssd_end + (layer == 0 ? 8 : 0);
    float gq = 0.f, gk = 0.f;
    for (int i = 0; i < 64; ++i) { gq = fmaxf(gq, fabsf(P.q_gain[layer * 64 + i])); gk = fmaxf(gk, fabsf(P.k_gain[layer * 64 + i])); }
    const bool nomax_ok = 0.125f * LOG2E * 64.0f * gq * gk * 1.01f <= 14.0f;
#if defined(DBG_NAIVE_INPROJ)
    naive_inproj(P, layer); cg::this_grid().sync();
#endif
#if defined(DBG_NAIVE_ATTN)
    naive_attn(P, layer, lds); __syncthreads();
#endif
#if defined(DBG_NAIVE_SSD)
    naive_ssd_scan(P, layer); cg::this_grid().sync(); naive_ssd_finish(P, layer);
#endif
#pragma unroll 1
    for (int u = blockIdx.x; u < nunits; u += gridDim.x) {
#if defined(DBG_NAIVE_SSD)
        if (u >= 512 && u < ssd_end) continue;
#endif
#if defined(DBG_NAIVE_ATTN)
        if (u < 512 || u >= ssd_end) continue;
#endif
        if (u >= 512 && u < ssd_end) { const int i = u - 512;
            int cid = i >> 1, g = i & 1, l0 = 0, l1 = 2;
            if (i >= 256) { const int j = i - 256; cid = 128 + (j >> 2); g = (j >> 1) & 1; l0 = j & 1; l1 = l0 + 1; }
            ssd_out_unit(P, layer, cid, g, l0, l1, lds);
            continue; }
        int base, kvh, qrow0, ta0, na, tb0 = 0, nb = 0, use_sink, outcol;
        if (u < 256) {
            kvh = u & 1; base = 8; qrow0 = (u >> 1) * 128; ta0 = 0; na = 260; use_sink = 0; outcol = 256 + kvh * 128;
        } else if (u < 512) {
            const int i = u - 256, qb = i >> 1; kvh = i & 1; base = 0; qrow0 = qb * 128; ta0 = 256; na = 4;
            const int lo = 2 * qb - 2 < 0 ? 0 : 2 * qb - 2, hi = 2 * qb + 4 > 256 ? 256 : 2 * qb + 4;
            tb0 = lo; nb = hi - lo; use_sink = 1; outcol = kvh * 128;
        } else {
            const int i = u - ssd_end, isB = i >> 2, cq = i & 1; kvh = (i >> 1) & 1; base = isB ? 8 : 0;
            qrow0 = NL + cq * 128; ta0 = 256; na = 4; use_sink = isB ? 0 : 1; outcol = (isB ? 256 : 0) + kvh * 128;
        }
        AttnJob J; J.Q0 = qkv + (size_t)(base + 2 * kvh) * HT; J.Q1 = qkv + (size_t)(base + 1 + 2 * kvh) * HT; J.K = qkv + (size_t)(base + 4 + kvh) * HT; J.VT = qkv + (size_t)(base + 6 + kvh) * HT;
        J.qrow0 = qrow0; J.ta0 = ta0; J.na = na; J.tb0 = tb0; J.nb = nb; J.use_sink = use_sink; J.sink0 = P.sink[layer * 4 + 2 * kvh]; J.sink1 = P.sink[layer * 4 + 2 * kvh + 1]; J.outcol = outcol;
        if (u < 256 && nomax_ok) attn_unit_pin(P, J, lds); else attn_unit<false>(P, J, lds);
#if defined(PROBE_MIX_A)
        if (u >= 256) attn_unit<false>(P, J, lds);
#endif
#if defined(PROBE_MIX_B)
        if (u < 256) attn_unit<true>(P, J, lds);
#endif
    }
}

constexpr int PPL = 8;
constexpr int NPHASES = 3 + PPL * 2;

__device__ __forceinline__ void run_phase(const Params& P, int ph, char* lds) {
    if (ph == 0) { phase_p0(P, lds); return; }
    if (ph == 1) { phase_modfin(P); return; }
    if (ph == 2) { phase_rows(P, 0, NT, nullptr, nullptr, 0, 0, 1); return; }
    const int layer = (ph - 3) / PPL, sub0 = (ph - 3) % PPL;
    const bool pre_out = layer == 0 && sub0 == 6, pre_dn = layer == 1 && sub0 == 0;
    const int nsteps = (pre_out || pre_dn) ? 2 : 1;
    const int layer_ = layer;
#pragma unroll 1
    for (int step = 0; step < nsteps; ++step) {
        const bool ctxout = pre_out && step == 0, ctxdn = pre_dn && step == 0;
        const int sub = ctxout ? 5 : ctxdn ? 7 : sub0;
        const int layer = ctxdn ? 0 : layer_;
        const int mt = ctxdn ? 65 : (layer == 0 ? (sub == 7 ? 64 : 65) : 64);
        switch (sub) {
            case 0: { EpiIn e{P, layer}; gemm_phase(( const hf*)(P.ws + OFF_H16), (const hf*)(P.ws + OFF_WIN) + (size_t)layer * INP * D, 65, 11, D, e, lds, layer == 1 ? 4 : 0); } break;
            case 1: phase_prep(P, layer, lds); break;
            case 2: phase_ssd_states(P, layer, lds); break;
            case 3: phase_ssd_scan(P); break;
            case 4: phase_mix(P, layer, lds); break;
            case 5: { EpiResLN e{P, layer, 2, layer == 0 ? nullptr : P.ln2_g + (layer - 1) * D, layer == 0 ? nullptr : P.ln2_b + (layer - 1) * D,
                                 P.ln1_g + layer * D, P.ln1_b + layer * D, layer, 3, 4, 0, layer * 2};
                      gemm_phase((const hf*)(P.ws + OFF_MIX), (const hf*)(P.ws + OFF_WOUT) + (size_t)layer * D * D, ctxout ? 1 : 64, 4, D, e, lds, ctxout ? 1 : 0); } break;
            case 6: { EpiGU e{P}; gemm_phase((const hf*)(P.ws + OFF_H16), (const hf*)(P.ws + OFF_WGU) + (size_t)layer * NGU * D, mt, 22, D, e, lds, layer == 0 ? 2 : 0); } break;
            case 7: { EpiResLN e{P, layer, 5, P.ln1_g + layer * D, P.ln1_b + layer * D,
                                 P.ln2_g + layer * D, P.ln2_b + layer * D, layer == 0 ? 1 : 0, 0, 1, layer == 1 ? 1 : 0, layer * 2 + 1};
                      gemm_phase((const hf*)(P.ws + OFF_G16), (const hf*)(P.ws + OFF_WDN) + (size_t)layer * D * DFF, ctxdn ? 1 : mt, 4, DFF, e, lds, ctxdn ? 3 : 0); } break;
        }
    }
}

__global__ void __launch_bounds__(512) fwd_kernel(Params P) {
    extern __shared__ __attribute__((aligned(16))) char lds[];
    P.wv = __builtin_amdgcn_readfirstlane((int)(threadIdx.x >> 6));
    volatile LAS unsigned* st = (volatile LAS unsigned*)(lds + 131072);
    if (threadIdx.x < 4) st[threadIdx.x] = 0u;
    __syncthreads();
    const XcdBarrier xb = xcd_barrier_post((unsigned*)(P.ws + OFF_BAR), st);
#pragma unroll 1
    for (int ph = P.ph_lo; ph < P.ph_hi; ++ph) {
        run_phase(P, ph, lds);
#if defined(PROBE_REPEAT_SUB)
        { const int sub_ = ph >= 3 ? (ph - 3) % PPL : -1 - ph; if ((PROBE_REPEAT_MASK >> (sub_ + 3)) & 1) { xcd_barrier(xb); run_phase(P, ph, lds); } }
#endif
        if (ph + 1 < P.ph_hi) { if (ph == P.ph_lo) cg::this_grid().sync(); else xcd_barrier(xb); }
    }
}

constexpr int LDS_BYTES = 131072 + 256;

extern "C" void kernel_launch(void* const* d_in, const int* in_sizes, int n_in, void* d_out, int out_size, void* d_ws, size_t ws_size, hipStream_t stream) {
    static int grid = 0;
    if (grid == 0) {
        if (n_in != 23 || out_size != NL * D || ws_size < OFF_END) { fprintf(stderr, "kernel_launch: unexpected shapes (n_in %d out %d ws %zu need %zu)\n", n_in, out_size, ws_size, (size_t)OFF_END); grid = -1; return; }
        int dev = 0, cus = 0, per_cu = 0;
        hipGetDevice(&dev); hipDeviceGetAttribute(&cus, hipDeviceAttributeMultiprocessorCount, dev);
        hipFuncSetAttribute((const void*)fwd_kernel, hipFuncAttributeMaxDynamicSharedMemorySize, LDS_BYTES);
        hipOccupancyMaxActiveBlocksPerMultiprocessor(&per_cu, (const void*)fwd_kernel, 512, LDS_BYTES);
        if (per_cu < 1) { fprintf(stderr, "kernel_launch: occupancy query says %d blocks/CU\n", per_cu); }
        (void)hipGetLastError();
        grid = cus > 0 ? cus : 256;
    }
    if (grid < 0) return;
    Params p{};
    const float** pp = (const float**)&p;
    for (int i = 0; i < 23; ++i) pp[i] = (const float*)d_in[i];
    p.out = (float*)d_out; p.ws = (unsigned char*)d_ws;
#if MULTI_LAUNCH
    for (int ph = 0; ph < NPHASES; ++ph) { p.ph_lo = ph; p.ph_hi = ph + 1; hipLaunchKernelGGL(fwd_kernel, dim3(grid), dim3(512), LDS_BYTES, stream, p); }
#else
    p.ph_lo = 0; p.ph_hi = NPHASES;
    if (hipMemsetAsync((char*)d_ws + OFF_BAR, 0, 16384, stream) != hipSuccess) fprintf(stderr, "memset of barrier words failed\n");
    void* args[] = {&p};
    hipError_t e = hipLaunchCooperativeKernel((const void*)fwd_kernel, dim3(grid), dim3(512), args, LDS_BYTES, stream);
    if (e != hipSuccess) fprintf(stderr, "cooperative launch failed: %s (grid %d)\n", hipGetErrorString(e), grid);
#endif
}
```

```cpp
#include <hip/hip_runtime.h>
#include <hip/hip_cooperative_groups.h>
#include <cstdio>
#include <cstdint>
namespace cg = cooperative_groups;

#ifndef MULTI_LAUNCH
#define MULTI_LAUNCH 0
#endif

typedef _Float16 hf;
typedef hf h2 __attribute__((ext_vector_type(2)));
typedef hf h4 __attribute__((ext_vector_type(4)));
typedef hf h8 __attribute__((ext_vector_type(8)));
typedef float f4 __attribute__((ext_vector_type(4)));
typedef float fx16 __attribute__((ext_vector_type(16)));
typedef unsigned u4 __attribute__((ext_vector_type(4)));
typedef unsigned u2 __attribute__((ext_vector_type(2)));

constexpr int NL = 16384, NCX = 256, NT = 16640, D = 1024, INC = 2576, INP = 2816, DFF = 2816, NGU = 5632;
constexpr int NCHK = 130;
constexpr size_t HT = (size_t)NT * 64;
constexpr float LOG2E = 1.4426950408889634f;
constexpr float ALPHA = 1.4142135623730951f;

constexpr size_t OFF_WIN = 0;
constexpr size_t OFF_WOUT = OFF_WIN + (size_t)2 * INP * D * 2;
constexpr size_t OFF_WGU = OFF_WOUT + (size_t)2 * D * D * 2;
constexpr size_t OFF_WDN = OFF_WGU + (size_t)2 * NGU * D * 2;
constexpr size_t OFF_H16 = OFF_WDN + (size_t)2 * D * DFF * 2;
constexpr size_t OFF_SMALL = OFF_H16 + (size_t)NT * D * 2;
constexpr size_t OFF_MODP = OFF_SMALL;
constexpr size_t OFF_MOD = OFF_MODP + (size_t)8 * 2 * 2 * 6144 * 4;
constexpr size_t OFF_ROPE = OFF_MOD + (size_t)2 * 2 * 6144 * 4;
constexpr size_t OFF_XRC = OFF_ROPE + (size_t)256 * 16 * 2 * 4;
constexpr size_t OFF_DTR = OFF_XRC + (size_t)NCX * D * 4;
constexpr size_t OFF_DTP = OFF_DTR + (size_t)NT * 16 * 4;
constexpr size_t OFF_DEC = OFF_DTP + (size_t)NT * 16 * 4;
constexpr size_t OFF_BAR = OFF_DEC + 16384;
constexpr size_t OFF_CNT = OFF_BAR + 13824;
constexpr size_t OFF_STATS = OFF_BAR + 16384;
constexpr size_t OFF_BIG = OFF_SMALL + (size_t)4 * 1024 * 1024 + 262144;
constexpr size_t OFF_QKV = OFF_BIG;
constexpr size_t OFF_Z = OFF_QKV + 16 * HT * 2;
constexpr size_t OFF_XBC = OFF_Z + (size_t)NT * 512 * 2;
constexpr size_t OFF_HS = OFF_XBC;
constexpr size_t OFF_U = OFF_XBC + (size_t)NT * 1024 * 2;
constexpr size_t OFF_UT = OFF_U + (size_t)NT * 1024 * 2;
constexpr size_t OFF_XSL = OFF_UT;
constexpr size_t OFF_CS = OFF_UT + (size_t)768 * NT * 2;
constexpr size_t OFF_MIX = OFF_CS;
constexpr size_t OFF_G16 = OFF_BIG;
constexpr size_t OFF_END = OFF_CS + (size_t)NCHK * 2 * 8 * 64 * 128 * 2;
constexpr int XRB_SPLIT = 12288;
constexpr size_t OFF_XRB_A = ((OFF_G16 + (size_t)NT * DFF * 2 + 4095) / 4096) * 4096;
constexpr size_t OFF_XRB_B = OFF_UT + (size_t)1024 * 1024;
static_assert(OFF_XRB_A + (size_t)XRB_SPLIT * D * 2 <= OFF_UT && (size_t)NT * 32 <= (size_t)1024 * 1024 && OFF_XRB_B + (size_t)(NL - XRB_SPLIT) * D * 2 <= OFF_CS, "XRB overflow");
static_assert(NCHK * 2 * 8 * 4 <= 16384 && 3456 * 4 <= 16384 && OFF_STATS + (size_t)NT * 8 <= OFF_BIG, "small region overflow");
static_assert(OFF_G16 + (size_t)NT * DFF * 2 <= OFF_END, "G16 overflow");
static_assert(OFF_END <= (size_t)256 * 1024 * 1024, "workspace too large");

struct Params {
    const float* x; const float* c; const float* ctx; const float* c_ctx; const float* w_ada; const float* b_ada; const float* w_in;
    const float* sink; const float* q_gain; const float* k_gain; const float* conv_w; const float* conv_b; const float* a_log;
    const float* dt_bias; const float* d_skip; const float* gnorm_w; const float* w_out; const float* ln1_g; const float* ln1_b;
    const float* ln2_g; const float* ln2_b; const float* w_gu; const float* w_down;
    float* out; unsigned char* ws; int ph_lo, ph_hi; int wv;
};

__device__ __forceinline__ float silu_f(float x) { return x * __builtin_amdgcn_rcpf(1.0f + __builtin_amdgcn_exp2f(-x * LOG2E)); }
__device__ __forceinline__ hf* xr16_row(const Params& P, int row, bool in_ws) {
    if (row >= NL) return (hf*)(P.ws + OFF_XRC) + (size_t)(row - NL) * D;
    if (in_ws) return row < XRB_SPLIT ? (hf*)(P.ws + OFF_XRB_A) + (size_t)row * D : (hf*)(P.ws + OFF_XRB_B) + (size_t)(row - XRB_SPLIT) * D;
    return (hf*)P.out + (size_t)row * D;
}
__device__ __forceinline__ float* xr_row(const Params& P, int row) { return row < NL ? P.out + (size_t)row * D : (float*)(P.ws + OFF_XRC) + (size_t)(row - NL) * D; }
__device__ __forceinline__ const float* modv(const Params& P, int layer, int set, int which) { return (const float*)(P.ws + OFF_MOD) + (size_t)((layer * 2 + set) * 6 + which) * 1024; }
__device__ __forceinline__ u4 pair16(h4 a_, h4 b_) {
    const u2 a = __builtin_bit_cast(u2, a_), b = __builtin_bit_cast(u2, b_);
    const auto r0 = __builtin_amdgcn_permlane16_swap(a.x, b.x, false, false);
    const auto r1 = __builtin_amdgcn_permlane16_swap(a.y, b.y, false, false);
    u4 w; w.x = r0[0]; w.y = r1[0]; w.z = r0[1]; w.w = r1[1]; return w;
}
__device__ __forceinline__ int pair_off(int fq) { return (fq & 1) ? 16 + (fq - 1) * 4 : fq * 4; }
__device__ __forceinline__ fx16 mfma16(h8 a, h8 b, fx16 c) { return __builtin_amdgcn_mfma_f32_32x32x16_f16(a, b, c, 0, 0, 0); }
__device__ __forceinline__ int opaque_tid_w(int wv) { int z = 0; asm volatile("" : "+v"(z)); const int lane = __builtin_amdgcn_mbcnt_hi(-1, __builtin_amdgcn_mbcnt_lo(-1, z)); return (wv << 6) | lane; }
#define opaque_tid() opaque_tid_w(P.wv)
__device__ __forceinline__ float shflx(float v, int mask, int lane) { return __builtin_bit_cast(float, __builtin_amdgcn_ds_bpermute((lane ^ mask) << 2, __builtin_bit_cast(int, v))); }
__device__ __forceinline__ float rdlane(float v, int l) { return __builtin_bit_cast(float, __builtin_amdgcn_readlane(__builtin_bit_cast(int, v), l)); }
__device__ __forceinline__ fx16 zero16() { fx16 z; for (int i = 0; i < 16; ++i) z[i] = 0.f; return z; }


#define XB_TMO      128
#define XB_XCNT(j)  (256  + 64 * (j))
#define XB_XSUB(j)  (1280 + 64 * (j))
#define XB_XGEN(j)  (2304 + 64 * (j))
#define XB_TOP      3328
#define XB_TOPGEN   3392
#define XCD_BAR_WORDS 3456
#define XB_SPIN_CAP (1u << 22)
#define LAS __attribute__((address_space(3)))
__device__ __forceinline__ unsigned xb_ld(unsigned* p)              { return __hip_atomic_load(p, __ATOMIC_RELAXED, __HIP_MEMORY_SCOPE_AGENT); }
__device__ __forceinline__ unsigned xb_add(unsigned* p, unsigned v) { return __hip_atomic_fetch_add(p, v, __ATOMIC_RELAXED, __HIP_MEMORY_SCOPE_AGENT); }
__device__ __forceinline__ unsigned xb_xcc_id() { return (unsigned)__builtin_amdgcn_s_getreg((3 << 11) | 20) & 0xFu; }
#define XB_SPIN(cond, bar) do { unsigned _sp = 0; while (cond) { __builtin_amdgcn_s_sleep(1); \
    if ((++_sp & 255u) == 0u) { if (xb_ld(&(bar)[XB_TMO])) break; if (_sp > XB_SPIN_CAP) { atomicAdd(&(bar)[XB_TMO], 1u); break; } } } } while (0)
struct XcdBarrier { unsigned* bar; unsigned x; volatile LAS unsigned* st; };
__device__ __forceinline__ XcdBarrier xcd_barrier_post(unsigned* bar, volatile LAS unsigned* st) {
    XcdBarrier b; b.bar = bar; b.x = xb_xcc_id(); b.st = st;
    if (threadIdx.x == 0) (void)xb_add(&bar[XB_XCNT(b.x)], 1u);
    return b;
}
__device__ __forceinline__ void xcd_barrier_complete(unsigned* bar, unsigned x, unsigned& nloc, unsigned& nx) {
    const unsigned G = gridDim.x * gridDim.y * gridDim.z;
    unsigned sum, cnt, mine, sp = 0u;
    for (;;) {
        sum = 0u; cnt = 0u; mine = 0u;
#pragma unroll
        for (unsigned j = 0; j < 16; ++j) { const unsigned c = xb_ld(&bar[XB_XCNT(j)]); sum += c; cnt += (c > 0u) ? 1u : 0u; mine = (j == x) ? c : mine; }
        if (sum == G) break;
        __builtin_amdgcn_s_sleep(1);
        if ((++sp & 255u) == 0u) { if (xb_ld(&bar[XB_TMO])) break; if (sp > XB_SPIN_CAP) { atomicAdd(&bar[XB_TMO], 1u); break; } }
    }
    nloc = mine > 0u ? mine : 1u; nx = cnt > 0u ? cnt : 1u;
}
__device__ __forceinline__ void xcd_barrier(const XcdBarrier& b) {
    asm volatile("s_waitcnt vmcnt(0)" ::: "memory");
    __syncthreads();
    if (threadIdx.x == 0) {
        unsigned* bar = b.bar;
        __builtin_amdgcn_s_waitcnt(0);
        __builtin_amdgcn_fence(__ATOMIC_ACQUIRE, "agent");
        unsigned nloc = b.st[0], nx = b.st[1];
        if (nloc == 0u) { xcd_barrier_complete(bar, b.x, nloc, nx); b.st[0] = nloc; b.st[1] = nx; }
        const unsigned old = xb_add(&bar[XB_XSUB(b.x)], 1u);
        const unsigned gen = old / nloc;
        if (old + 1u == (gen + 1u) * nloc) {
            __builtin_amdgcn_fence(__ATOMIC_RELEASE, "agent");
            asm volatile("s_waitcnt vmcnt(0)" ::: "memory");
            const unsigned og = xb_add(&bar[XB_TOP], 1u);
            const unsigned tg = og / nx;
            if (og + 1u == (tg + 1u) * nx) xb_add(&bar[XB_TOPGEN], 1u);
            else XB_SPIN(xb_ld(&bar[XB_TOPGEN]) == tg, bar);
            xb_add(&bar[XB_XGEN(b.x)], 1u);
            asm volatile("s_waitcnt vmcnt(0)" ::: "memory");
        } else {
            XB_SPIN(xb_ld(&bar[XB_XGEN(b.x)]) == gen, bar);
            asm volatile("s_waitcnt vmcnt(0)" ::: "memory");
        }
    }
    __syncthreads();
}

__device__ __forceinline__ void phase_p0(const Params& P, char* lds) {
    const int tid = opaque_tid();
    float* tile = (float*)lds;
    unsigned* adacnt = (unsigned*)(P.ws + OFF_CNT) + 302;
    for (int q = blockIdx.x; q < 1536 + 192 + 8; q += gridDim.x) {
        const int u = q < 200 ? 1536 + q : q - 200;
        if (u < 1536) {
            const float* src; hf* dst; int ld, K, r0, k0, kind;
            if (u < 352) { const int l = u / 176, rem = u % 176; r0 = (rem / 16) * 256; k0 = (rem % 16) * 64; ld = INC; K = D; kind = 0; src = P.w_in + (size_t)l * D * INC; dst = (hf*)(P.ws + OFF_WIN) + (size_t)l * INP * D; }
            else if (u < 480) { const int i = u - 352, l = i / 64, rem = i % 64; r0 = (rem / 16) * 256; k0 = (rem % 16) * 64; ld = D; K = D; kind = 1; src = P.w_out + (size_t)l * D * D; dst = (hf*)(P.ws + OFF_WOUT) + (size_t)l * D * D; }
            else if (u < 1184) { const int i = u - 480, l = i / 352, rem = i % 352; r0 = (rem / 16) * 256; k0 = (rem % 16) * 64; ld = NGU; K = D; kind = 2; src = P.w_gu + (size_t)l * D * NGU; dst = (hf*)(P.ws + OFF_WGU) + (size_t)l * NGU * D; }
            else { const int i = u - 1184, l = i / 176, rem = i % 176; r0 = (rem / 44) * 256; k0 = (rem % 44) * 64; ld = D; K = DFF; kind = 3; src = P.w_down + (size_t)l * DFF * D; dst = (hf*)(P.ws + OFF_WDN) + (size_t)l * D * DFF; }
            const int c4 = (tid & 63) * 4, kq = tid >> 6;
            int scol = r0 + c4; bool valid = true;
            if (kind == 2) scol = c4 < 128 ? (r0 >> 1) + c4 : DFF + (r0 >> 1) + (c4 - 128);
            else if (kind == 0 && scol >= INC) valid = false;
            f4 v[8];
#pragma unroll
            for (int i = 0; i < 8; ++i) v[i] = valid ? *(const f4*)(src + (size_t)(k0 + kq + 8 * i) * ld + scol) : (f4){0.f, 0.f, 0.f, 0.f};
#pragma unroll
            for (int i = 0; i < 8; ++i) { float* tp = tile + (kq + 8 * i) * 257 + c4; tp[0] = v[i][0]; tp[1] = v[i][1]; tp[2] = v[i][2]; tp[3] = v[i][3]; }
            __syncthreads();
            const int kc = tid & 7;
#pragma unroll
            for (int p = 0; p < 4; ++p) {
                const int rr = (tid >> 3) + 64 * p;
                const int c = kind == 2 ? ((rr >> 5) & 1) * 128 + (rr >> 6) * 32 + (rr & 31) : rr;
                h8 o;
#pragma unroll
                for (int j = 0; j < 8; ++j) o[j] = (hf)tile[(kc * 8 + j) * 257 + c];
                *(h8*)(dst + (size_t)(r0 + rr) * K + k0 + kc * 8) = o;
            }
            __syncthreads();
        } else if (u < 1536 + 192) {
            const int i = u - 1536, l = i / 96, rem = i % 96, cc = rem / 8, ks = rem % 8;
            float* sv = (float*)lds;
            if (tid < 256) { const int set = tid >> 7, k = tid & 127; const float v = set ? P.c_ctx[ks * 128 + k] : P.c[ks * 128 + k]; sv[tid] = v / (1.0f + expf(-v)); }
            __syncthreads();
            const int n = cc * 512 + tid;
            const float* w = P.w_ada + (size_t)l * D * 6144 + (size_t)(ks * 128) * 6144 + n;
            float a0 = 0.f, a1 = 0.f;
#pragma unroll 16
            for (int k = 0; k < 128; ++k) { const float wv = w[(size_t)k * 6144]; a0 += sv[k] * wv; a1 += sv[128 + k] * wv; }
            float* mp = (float*)(P.ws + OFF_MODP);
            mp[(size_t)((ks * 2 + l) * 2 + 0) * 6144 + n] = a0;
            mp[(size_t)((ks * 2 + l) * 2 + 1) * 6144 + n] = a1;
            asm volatile("s_waitcnt vmcnt(0)" ::: "memory");
            __syncthreads();
            if (tid == 0) { __builtin_amdgcn_fence(__ATOMIC_RELEASE, "agent"); asm volatile("s_waitcnt vmcnt(0)" ::: "memory");
                __hip_atomic_fetch_add(adacnt, 1u, __ATOMIC_RELAXED, __HIP_MEMORY_SCOPE_AGENT); }
        } else {
            const int e = (u - 1728) * 512 + tid, pos = e >> 4, f = e & 15;
            const float inv = exp2f(-(float)f * (13.287712379549449f / 16.0f));
            const float ang = (float)pos * inv;
            float sn, cs; sincosf(ang, &sn, &cs);
            float2* rt = (float2*)(P.ws + OFF_ROPE);
            rt[e] = make_float2(cs, sn);
        }
    }
    if (tid == 0) { unsigned spins = 0;
        while (__hip_atomic_load(adacnt, __ATOMIC_RELAXED, __HIP_MEMORY_SCOPE_AGENT) < 192u) { __builtin_amdgcn_s_sleep(2); if (++spins > (1u << 22)) break; }
        __builtin_amdgcn_fence(__ATOMIC_ACQUIRE, "agent"); asm volatile("s_waitcnt vmcnt(0)" ::: "memory"); }
    __syncthreads();
    {
        const int lane = tid & 63, w = tid >> 6;
        float* modl = (float*)(lds + 69632);
        const float* mp = (const float*)(P.ws + OFF_MODP);
#pragma unroll 1
        for (int e = tid; e < 4096; e += 512) {
            const int set = e >> 11, n = e & 2047;
            float s = P.b_ada[n];
#pragma unroll
            for (int ks = 0; ks < 8; ++ks) s += mp[(size_t)((ks * 2 + 0) * 2 + set) * 6144 + n];
            modl[e] = s;
        }
        __syncthreads();
        hf* H = (hf*)(P.ws + OFF_H16);
        const int half = NT >> 1;
#pragma unroll 1
        for (int r0 = blockIdx.x * 8 + w; r0 < half; r0 += gridDim.x * 8) {
            f4 v[2][4];
#pragma unroll
            for (int k = 0; k < 2; ++k) {
                const int row = r0 + k * half;
                const float* srcp = row < NL ? P.x + (size_t)row * D : P.ctx + (size_t)(row - NL) * D;
#pragma unroll
                for (int i = 0; i < 4; ++i) v[k][i] = *(const f4*)(srcp + (lane + 64 * i) * 4);
            }
#pragma unroll
            for (int k = 0; k < 2; ++k) {
                const int row = r0 + k * half;
                const float* sh = modl + (row >= NL ? 2048 : 0); const float* sc = sh + 1024;
#pragma unroll
                for (int i = 0; i < 4; ++i) { const int col = (lane + 64 * i) * 4; const f4 a4 = *(const f4*)(sc + col), b4 = *(const f4*)(sh + col); const f4 y = v[k][i] * (1.0f + a4) + b4;
                    h4 o; o[0] = (hf)y[0]; o[1] = (hf)y[1]; o[2] = (hf)y[2]; o[3] = (hf)y[3]; *(h4*)(H + (size_t)row * D + col) = o; }
            }
        }
        float* mo = (float*)(P.ws + OFF_MOD);
        for (int e = blockIdx.x * 512 + tid; e < 2 * 2 * 6144; e += gridDim.x * 512) {
            const int l = e / 12288, rem = e % 12288, set = rem / 6144, n = rem % 6144;
            float s = P.b_ada[l * 6144 + n];
#pragma unroll
            for (int ks = 0; ks < 8; ++ks) s += mp[(size_t)((ks * 2 + l) * 2 + set) * 6144 + n];
            mo[e] = s;
        }
    }
}

__device__ __forceinline__ void phase_modfin(const Params& P) {
    const float* mp = (const float*)(P.ws + OFF_MODP);
    float* mo = (float*)(P.ws + OFF_MOD);
    for (int e = blockIdx.x * 512 + opaque_tid(); e < 2 * 2 * 6144; e += gridDim.x * 512) {
        const int l = e / 12288, rem = e % 12288, set = rem / 6144, n = rem % 6144;
        float s = P.b_ada[l * 6144 + n];
#pragma unroll
        for (int ks = 0; ks < 8; ++ks) s += mp[(size_t)((ks * 2 + l) * 2 + set) * 6144 + n];
        mo[e] = s;
    }
}

__device__ __forceinline__ void phase_rows(const Params& P, int mode, int nrows, const float* lg, const float* lb, int modlayer, int which_sh, int which_sc) {
    const int tid = opaque_tid(), lane = tid & 63, w = tid >> 6;
    hf* H = (hf*)(P.ws + OFF_H16);
    float2* stats = (float2*)(P.ws + OFF_STATS);
    const int half = nrows >> 1;
    for (int r0 = blockIdx.x * 8 + w; r0 < half; r0 += gridDim.x * 8) {
        f4 v[2][4];
#pragma unroll
        for (int k = 0; k < 2; ++k) {
            const int row = r0 + k * half;
            const float* src = mode == 0 ? (row < NL ? P.x + (size_t)row * D : P.ctx + (size_t)(row - NL) * D) : xr_row(P, row);
#pragma unroll
            for (int i = 0; i < 4; ++i) v[k][i] = *(const f4*)(src + (lane + 64 * i) * 4);
        }
#pragma unroll
        for (int k = 0; k < 2; ++k) {
            const int row = r0 + k * half;
            const int set = row >= NL ? 1 : 0;
            if (mode != 0) {
                float s = 0.f;
#pragma unroll
                for (int i = 0; i < 4; ++i) s += (v[k][i][0] + v[k][i][1]) + (v[k][i][2] + v[k][i][3]);
#pragma unroll
                for (int d = 32; d >= 1; d >>= 1) s += shflx(s, d, lane);
                const float mean = s * (1.0f / 1024.0f);
                float q = 0.f;
#pragma unroll
                for (int i = 0; i < 4; ++i) { const f4 dd = v[k][i] - mean; q += (dd[0] * dd[0] + dd[1] * dd[1]) + (dd[2] * dd[2] + dd[3] * dd[3]); }
#pragma unroll
                for (int d = 32; d >= 1; d >>= 1) q += shflx(q, d, lane);
                const float rstd = 1.0f / sqrtf(q * (1.0f / 1024.0f) + 1e-5f);
                if (lane == 0) stats[row] = make_float2(mean, rstd);
#pragma unroll
                for (int i = 0; i < 4; ++i) { const int col = (lane + 64 * i) * 4; const f4 g = *(const f4*)(lg + col), b = *(const f4*)(lb + col); v[k][i] = (v[k][i] - mean) * rstd * g + b; }
            }
            if (mode == 2) {
                float* dst = xr_row(P, row);
#pragma unroll
                for (int i = 0; i < 4; ++i) *(f4*)(dst + (lane + 64 * i) * 4) = v[k][i];
            } else {
                const float* sh = modv(P, modlayer, set, which_sh); const float* sc = modv(P, modlayer, set, which_sc);
#pragma unroll
                for (int i = 0; i < 4; ++i) { const int col = (lane + 64 * i) * 4; const f4 a = *(const f4*)(sc + col), b = *(const f4*)(sh + col); const f4 y = v[k][i] * (1.0f + a) + b;
                    h4 o; o[0] = (hf)y[0]; o[1] = (hf)y[1]; o[2] = (hf)y[2]; o[3] = (hf)y[3]; *(h4*)(H + (size_t)row * D + col) = o; }
            }
        }
    }
}

__device__ __forceinline__ int lds_byte(int r, int c) { const int st = (r >> 4) * 2 + (c >> 5), rr = r & 15, cc = c & 31, ob = rr * 64 + cc * 2; return st * 1024 + (ob ^ (((ob >> 9) & 1) << 5)); }
__device__ __forceinline__ void stage_rc(int b, int& R, int& C) { const int st = b / 1024, sb = b % 1024, swz = sb ^ (((sb >> 9) & 1) << 5); R = (st >> 1) * 16 + swz / 64; C = (st & 1) * 32 + (swz % 64) / 2; }

template <class Epi>
__device__ __forceinline__ void gemm_phase(const hf* X, const hf* Wt, int Mtiles, int Ntiles, int K, const Epi& epi, char* lds, int mode) {
    constexpr int BK = 64, HALF = 128, HTB = HALF * BK * 2;
    const int tid = opaque_tid_w(epi.P.wv), lane = tid & 63, wid = tid >> 6, wr = wid >> 2, wc = wid & 3, fr = lane & 15, fq = lane >> 4;
#define SA(b, h) (lds + ((b) * 2 + (h)) * HTB)
#define SB(b, h) (lds + (4 + (b) * 2 + (h)) * HTB)
#define STAGE(Pp, BASE, br, kt) do { const int so_ = ((br) * K + (kt) * BK) * 2; \
      __builtin_amdgcn_raw_ptr_buffer_load_lds(rs_##BASE, (LAS void*)((LAS char*)(Pp) + wbase), 16, (int)soff, so_, 0, 0); \
      __builtin_amdgcn_raw_ptr_buffer_load_lds(rs_##BASE, (LAS void*)((LAS char*)(Pp) + wbase + 8192), 16, (int)soff, so_ + 128 * K, 0, 0); } while (0)
#define LDA(dst, b, h) _Pragma("unroll") for (int m = 0; m < 4; ++m) _Pragma("unroll") for (int k = 0; k < 2; ++k) \
    dst[m][k] = *reinterpret_cast<const h8*>(SA(b, h) + lds_byte(wr * 64 + m * 16 + fr, k * 32 + fq * 8))
#define LDB(dst, b, h) _Pragma("unroll") for (int n = 0; n < 2; ++n) _Pragma("unroll") for (int k = 0; k < 2; ++k) \
    dst[n][k] = *reinterpret_cast<const h8*>(SB(b, h) + lds_byte(wc * 32 + n * 16 + fr, k * 32 + fq * 8))
#define MMA(ai, bj, At_, Bt_) do { __builtin_amdgcn_s_setprio(1); \
    _Pragma("unroll") for (int m = 0; m < 4; ++m) _Pragma("unroll") for (int n = 0; n < 2; ++n) _Pragma("unroll") for (int k = 0; k < 2; ++k) \
      acc[ai][bj][m][n] = __builtin_amdgcn_mfma_f32_16x16x32_f16(At_[m][k], Bt_[n][k], acc[ai][bj][m][n], 0, 0, 0); \
    __builtin_amdgcn_s_setprio(0); } while (0)
#define WAIT_V(n) asm volatile("s_waitcnt vmcnt(" #n ")" ::: "memory")
#define WAIT_L(n) asm volatile("s_waitcnt lgkmcnt(" #n ")" ::: "memory")
#define BAR __builtin_amdgcn_s_barrier()
#define SCHED __builtin_amdgcn_sched_barrier(0)
    const int nt = K / BK;
    const int wbase = __builtin_amdgcn_readfirstlane(wid) * 1024;
    const __amdgpu_buffer_rsrc_t rs_X = __builtin_amdgcn_make_buffer_rsrc((void*)X, 0, 0x7fffffff, 0x00020000);
    const __amdgpu_buffer_rsrc_t rs_Wt = __builtin_amdgcn_make_buffer_rsrc((void*)Wt, 0, 0x7fffffff, 0x00020000);
    unsigned soff; { int r0, c0; stage_rc(tid * 16, r0, c0); soff = (unsigned)(r0 * K + c0) * 2u; }
    const int G = gridDim.x, per = (G & 7) == 0 ? G >> 3 : 0, total = Mtiles * Ntiles;
    auto unit_of = [&](int it, int& pm, int& pn) -> bool {
        int v = per ? (it * 8 + (blockIdx.x & 7)) * per + (blockIdx.x >> 3) : it * G + blockIdx.x;
        if (mode == 1 || mode == 3) v = (it == 0 && (int)(blockIdx.x & 7) == (mode == 1 ? 5 : 7) && (blockIdx.x >> 3) < 4) ? (int)(blockIdx.x >> 3) : total;
        if (mode == 4 && (blockIdx.x & 7) == 7) {
            const int j = blockIdx.x >> 3;
            if (j < 4 && it >= 1) v = total; else if (j >= 4 && j < 8 && it == 2) v = 480 + (j - 4);
        }
        if (v >= total) return false;
        const int grp = v / (4 * Ntiles), rem = v - grp * 4 * Ntiles, rows = Mtiles - 4 * grp < 4 ? Mtiles - 4 * grp : 4;
        pn = rem / rows; pm = 4 * grp + rem % rows;
        if (mode == 1 || mode == 3) { pn = v; pm = 64; }
        return true;
    };
    bool pre = false;
#pragma unroll 1
    for (int it = 0;; ++it) {
        int pn, pm;
        if (!unit_of(it, pm, pn)) break;
        unsigned* ctxready = (unsigned*)(epi.P.ws + OFF_CNT) + (mode >= 3 ? 301 : 300);
        if ((mode == 2 || mode == 4) && pm == 64) {
            if (opaque_tid_w(epi.P.wv) == 0) {
                unsigned spins = 0;
                while (__hip_atomic_load(ctxready, __ATOMIC_RELAXED, __HIP_MEMORY_SCOPE_AGENT) < 4u) { __builtin_amdgcn_s_sleep(2); if (++spins > (1u << 22)) break; }
                __builtin_amdgcn_fence(__ATOMIC_ACQUIRE, "agent");
                asm volatile("s_waitcnt vmcnt(0)" ::: "memory");
            }
            __syncthreads();
        }
        const int brow = pn * 256, bcol = pm * 256;
        f4 acc[2][2][4][2];
#pragma unroll
        for (int a = 0; a < 2; ++a)
#pragma unroll
            for (int b = 0; b < 2; ++b)
#pragma unroll
                for (int m = 0; m < 4; ++m)
#pragma unroll
                    for (int n = 0; n < 2; ++n) acc[a][b][m][n] = (f4){0.f, 0.f, 0.f, 0.f};
        h8 At[4][2], B0[2][2], B1[2][2];
        if (!pre) { STAGE(SB(0, 0), X, bcol, 0); STAGE(SA(0, 0), Wt, brow, 0);
                    STAGE(SB(0, 1), X, bcol + HALF, 0); STAGE(SA(0, 1), Wt, brow + HALF, 0); }
        if (wr == 1) BAR;
        if (pre) WAIT_V(0); else WAIT_V(4);
        BAR;
        STAGE(SB(1, 0), X, bcol, 1); STAGE(SA(1, 0), Wt, brow, 1); STAGE(SB(1, 1), X, bcol + HALF, 1);
        WAIT_V(6); BAR;
#pragma unroll 1
        for (int t = 0; t < nt - 2; t += 2) {
            LDB(B0, 0, 0); SCHED; LDA(At, 0, 0); STAGE(SA(1, 1), Wt, brow + HALF, t + 1);
            WAIT_L(8); BAR; WAIT_L(0); MMA(0, 0, At, B0); BAR; SCHED;
            LDB(B1, 0, 1); STAGE(SB(0, 0), X, bcol, t + 2);
            BAR; WAIT_L(0); MMA(0, 1, At, B1); BAR;
            LDA(At, 0, 1); STAGE(SA(0, 0), Wt, brow, t + 2);
            BAR; WAIT_L(0); MMA(1, 0, At, B0); BAR; SCHED;
            STAGE(SB(0, 1), X, bcol + HALF, t + 2);
            WAIT_V(6); BAR; MMA(1, 1, At, B1); BAR;
            LDB(B0, 1, 0); SCHED; LDA(At, 1, 0); STAGE(SA(0, 1), Wt, brow + HALF, t + 2);
            WAIT_L(8); BAR; WAIT_L(0); MMA(0, 0, At, B0); BAR; SCHED;
            LDB(B1, 1, 1); STAGE(SB(1, 0), X, bcol, t + 3);
            BAR; WAIT_L(0); MMA(0, 1, At, B1); BAR;
            LDA(At, 1, 1); STAGE(SA(1, 0), Wt, brow, t + 3);
            BAR; WAIT_L(0); MMA(1, 0, At, B0); BAR; SCHED;
            STAGE(SB(1, 1), X, bcol + HALF, t + 3);
            WAIT_V(6); BAR; MMA(1, 1, At, B1); BAR;
        }
        { LDB(B0, 0, 0); LDA(At, 0, 0); STAGE(SA(1, 1), Wt, brow + HALF, nt - 1);
          BAR; WAIT_L(0); MMA(0, 0, At, B0); BAR;
          LDB(B1, 0, 1); BAR; WAIT_L(0); MMA(0, 1, At, B1); BAR;
          LDA(At, 0, 1); WAIT_V(4); BAR; WAIT_L(0); MMA(1, 0, At, B0); MMA(1, 1, At, B1); BAR; }
        { LDB(B0, 1, 0); LDA(At, 1, 0); WAIT_V(2); BAR; WAIT_L(0); MMA(0, 0, At, B0); BAR;
          LDB(B1, 1, 1); WAIT_V(0); BAR; WAIT_L(0); MMA(0, 1, At, B1); BAR;
          LDA(At, 1, 1); BAR; WAIT_L(0); MMA(1, 0, At, B0); MMA(1, 1, At, B1); BAR; }
        if (wr == 0) BAR;
        pre = false;
        if constexpr (Epi::kPrefetchNext) {
            int pm2, pn2;
            if (unit_of(it + 1, pm2, pn2) && !((mode == 2 || mode == 4) && pm2 == 64)) {
                const int brow2 = pn2 * 256, bcol2 = pm2 * 256;
                STAGE(SB(0, 0), X, bcol2, 0); STAGE(SA(0, 0), Wt, brow2, 0);
                STAGE(SB(0, 1), X, bcol2 + HALF, 0); STAGE(SA(0, 1), Wt, brow2 + HALF, 0);
                pre = true;
            }
        }
        epi(acc, pm, pn, wr, wc, fr, fq, lds);
        if (mode == 1 || mode == 3) {
            asm volatile("s_waitcnt vmcnt(0)" ::: "memory");
            __syncthreads();
            if (opaque_tid_w(epi.P.wv) == 0) {
                __builtin_amdgcn_fence(__ATOMIC_RELEASE, "agent");
                asm volatile("s_waitcnt vmcnt(0)" ::: "memory");
                __hip_atomic_fetch_add(ctxready, 1u, __ATOMIC_RELAXED, __HIP_MEMORY_SCOPE_AGENT);
            }
        }
    }
#undef SA
#undef SB
#undef STAGE
#undef LDA
#undef LDB
#undef MMA
#undef WAIT_V
#undef WAIT_L
#undef BAR
#undef SCHED
}

__device__ __forceinline__ unsigned pk2h(float lo, float hi) { h2 v; v[0] = (hf)lo; v[1] = (hf)hi; return __builtin_bit_cast(unsigned, v); }
struct EpiIn {
    static constexpr bool kPrefetchNext = true;
    Params P; int layer;
    __device__ __forceinline__ void operator()(f4 (&acc)[2][2][4][2], int pm, int pn, int, int, int, int, char*) const {
        hf* qkv = (hf*)(P.ws + OFF_QKV);
        const float2* rope = (const float2*)(P.ws + OFF_ROPE);
        const int tq_ = opaque_tid_w(P.wv), lane = tq_ & 63, wr = tq_ >> 8, wc = (tq_ >> 6) & 3, fr = lane & 15, fq = lane >> 4;
#pragma unroll
        for (int ai = 0; ai < 2; ++ai) {
            const int fb = pn * 4 + ai * 2 + wr;
            if (fb > 40) continue;
#pragma unroll
            for (int bj = 0; bj < 2; ++bj)
#pragma unroll
                for (int n = 0; n < 2; ++n) {
                    const int t = pm * 256 + bj * 128 + wc * 32 + n * 16 + fr;
                    f4 v[4];
#pragma unroll
                    for (int m = 0; m < 4; ++m) v[m] = acc[ai][bj][m][n];
                    if (fb < 16) {
                        const int sub = fb & 7;
                        if (sub < 6) {
                            if (fb >= 8) {
                                float ss = 0.f;
#pragma unroll
                                for (int m = 0; m < 4; ++m) ss += (v[m][0] * v[m][0] + v[m][1] * v[m][1]) + (v[m][2] * v[m][2] + v[m][3] * v[m][3]);
                                ss += shflx(ss, 16, lane); ss += shflx(ss, 32, lane);
                                const float rs = 1.0f / sqrtf(ss * (1.0f / 64.0f) + 1e-6f);
                                const float* gn = (sub < 4 ? P.q_gain : P.k_gain) + layer * 64;
#pragma unroll
                                for (int m = 0; m < 4; ++m) { const f4 g = *(const f4*)(gn + m * 16 + fq * 4); v[m] = v[m] * rs * g; }
                            }
                            if (t < NL) {
#pragma unroll
                                for (int ax = 0; ax < 2; ++ax) {
                                    const int pos = ax == 0 ? (t >> 6) : (t & 63);
                                    const f4* rp4 = (const f4*)(rope + pos * 16 + fq * 4);
                                    const f4 c01 = rp4[0], c23 = rp4[1];
#pragma unroll
                                    for (int j = 0; j < 4; ++j) { float2 cs; cs.x = (j < 2 ? c01 : c23)[(j & 1) * 2]; cs.y = (j < 2 ? c01 : c23)[(j & 1) * 2 + 1]; const float u1 = v[2 * ax][j], u2 = v[2 * ax + 1][j];
                                        v[2 * ax][j] = u1 * cs.x - u2 * cs.y; v[2 * ax + 1][j] = u1 * cs.y + u2 * cs.x; }
                                }
                            }
                            const float sc = sub < 4 ? 0.125f * LOG2E : 1.0f;
                            hf* dst = qkv + (size_t)fb * HT + (size_t)t * 64 + pair_off(fq);
#pragma unroll
                            for (int mp = 0; mp < 2; ++mp) { h4 o0, o1;
#pragma unroll
                                for (int e = 0; e < 4; ++e) { o0[e] = (hf)(v[2 * mp][e] * sc); o1[e] = (hf)(v[2 * mp + 1][e] * sc); }
                                *(u4*)(dst + mp * 32) = pair16(o0, o1); }
                        } else {
                            const int tp = (t & ~12) | (((t >> 2) & 1) << 3) | (((t >> 3) & 1) << 2);
                            const int q4 = fr & 3; const bool b0 = q4 & 1, b1 = (q4 & 2) != 0;
                            const int qd = fr >> 2, qpos = ((qd & 1) << 1) | (qd >> 1);
                            __attribute__((address_space(1))) hf* dst = (__attribute__((address_space(1))) hf*)(qkv + (size_t)fb * HT + (t & ~15) + 4 * qpos + (size_t)(4 * fq + q4) * NT);
#pragma unroll
                            for (int m = 0; m < 4; ++m) {
                                const float x0 = v[m][0], x1 = v[m][1], x2 = v[m][2], x3 = v[m][3];
                                const float r01 = __builtin_bit_cast(float, __builtin_amdgcn_update_dpp(0, __builtin_bit_cast(int, b0 ? x0 : x1), 0xB1, 0xf, 0xf, false));
                                const float r23 = __builtin_bit_cast(float, __builtin_amdgcn_update_dpp(0, __builtin_bit_cast(int, b0 ? x2 : x3), 0xB1, 0xf, 0xf, false));
                                const unsigned A0 = b0 ? pk2h(r01, x1) : pk2h(x0, r01), A1 = b0 ? pk2h(r23, x3) : pk2h(x2, r23);
                                const unsigned rB = (unsigned)__builtin_amdgcn_update_dpp(0, (int)(b1 ? A0 : A1), 0x4E, 0xf, 0xf, false);
                                u2 w2; w2.x = b1 ? rB : A0; w2.y = b1 ? A1 : rB;
                                *(__attribute__((address_space(1))) u2*)(dst + (size_t)(m * 16) * NT) = w2;
                            }
                        }
                    } else if (fb < 40) {
                        hf* dst = (fb < 24 ? (hf*)(P.ws + OFF_Z) + (size_t)t * 512 + (fb - 16) * 64 : (hf*)(P.ws + OFF_XBC) + (size_t)t * 1024 + (fb - 24) * 64) + pair_off(fq);
#pragma unroll
                        for (int mp = 0; mp < 2; ++mp) { h4 o0, o1;
#pragma unroll
                            for (int e = 0; e < 4; ++e) { o0[e] = (hf)v[2 * mp][e]; o1[e] = (hf)v[2 * mp + 1][e]; }
                            *(u4*)(dst + mp * 32) = pair16(o0, o1); }
                    } else {
                        *(f4*)((float*)(P.ws + OFF_DTR) + (size_t)t * 16 + fq * 4) = v[0];
                    }
                }
        }
    }
};

struct EpiRes {
    static constexpr bool kPrefetchNext = false;
    Params P; int layer; int which_g; const float* lng; const float* lnb;
    __device__ __forceinline__ void operator()(f4 (&acc)[2][2][4][2], int pm, int pn, int wr, int wc, int fr, int fq, char*) const {
        const float2* stats = (const float2*)(P.ws + OFF_STATS);
#pragma unroll
        for (int bj = 0; bj < 2; ++bj)
#pragma unroll
            for (int n = 0; n < 2; ++n) {
                const int t = pm * 256 + bj * 128 + wc * 32 + n * 16 + fr;
                float* xr = xr_row(P, t);
                const float* xin = lng ? xr : (t < NL ? P.x + (size_t)t * D : P.ctx + (size_t)(t - NL) * D);
                float2 st = make_float2(0.f, 1.f);
                if (lng) st = stats[t];
                const float* g = modv(P, layer, t >= NL ? 1 : 0, which_g);
#pragma unroll
                for (int ai = 0; ai < 2; ++ai)
#pragma unroll
                    for (int m = 0; m < 4; ++m) {
                        const int f = pn * 256 + ai * 128 + wr * 64 + m * 16 + fq * 4;
                        f4 xv = *(const f4*)(xin + f); const f4 gv = *(const f4*)(g + f);
                        if (lng) { const f4 lg4 = *(const f4*)(lng + f), lb4 = *(const f4*)(lnb + f); xv = (xv - st.x) * st.y * lg4 + lb4; }
                        *(f4*)(xr + f) = ALPHA * xv + gv * acc[ai][bj][m][n];
                    }
            }
    }
};

struct EpiResLN {
    static constexpr bool kPrefetchNext = false;
    Params P; int layer; int which_g; const float* lng_in; const float* lnb_in;
    const float* lng; const float* lnb; int modlayer, which_sh, which_sc; int final_out; int inst;
    __device__ __forceinline__ void operator()(f4 (&acc)[2][2][4][2], int pm, int pn, int wr, int wc, int fr, int fq, char* lds) const {
        const int tid = opaque_tid(), lane = tid & 63, wid = tid >> 6;
        float2* stats = (float2*)(P.ws + OFF_STATS);
        float2* part = (float2*)lds;
        float2* mr = (float2*)(lds + 4096);
        volatile LAS unsigned* flag = (volatile LAS unsigned*)(lds + 8192);
        unsigned long long* slots = (unsigned long long*)(P.ws + OFF_XSL);
        unsigned* cnt = (unsigned*)(P.ws + OFF_CNT) + inst * 65 + pm;
        const int wr1 = wid >> 2, wc1 = wid & 3, fr1 = lane & 15, fq1 = lane >> 4;
        const float* g = modv(P, layer, pm == 64 ? 1 : 0, which_g);
        float sa[2][2], qa[2][2];
#pragma unroll
        for (int bj = 0; bj < 2; ++bj)
#pragma unroll
            for (int n = 0; n < 2; ++n) { sa[bj][n] = 0.f; qa[bj][n] = 0.f; }
#pragma unroll
        for (int ai = 0; ai < 2; ++ai)
#pragma unroll
            for (int mp = 0; mp < 2; ++mp) {
                const int fp = pn * 256 + ai * 128 + wr1 * 64 + mp * 32;
                f4 gv[2], lg4[2], lb4[2];
#pragma unroll
                for (int mm = 0; mm < 2; ++mm) { const int f = fp + mm * 16 + fq1 * 4; gv[mm] = *(const f4*)(g + f);
                    if (lng_in) { lg4[mm] = *(const f4*)(lng_in + f); lb4[mm] = *(const f4*)(lnb_in + f); } }
#pragma unroll
                for (int bj = 0; bj < 2; ++bj)
#pragma unroll
                    for (int n = 0; n < 2; ++n) {
                        const int t = pm * 256 + bj * 128 + wc1 * 32 + n * 16 + fr1;
                        float2 st = make_float2(0.f, 1.f); if (lng_in) st = stats[t];
                        h4 x16[2];
                        if (lng_in) { const u4 wv = *(const u4*)(xr16_row(P, t, inst == 3) + fp + pair_off(fq1));
                            const auto r0 = __builtin_amdgcn_permlane16_swap(wv.x, wv.z, false, false); const auto r1 = __builtin_amdgcn_permlane16_swap(wv.y, wv.w, false, false);
                            u2 a2; a2.x = r0[0]; a2.y = r1[0]; u2 b2; b2.x = r0[1]; b2.y = r1[1];
                            x16[0] = __builtin_bit_cast(h4, a2); x16[1] = __builtin_bit_cast(h4, b2); }
                        h4 v16[2];
#pragma unroll
                        for (int mm = 0; mm < 2; ++mm) {
                            const int m = 2 * mp + mm;
                            const int f = fp + mm * 16 + fq1 * 4;
                            f4 xv;
                            if (lng_in) { xv[0] = (float)x16[mm][0]; xv[1] = (float)x16[mm][1]; xv[2] = (float)x16[mm][2]; xv[3] = (float)x16[mm][3];
                                xv = (xv - st.x) * st.y * lg4[mm] + lb4[mm]; }
                            else xv = *(const f4*)((t < NL ? P.x + (size_t)t * D : P.ctx + (size_t)(t - NL) * D) + f);
                            const f4 v = ALPHA * xv + gv[mm] * acc[ai][bj][m][n];
                            acc[ai][bj][m][n] = v;
                            v16[mm][0] = (hf)v[0]; v16[mm][1] = (hf)v[1]; v16[mm][2] = (hf)v[2]; v16[mm][3] = (hf)v[3];
                            sa[bj][n] += (v[0] + v[1]) + (v[2] + v[3]); qa[bj][n] += (v[0] * v[0] + v[1] * v[1]) + (v[2] * v[2] + v[3] * v[3]);
                        }
                        if (!final_out) *(u4*)(xr16_row(P, t, inst == 2) + fp + pair_off(fq1)) = pair16(v16[0], v16[1]);
                    }
            }
#pragma unroll
        for (int bj = 0; bj < 2; ++bj)
#pragma unroll
            for (int n = 0; n < 2; ++n) {
                float s = sa[bj][n], q = qa[bj][n];
                s += shflx(s, 16, lane); s += shflx(s, 32, lane); q += shflx(q, 16, lane); q += shflx(q, 32, lane);
                if (fq1 == 0) { const int t2 = opaque_tid();
                    part[(bj * 128 + ((t2 >> 6) & 3) * 32 + n * 16 + (t2 & 15)) * 2 + (t2 >> 8)] = make_float2(s, q); }
            }
        __syncthreads();
        if (tid < 256) { const float2 a = part[tid * 2], b = part[tid * 2 + 1];
            const unsigned long long wv = ((unsigned long long)__float_as_uint(a.y + b.y) << 32) | __float_as_uint(a.x + b.x);
            __hip_atomic_store(slots + (size_t)(pm * 256 + tid) * 4 + pn, wv, __ATOMIC_RELAXED, __HIP_MEMORY_SCOPE_AGENT); }
        asm volatile("s_waitcnt vmcnt(0)" ::: "memory");
        __syncthreads();
        if (wid == 0) {
            if (lane == 0) __hip_atomic_fetch_add(cnt, 1u, __ATOMIC_RELAXED, __HIP_MEMORY_SCOPE_AGENT);
            unsigned spins = 0; bool dead = false;
            while ((unsigned)__builtin_amdgcn_readfirstlane((int)__hip_atomic_load(cnt, __ATOMIC_RELAXED, __HIP_MEMORY_SCOPE_AGENT)) < 4u) {
                __builtin_amdgcn_s_sleep(2);
                if (++spins > (1u << 22)) { dead = true; break; }
            }
            __builtin_amdgcn_fence(__ATOMIC_ACQUIRE, "agent");
            asm volatile("s_waitcnt vmcnt(0)" ::: "memory");
            if (lane == 0) flag[0] = dead ? 1u : 0u;
        }
        __syncthreads();
        if (tid < 256) { const unsigned long long* sl = slots + (size_t)(pm * 256 + tid) * 4; float s = 0.f, q = 0.f;
#pragma unroll
            for (int k = 0; k < 4; ++k) { const unsigned long long wv = __hip_atomic_load(sl + k, __ATOMIC_RELAXED, __HIP_MEMORY_SCOPE_AGENT); s += __uint_as_float((unsigned)wv); q += __uint_as_float((unsigned)(wv >> 32)); }
            const float mean = s * (1.0f / 1024.0f);
            float var = q * (1.0f / 1024.0f) - mean * mean; var = var < 0.f ? 0.f : var;
            float2 o = make_float2(mean, 1.0f / sqrtf(var + 1e-5f));
            if (flag[0]) o = make_float2(__builtin_nanf(""), __builtin_nanf(""));
            mr[tid] = o;
            if (pn == 0) stats[pm * 256 + tid] = o; }
        __syncthreads();
        hf* H = (hf*)(P.ws + OFF_H16);
        const int t4 = opaque_tid(), wr4 = t4 >> 8, wc4 = (t4 >> 6) & 3, fr4 = t4 & 15, fq4 = (t4 >> 4) & 3;
        const float* sh = modv(P, modlayer, pm == 64 ? 1 : 0, which_sh); const float* sc = modv(P, modlayer, pm == 64 ? 1 : 0, which_sc);
#pragma unroll
        for (int ai = 0; ai < 2; ++ai)
#pragma unroll
            for (int mp = 0; mp < 2; ++mp) {
                const int fp = pn * 256 + ai * 128 + wr4 * 64 + mp * 32;
                f4 lg4[2], lb4[2], sc4[2], sh4[2];
#pragma unroll
                for (int mm = 0; mm < 2; ++mm) { const int f = fp + mm * 16 + fq4 * 4; lg4[mm] = *(const f4*)(lng + f); lb4[mm] = *(const f4*)(lnb + f);
                    if (!final_out) { sc4[mm] = *(const f4*)(sc + f); sh4[mm] = *(const f4*)(sh + f); } }
#pragma unroll
                for (int bj = 0; bj < 2; ++bj)
#pragma unroll
                    for (int n = 0; n < 2; ++n) {
                        const int tl = bj * 128 + wc4 * 32 + n * 16 + fr4, t = pm * 256 + tl;
                        const float2 st = mr[tl];
                        h4 o16[2];
#pragma unroll
                        for (int mm = 0; mm < 2; ++mm) {
                            const int m = 2 * mp + mm;
                            const f4 xn = (acc[ai][bj][m][n] - st.x) * st.y * lg4[mm] + lb4[mm];
                            if (final_out) { if (t < NL) *(f4*)(P.out + (size_t)t * D + fp + mm * 16 + fq4 * 4) = xn; }
                            else { const f4 y = xn * (1.0f + sc4[mm]) + sh4[mm];
                                o16[mm][0] = (hf)y[0]; o16[mm][1] = (hf)y[1]; o16[mm][2] = (hf)y[2]; o16[mm][3] = (hf)y[3]; }
                        }
                        if (!final_out) *(u4*)(H + (size_t)t * D + fp + pair_off(fq4)) = pair16(o16[0], o16[1]);
                    }
            }
        __syncthreads();
    }
};

struct EpiGU {
    static constexpr bool kPrefetchNext = true;
    Params P;
    __device__ __forceinline__ void operator()(f4 (&acc)[2][2][4][2], int pm, int pn, int, int, int, int, char*) const {
        hf* G = (hf*)(P.ws + OFF_G16);
        const int tq_ = opaque_tid_w(P.wv), wr = tq_ >> 8, wc = (tq_ >> 6) & 3, fr = tq_ & 15, fq = (tq_ >> 4) & 3;
        const int offe = pair_off(fq);
#pragma unroll
        for (int bj = 0; bj < 2; ++bj)
#pragma unroll
            for (int n = 0; n < 2; ++n) {
                const int t = pm * 256 + bj * 128 + wc * 32 + n * 16 + fr;
#pragma unroll
                for (int ai = 0; ai < 2; ++ai) {
                    u2 pk[2];
#pragma unroll
                    for (int mm = 0; mm < 2; ++mm) {
                        const f4 gt = acc[ai][bj][mm][n], up = acc[ai][bj][mm + 2][n];
                        h4 o;
#pragma unroll
                        for (int e = 0; e < 4; ++e) o[e] = (hf)(silu_f(gt[e]) * up[e]);
                        pk[mm] = __builtin_bit_cast(u2, o);
                    }
                    const auto r0 = __builtin_amdgcn_permlane16_swap(pk[0].x, pk[1].x, false, false);
                    const auto r1 = __builtin_amdgcn_permlane16_swap(pk[0].y, pk[1].y, false, false);
                    u4 w4; w4.x = r0[0]; w4.y = r1[0]; w4.z = r0[1]; w4.w = r1[1];
                    *(u4*)(G + (size_t)t * DFF + pn * 128 + (ai * 2 + wr) * 32 + offe) = w4;
                }
            }
    }
};

__device__ __forceinline__ void phase_prep(const Params& P, int layer, char* lds) {
    const int tid = opaque_tid();
    hf* raw = (hf*)lds;
    hf* outt = (hf*)(lds + 32768);
    const hf* XBC = (const hf*)(P.ws + OFF_XBC);
    hf* U = (hf*)(P.ws + OFF_U); hf* UT = (hf*)(P.ws + OFF_UT);
    u4 pre[3];
#define PREP_FETCH(uu) do { const int tb_ = (uu) >> 3, cb_ = (uu) & 7, t0_ = tb_ * 64, c0_ = cb_ * 128; const int s0_ = t0_ < NL ? 0 : NL, s1_ = t0_ < NL ? NL : NT; \
    _Pragma("unroll") for (int i_ = 0; i_ < 3; ++i_) { const int e_ = tid + i_ * 512, r_ = e_ >> 4, ch_ = e_ & 15, t_ = t0_ - 2 + r_; u4 v_ = {0u, 0u, 0u, 0u}; \
        if (e_ < 68 * 16 && t_ >= s0_ && t_ < s1_) v_ = *(const u4*)(XBC + (size_t)t_ * 1024 + c0_ + ch_ * 8); pre[i_] = v_; } } while (0)
    if (blockIdx.x < 260 * 8) PREP_FETCH(blockIdx.x);
    float wv[5] = {0.f, 0.f, 0.f, 0.f, 0.f}, bb = 0.f; int cbw = -1;
    for (int u = blockIdx.x; u < 260 * 8; u += gridDim.x) {
        const int tb = u >> 3, cb = u & 7, t0 = tb * 64, c0 = cb * 128;
#pragma unroll
        for (int i = 0; i < 3; ++i) { const int e = tid + i * 512; if (e < 68 * 16) *(u4*)(raw + (e >> 4) * 128 + (e & 15) * 8) = pre[i]; }
        __syncthreads();
        if (u + (int)gridDim.x < 260 * 8) PREP_FETCH(u + gridDim.x);
        {
            const int ch = tid & 127, tq = tid >> 7, gc = c0 + ch;
            if (cb != cbw) {
                cbw = cb;
#pragma unroll
                for (int k = 0; k < 5; ++k) wv[k] = P.conv_w[(size_t)layer * 5 * 1024 + k * 1024 + gc];
                bb = P.conv_b[layer * 1024 + gc];
            }
            float xin[20];
#pragma unroll
            for (int i = 0; i < 20; ++i) xin[i] = (float)raw[(tq * 16 + i) * 128 + ch];
            h8 o0, o1;
#pragma unroll
            for (int i = 0; i < 16; ++i) {
                float s = bb;
#pragma unroll
                for (int k = 0; k < 5; ++k) s += wv[k] * xin[i + k];
                const hf ov = (hf)silu_f(s);
                if (c0 >= 512) outt[(tq * 16 + i) * 128 + ch] = ov;
                if (i < 8) o0[i] = ov; else o1[i - 8] = ov;
            }
            if (gc < 768) { hf* d = UT + (size_t)gc * NT + t0 + tq * 16; *(h8*)d = o0; *(h8*)(d + 8) = o1; }
        }
        __syncthreads();
        if (c0 >= 512) { for (int e = tid; e < 64 * 16; e += 512) { const int r = e >> 4, ch = e & 15; *(u4*)(U + (size_t)(t0 + r) * 1024 + c0 + ch * 8) = *(const u4*)(outt + r * 128 + ch * 8); } }
        if (cb == 0) {
            const float* dr = (const float*)(P.ws + OFF_DTR); float* dp = (float*)(P.ws + OFF_DTP);
            for (int e = tid; e < 1024; e += 512) { const int j = e & 15; const float xv = dr[(size_t)t0 * 16 + e] + P.dt_bias[layer * 16 + j]; dp[(size_t)t0 * 16 + e] = xv > 20.f ? xv : log1pf(expf(xv)); }
        }
    }
#undef PREP_FETCH
    __syncthreads();
}

template <int NROWS>
__device__ __forceinline__ void stage_rows16(const hf* src, size_t ld, char* dst, int tid) {
#pragma unroll
    for (int i = 0; i < NROWS * 16 / 512; ++i) { const int e = tid + i * 512, r = e >> 4, c = e & 15;
        *(u4*)(dst + r * 256 + ((c ^ (r & 15)) << 4)) = *(const u4*)(src + (size_t)r * ld + c * 8); }
}
template <int NROWS>
__device__ __forceinline__ void stage_rows8(const hf* src, size_t ld, char* dst, int tid) {
    typedef unsigned u2 __attribute__((ext_vector_type(2)));
#pragma unroll
    for (int i = 0; i < NROWS * 16 / 512; ++i) { const int e = tid + i * 512, r = e >> 4, c = e & 15;
        const u4 v = *(const u4*)(src + (size_t)r * ld + c * 8);
        u2 lo; lo.x = v.x; lo.y = v.y; u2 hi; hi.x = v.z; hi.y = v.w;
        *(u2*)(dst + r * 256 + (((2 * c) ^ (r & 31)) << 3)) = lo; *(u2*)(dst + r * 256 + (((2 * c + 1) ^ (r & 31)) << 3)) = hi; }
}

__device__ __forceinline__ float wave_incl_scan(float v, int lane) {
#pragma unroll
    for (int d = 1; d < 64; d <<= 1) { const float t = __builtin_bit_cast(float, __builtin_amdgcn_ds_bpermute((lane - d) << 2, __builtin_bit_cast(int, v))); if (lane >= d) v += t; }
    return v;
}

__device__ __forceinline__ void phase_ssd_states(const Params& P, int layer, char* lds) {
    const int tid = opaque_tid(), lane = tid & 63, w = tid >> 6, hh = w & 3, dir = w >> 2, r31 = lane & 31, h = lane >> 5;
    float* wtab = (float*)lds + w * 128;
    char* XT = lds + 16384;
    char* BT = lds + 16384 + 65536;
    const hf* UT = (const hf*)(P.ws + OFF_UT); const float* DTP = (const float*)(P.ws + OFF_DTP);
    hf* CS = (hf*)(P.ws + OFF_CS); float* DEC = (float*)(P.ws + OFF_DEC);
    const int sw16 = r31 & 15;
    u4 pre[8]; float pdt0 = 0.f, pdt1 = 0.f;
#define ST_FETCH(uu) do { const int cid_ = (uu) >> 2, g_ = ((uu) >> 1) & 1, ph_ = (uu) & 1, t0_ = cid_ * 128; \
        _Pragma("unroll") for (int i_ = 0; i_ < 4; ++i_) { const int e_ = tid + i_ * 512, r_ = e_ >> 4, c_ = e_ & 15; \
            pre[i_] = *(const u4*)(UT + (size_t)(g_ * 256 + (r_ >> 5) * 64 + ph_ * 32 + (r_ & 31)) * NT + t0_ + c_ * 8); \
            pre[4 + i_] = *(const u4*)(UT + (size_t)(512 + g_ * 128 + r_) * NT + t0_ + c_ * 8); } \
        pdt0 = DTP[(size_t)(t0_ + 2 * lane) * 16 + dir * 8 + g_ * 4 + hh]; pdt1 = DTP[(size_t)(t0_ + 2 * lane + 1) * 16 + dir * 8 + g_ * 4 + hh]; } while (0)
    if ((int)blockIdx.x < NCHK * 4) ST_FETCH((int)blockIdx.x);
    for (int u = blockIdx.x; u < NCHK * 4; u += gridDim.x) {
        const int cid = u >> 2, g = (u >> 1) & 1, ph = u & 1, t0 = cid * 128, head = g * 4 + hh;
#pragma unroll
        for (int i = 0; i < 4; ++i) { const int e = tid + i * 512, r = e >> 4, c = e & 15;
            *(u4*)(XT + r * 256 + ((c ^ (r & 15)) << 4)) = pre[i]; *(u4*)(BT + r * 256 + ((c ^ (r & 15)) << 4)) = pre[4 + i]; }
        const float a = -expf(P.a_log[layer * 16 + dir * 8 + head]);
        const float dt0 = pdt0, dt1 = pdt1;
        if (u + (int)gridDim.x < NCHK * 4) ST_FETCH(u + (int)gridDim.x);
        const float d0 = dt0 * a, d1 = dt1 * a;
        const float inc1 = wave_incl_scan(d0 + d1, lane), inc0 = inc1 - d1;
        const float total = rdlane(inc1, 63);
        float w0, w1;
        if (dir == 0) { w0 = expf(total - inc0) * dt0; w1 = expf(total - inc1) * dt1; }
        else { w0 = expf(inc0 - d0) * dt0; w1 = expf(inc1 - d1) * dt1; }
        wtab[2 * lane] = w0; wtab[2 * lane + 1] = w1;
        if (lane == 0) DEC[(cid * 2 + dir) * 8 + head] = expf(total);
        __syncthreads();
        fx16 S[4];
#pragma unroll
        for (int b = 0; b < 4; ++b) S[b] = zero16();
#pragma unroll 4
        for (int kk = 0; kk < 8; ++kk) {
            const f4 wa = *(const f4*)(wtab + kk * 16 + 8 * h), wb = *(const f4*)(wtab + kk * 16 + 8 * h + 4);
            h8 w8; w8[0] = (hf)wa[0]; w8[1] = (hf)wa[1]; w8[2] = (hf)wa[2]; w8[3] = (hf)wa[3]; w8[4] = (hf)wb[0]; w8[5] = (hf)wb[1]; w8[6] = (hf)wb[2]; w8[7] = (hf)wb[3];
            const int co = ((2 * kk + h) ^ sw16) << 4;
            h8 bf[4];
            const h8 xf = *(const h8*)(XT + (hh * 32 + r31) * 256 + co) * w8;
#pragma unroll
            for (int nt = 0; nt < 4; ++nt) bf[nt] = *(const h8*)(BT + (nt * 32 + r31) * 256 + co);
#pragma unroll
            for (int nt = 0; nt < 4; ++nt) S[nt] = mfma16(bf[nt], xf, S[nt]);
        }
        hf* cs = CS + (size_t)((cid * 2 + dir) * 8 + head) * 8192 + (size_t)(ph * 32 + r31) * 128 + (h ? 8 : 0);
#pragma unroll
        for (int nt = 0; nt < 4; ++nt)
#pragma unroll
            for (int gp = 0; gp < 2; ++gp) {
                h4 a4, b4;
#pragma unroll
                for (int e = 0; e < 4; ++e) { a4[e] = (hf)S[nt][8 * gp + e]; b4[e] = (hf)S[nt][8 * gp + 4 + e]; }
                const u2 a = __builtin_bit_cast(u2, a4), b = __builtin_bit_cast(u2, b4);
                const auto r0 = __builtin_amdgcn_permlane32_swap(a.x, b.x, false, false);
                const auto r1 = __builtin_amdgcn_permlane32_swap(a.y, b.y, false, false);
                u4 w4; w4.x = r0[0]; w4.y = r1[0]; w4.z = r0[1]; w4.w = r1[1];
                *(u4*)(cs + nt * 32 + gp * 16) = w4;
            }
        __syncthreads();
    }
#undef ST_FETCH
}

__device__ __forceinline__ void phase_ssd_scan(const Params& P) {
    const hf* CS = (const hf*)(P.ws + OFF_CS); hf* HS = (hf*)(P.ws + OFF_HS); const float* DEC = (const float*)(P.ws + OFF_DEC);
    for (int e = blockIdx.x * 512 + opaque_tid(); e < 131072; e += gridDim.x * 512) {
        const int dir = e >> 16, head = (e >> 13) & 7, rest = e & 8191;
        float st = 0.f;
#pragma unroll 1
        for (int b0 = 0; b0 < NCHK; b0 += 26) {
            float cs[26], dc[26];
#pragma unroll
            for (int i = 0; i < 26; ++i) {
                const int step = b0 + i, cid = dir ? 129 - step : (step < 2 ? 128 + step : step - 2);
                cs[i] = (float)CS[(size_t)((cid * 2 + dir) * 8 + head) * 8192 + rest];
                dc[i] = DEC[(cid * 2 + dir) * 8 + head];
            }
#pragma unroll
            for (int i = 0; i < 26; ++i) {
                const int step = b0 + i, cid = dir ? 129 - step : (step < 2 ? 128 + step : step - 2);
                HS[(size_t)((cid * 2 + dir) * 8 + head) * 8192 + rest] = (hf)st;
                st = st * dc[i] + cs[i];
            }
        }
    }
}

struct AttnJob { const hf* Q0; const hf* Q1; const hf* K; const hf* VT; int qrow0; int ta0, na, tb0, nb; int use_sink; float sink0, sink1; int outcol; };

template <bool NOMAX>
__device__ __forceinline__ void attn_unit(const Params& P, const AttnJob& J, char* lds) {
    const int tid = opaque_tid(), lane = tid & 63, w = tid >> 6, r31 = lane & 31, h = lane >> 5, hsel = w >> 2;
    const int qbase = J.qrow0 + (w & 3) * 32;
    const int fsw = (r31 >> 1) & 7;
    const hf* Qp = (hsel ? J.Q1 : J.Q0) + (size_t)(qbase + r31) * 64 + h * 8;
    h8 qf[4];
#pragma unroll
    for (int kk = 0; kk < 4; ++kk) qf[kk] = *(const h8*)(Qp + kk * 16);
    asm volatile("" : "+v"(qf[0]), "+v"(qf[1]), "+v"(qf[2]), "+v"(qf[3]));
    fx16 o[2]; o[0] = zero16(); o[1] = zero16();
    float m = -1e30f, l = 0.f;
    fx16 ol = zero16();
    h8 ones; { const hf ov = (hf)((NOMAX && r31 == 0) ? 1.0f : 0.0f);
#pragma unroll
      for (int e = 0; e < 8; ++e) ones[e] = ov; }
    const int srow = tid >> 3, sc = tid & 7;
    const int kst = srow * 128 + ((sc ^ ((srow >> 1) & 7)) << 4);
    const int npairs = (J.na + J.nb) >> 1;
    u4 kr[2], vr[2];
#define TILE_OF(j) ((j) < J.na ? J.ta0 + (j) : J.tb0 + ((j) - J.na))
#pragma unroll
    for (int e = 0; e < 2; ++e) { const int tile = TILE_OF(e);
        kr[e] = *(const u4*)(J.K + (size_t)(tile * 64 + srow) * 64 + sc * 8); vr[e] = *(const u4*)(J.VT + (size_t)srow * NT + tile * 64 + sc * 8); }
#pragma unroll
    for (int e = 0; e < 2; ++e) { *(u4*)(lds + e * 16384 + kst) = kr[e]; *(u4*)(lds + e * 16384 + 8192 + kst) = vr[e]; }
    __syncthreads();
#pragma unroll 1
    for (int jp = 0; jp < npairs; ++jp) {
        const int cur = jp & 1;
        const bool more = jp + 1 < npairs;
        if (more) {
#pragma unroll
            for (int e = 0; e < 2; ++e) { const int tn = TILE_OF(2 * jp + 2 + e);
                kr[e] = *(const u4*)(J.K + (size_t)(tn * 64 + srow) * 64 + sc * 8); vr[e] = *(const u4*)(J.VT + (size_t)srow * NT + tn * 64 + sc * 8); }
        }
#pragma unroll
        for (int e2 = 0; e2 < 2; ++e2) {
        const int j = 2 * jp + e2;
        const int tile = TILE_OF(j);
        __builtin_amdgcn_sched_barrier(0);
        const char* lk = lds + cur * 32768 + e2 * 16384; const char* lv = lk + 8192;
        h8 kfr[2][4], vfr[4][2];
#pragma unroll
        for (int kk = 0; kk < 4; ++kk) {
            const int co = ((kk * 2 + h) ^ fsw) << 4;
#pragma unroll
            for (int kt = 0; kt < 2; ++kt) kfr[kt][kk] = *(const h8*)(lk + (kt * 32 + r31) * 128 + co);
        }
#pragma unroll
        for (int s4 = 0; s4 < 4; ++s4)
#pragma unroll
            for (int dt = 0; dt < 2; ++dt) {
                vfr[s4][dt] = *(const LAS h8*)((const LAS char*)lv + (dt * 32 + r31) * 128 + (((2 * s4 + h) ^ fsw) << 4));
            }
        __builtin_amdgcn_sched_barrier(0);
        fx16 s[2]; s[0] = zero16(); s[1] = zero16();
#pragma unroll
        for (int kk = 0; kk < 4; ++kk)
#pragma unroll
            for (int kt = 0; kt < 2; ++kt) s[kt] = mfma16(kfr[kt][kk], qf[kk], s[kt]);
        if (!NOMAX && j >= J.na) {
            const int qpos = qbase + r31;
#pragma unroll
            for (int kt = 0; kt < 2; ++kt)
#pragma unroll
                for (int i = 0; i < 16; ++i) { const int kpos = tile * 64 + kt * 32 + (i & 3) + 8 * (i >> 2) + 4 * h; const int dd = qpos - kpos; if (dd > 128 || dd < -128) s[kt][i] = -1e30f; }
        }
        float rs4[4] = {0.f, 0.f, 0.f, 0.f};
        if (NOMAX) {
#pragma unroll
            for (int kt = 0; kt < 2; ++kt)
#pragma unroll
                for (int i = 0; i < 16; ++i) s[kt][i] = __builtin_amdgcn_exp2f(s[kt][i]);
        } else {
            float mx = s[0][0];
#pragma unroll
            for (int kt = 0; kt < 2; ++kt)
#pragma unroll
                for (int i = 0; i < 16; ++i) mx = fmaxf(mx, s[kt][i]);
            mx = fmaxf(mx, shflx(mx, 32, lane));
            const float mn = fmaxf(m, mx);
            const float alpha = __builtin_amdgcn_exp2f(m - mn);
            m = mn;
#pragma unroll
            for (int kt = 0; kt < 2; ++kt)
#pragma unroll
                for (int i = 0; i < 16; ++i) { const float p = __builtin_amdgcn_exp2f(s[kt][i] - mn); s[kt][i] = p; rs4[i & 3] += p; }
            l = l * alpha + ((rs4[0] + rs4[1]) + (rs4[2] + rs4[3]));
            o[0] *= alpha; o[1] *= alpha;
        }
#pragma unroll
        for (int s4 = 0; s4 < 4; ++s4) {
            h8 pf;
#pragma unroll
            for (int e = 0; e < 8; ++e) pf[e] = (hf)s[s4 >> 1][8 * (s4 & 1) + e];
#pragma unroll
            for (int dt = 0; dt < 2; ++dt) o[dt] = mfma16(vfr[s4][dt], pf, o[dt]);
            if (NOMAX) ol = mfma16(ones, pf, ol);
        }
        }
        if (more) { char* lb = lds + (cur ^ 1) * 32768;
#pragma unroll
            for (int e = 0; e < 2; ++e) { *(u4*)(lb + e * 16384 + kst) = kr[e]; *(u4*)(lb + e * 16384 + 8192 + kst) = vr[e]; } }
        __syncthreads();
    }
#undef TILE_OF
    if (NOMAX) l = ol[0];
    l += shflx(l, 32, lane);
    if (!NOMAX && J.use_sink) l += __builtin_amdgcn_exp2f((hsel ? J.sink1 : J.sink0) * LOG2E - m);
    const float inv = 1.0f / l;
    hf* dst = (hf*)(P.ws + OFF_MIX) + (size_t)(qbase + r31) * 1024 + J.outcol + hsel * 64;
#pragma unroll
    for (int dt = 0; dt < 2; ++dt)
#pragma unroll
        for (int rg = 0; rg < 4; ++rg) { h4 ov;
#pragma unroll
            for (int e = 0; e < 4; ++e) ov[e] = (hf)(o[dt][rg * 4 + e] * inv);
            *(h4*)(dst + dt * 32 + rg * 8 + 4 * h) = ov; }
}

__device__ __forceinline__ fx16 neg4_16() { fx16 z; for (int i = 0; i < 16; ++i) z[i] = -4.0f; return z; }
__device__ __forceinline__ void attn_unit_pin(const Params& P, const AttnJob& J, char* lds) {
    const int tid = opaque_tid(), lane = tid & 63, w = tid >> 6, r31 = lane & 31, h = lane >> 5, kg = w >> 2;
    const int qbase = J.qrow0 + (w & 3) * 32;
    const int fsw = (r31 >> 1) & 7;
    h8 qf[2][4];
#pragma unroll
    for (int cb = 0; cb < 2; ++cb) { const hf* Qp = (cb ? J.Q1 : J.Q0) + (size_t)(qbase + r31) * 64 + h * 8;
#pragma unroll
        for (int kk = 0; kk < 4; ++kk) qf[cb][kk] = *(const h8*)(Qp + kk * 16); }
    asm volatile("" : "+v"(qf[0][0]), "+v"(qf[0][1]), "+v"(qf[0][2]), "+v"(qf[0][3]), "+v"(qf[1][0]), "+v"(qf[1][1]), "+v"(qf[1][2]), "+v"(qf[1][3]));
    fx16 o[4]; o[0] = zero16(); o[1] = zero16(); o[2] = zero16(); o[3] = zero16();
    float l0 = 0.f, l1 = 0.f;
    const int srow = tid >> 3, sc = tid & 7;
    const int kst = srow * 128 + ((sc ^ ((srow >> 1) & 7)) << 4);
    const int T = J.na;
    const __amdgpu_buffer_rsrc_t rsK = __builtin_amdgcn_make_buffer_rsrc((void*)J.K, 0, 0x7fffffff, 0x00020000), rsV = __builtin_amdgcn_make_buffer_rsrc((void*)J.VT, 0, 0x7fffffff, 0x00020000);
    const int ks0 = J.ta0 * 8192, vs0 = J.ta0 * 128;
    const int wb = __builtin_amdgcn_readfirstlane(w) * 1024;
    const int vlo = srow * (NT * 2) + ((sc ^ ((srow >> 1) & 7)) << 4);
#define PN_KDMA(t, S) __builtin_amdgcn_raw_ptr_buffer_load_lds(rsK, (LAS void*)((LAS char*)lds + (S) * 16384 + wb), 16, kst, ks0 + (t) * 8192, 0, 0)
#define PN_VDMA(t, S) __builtin_amdgcn_raw_ptr_buffer_load_lds(rsV, (LAS void*)((LAS char*)lds + (S) * 16384 + 8192 + wb), 16, vlo, vs0 + (t) * 128, 0, 0)
    int ko[4], vo[2];
#pragma unroll
    for (int kk = 0; kk < 4; ++kk) ko[kk] = (kg * 32 + r31) * 128 + (((2 * kk + h) ^ fsw) << 4);
#pragma unroll
    for (int ks = 0; ks < 2; ++ks) vo[ks] = 8192 + r31 * 128 + (((2 * (2 * kg + ks) + h) ^ fsw) << 4);
    const LAS char* L3 = (const LAS char*)lds;
#define PN_KRD(j, S) do { kf[j] = *(const LAS h8*)(L3 + ko[j] + (S) * 16384); } while (0)
#define PN_VRD(v, S) do { vfr[v] = *(const LAS h8*)(L3 + vo[(v) >> 1] + (S) * 16384 + ((v) & 1) * 4096); } while (0)
#define PN_SB __builtin_amdgcn_sched_barrier(0)
#define PN_PIN(x) asm volatile("" : "+v"(x))
#define PN_BAR do { asm volatile("s_waitcnt lgkmcnt(0)" ::: "memory"); __builtin_amdgcn_s_barrier(); asm volatile("" ::: "memory"); } while (0)
#define PN_BAR8 do { asm volatile("s_waitcnt vmcnt(2)" ::: "memory"); __builtin_amdgcn_s_barrier(); asm volatile("" ::: "memory"); } while (0)
    PN_KDMA(0, 0); PN_KDMA(1, 1); PN_KDMA(2, 2); PN_VDMA(0, 0); PN_VDMA(1, 1);
    asm volatile("s_waitcnt vmcnt(0)" ::: "memory");
    PN_BAR;
    h8 kf[4], vfr[4]; unsigned pwe[16];
#pragma unroll
    for (int j = 0; j < 4; ++j) PN_KRD(j, 0);
    fx16 a0, a1, b0, b1;
    a0 = neg4_16(); a1 = neg4_16();
#pragma unroll
    for (int kk = 0; kk < 4; ++kk) { a0 = mfma16(kf[kk], qf[0][kk], a0); a1 = mfma16(kf[kk], qf[1][kk], a1); }
    PN_KDMA(3, 3); PN_VDMA(2, 2);
#pragma unroll
    for (int i = 0; i < 16; ++i) { a0[i] = __builtin_amdgcn_exp2f(a0[i]); if (i < 10) a1[i] = __builtin_amdgcn_exp2f(a1[i]); }
#pragma unroll
    for (int j = 0; j < 4; ++j) PN_KRD(j, 1);
    PN_BAR;
#define PN_PF(P0, P1, idx) ((idx) < 16 ? P0[(idx) & 15] : P1[(idx) & 15])
#define PN_PAIR(j) (__builtin_bit_cast(h2, (unsigned)pwe[2 * (j)]) + __builtin_bit_cast(h2, (unsigned)pwe[2 * (j) + 1]))
#define PN_GAPA(i, C0, C1, P0, P1, SP) do { if ((i) < 4) { PN_VRD(i, SP); } PN_SB; \
        if ((i) & 1) C1 = mfma16(kf[(i) >> 1], qf[1][(i) >> 1], C1); else C0 = mfma16(kf[(i) >> 1], qf[0][(i) >> 1], C0); PN_SB; \
        if ((i) < 6) { P1[10 + (i)] = __builtin_amdgcn_exp2f(P1[10 + (i)]); PN_PIN(P1); PN_SB; } \
          \
        h2 ps_; if ((i) > 0) { ps_ = PN_PAIR((i) - 1); PN_SB; } \
        pwe[2 * (i)] = pk2h(PN_PF(P0, P1, 4 * (i)), PN_PF(P0, P1, 4 * (i) + 1)); PN_PIN(pwe[2 * (i)]); PN_SB; \
        if ((i) == 1) hsA = cont_ ? hsA + ps_ : ps_; else if ((i) > 1 && (i) <= 4) hsA = hsA + ps_; else if ((i) == 5) hsB = cont_ ? hsB + ps_ : ps_; else if ((i) > 5) hsB = hsB + ps_; if ((i) > 0) { PN_SB; } \
        pwe[2 * (i) + 1] = pk2h(PN_PF(P0, P1, 4 * (i) + 2), PN_PF(P0, P1, 4 * (i) + 3)); PN_PIN(pwe[2 * (i) + 1]); PN_SB; } while (0)
#define PN_E1(C0, C1, idx) do { if ((idx) < 16) C0[(idx) & 15] = __builtin_amdgcn_exp2f(C0[(idx) & 15]); else C1[(idx) & 15] = __builtin_amdgcn_exp2f(C1[(idx) & 15]); } while (0)
#define PN_EXP4(C0, C1, i) do { if ((i) < 6) { PN_E1(C0, C1, 3 * (i)); PN_E1(C0, C1, 3 * (i) + 1); PN_E1(C0, C1, 3 * (i) + 2); } \
        else { PN_E1(C0, C1, 18 + 4 * ((i) - 6)); PN_E1(C0, C1, 19 + 4 * ((i) - 6)); PN_E1(C0, C1, 20 + 4 * ((i) - 6)); PN_E1(C0, C1, 21 + 4 * ((i) - 6)); } PN_PIN(C0); PN_PIN(C1); } while (0)
#define PN_PWV(s) ({ u4 q_; q_.x = pwe[4 * (s)]; q_.y = pwe[4 * (s) + 1]; q_.z = pwe[4 * (s) + 2]; q_.w = pwe[4 * (s) + 3]; __builtin_bit_cast(h8, q_); })
#define PN_PV(i) o[((i) >> 2) * 2 + ((i) & 1)] = mfma16(vfr[(((i) >> 1) & 1) * 2 + ((i) & 1)], PN_PWV((i) >> 1), o[((i) >> 2) * 2 + ((i) & 1)])
#define PN_GAPB(i, C0, C1) do { PN_PV(i); PN_EXP4(C0, C1, i); PN_SB; } while (0)
#define PN_STEP(C0, C1, P0, P1, t, S) do { PN_SB; \
        constexpr bool cont_ = ((S) & 1) == 0; C0 = neg4_16(); C1 = neg4_16(); \
        PN_GAPA(0, C0, C1, P0, P1, ((S) + 3) & 3); PN_GAPA(1, C0, C1, P0, P1, ((S) + 3) & 3); PN_GAPA(2, C0, C1, P0, P1, ((S) + 3) & 3); PN_GAPA(3, C0, C1, P0, P1, ((S) + 3) & 3); \
        PN_GAPA(4, C0, C1, P0, P1, ((S) + 3) & 3); PN_GAPA(5, C0, C1, P0, P1, ((S) + 3) & 3); PN_GAPA(6, C0, C1, P0, P1, ((S) + 3) & 3); PN_GAPA(7, C0, C1, P0, P1, ((S) + 3) & 3); \
        { const h2 ps7_ = PN_PAIR(7); hsB = hsB + ps7_; PN_SB; } if (cont_) { l0 = __builtin_amdgcn_fdot2(hsA, h2{(_Float16)1.f, (_Float16)1.f}, l0, false); l1 = __builtin_amdgcn_fdot2(hsB, h2{(_Float16)1.f, (_Float16)1.f}, l1, false); } \
        PN_KDMA((t) + 3, ((S) + 3) & 3); PN_VDMA((t) + 2, ((S) + 2) & 3); PN_SB; \
        PN_GAPB(0, C0, C1); PN_GAPB(1, C0, C1); \
        PN_KRD(0, ((S) + 1) & 3); PN_SB; PN_GAPB(2, C0, C1); PN_KRD(1, ((S) + 1) & 3); PN_SB; PN_GAPB(3, C0, C1); \
        PN_KRD(2, ((S) + 1) & 3); PN_SB; PN_GAPB(4, C0, C1); PN_KRD(3, ((S) + 1) & 3); PN_SB; PN_GAPB(5, C0, C1); \
        PN_GAPB(6, C0, C1); PN_GAPB(7, C0, C1); \
        PN_BAR8; } while (0)
    int t = 1;
    h2 hsA, hsB;
#pragma unroll 1
    for (; t + 3 < T; t += 4) { PN_STEP(b0, b1, a0, a1, t, 1); PN_STEP(a0, a1, b0, b1, t + 1, 2); PN_STEP(b0, b1, a0, a1, t + 2, 3); PN_STEP(a0, a1, b0, b1, t + 3, 0); }
    PN_STEP(b0, b1, a0, a1, t, 1); PN_STEP(a0, a1, b0, b1, t + 1, 2); PN_STEP(b0, b1, a0, a1, t + 2, 3);
    l0 += (float)hsA[0] + (float)hsA[1]; l1 += (float)hsB[0] + (float)hsB[1];
    {
#pragma unroll
        for (int i = 10; i < 16; ++i) b1[i] = __builtin_amdgcn_exp2f(b1[i]);
        float s0 = 0.f, s1 = 0.f;
#pragma unroll
        for (int i = 0; i < 16; ++i) { s0 += b0[i]; s1 += b1[i]; }
        l0 += s0; l1 += s1;
#pragma unroll
        for (int s4 = 0; s4 < 4; ++s4)
#pragma unroll
            for (int e = 0; e < 4; ++e) pwe[4 * s4 + e] = (s4 < 2) ? pk2h(b0[8 * s4 + 2 * e], b0[8 * s4 + 2 * e + 1]) : pk2h(b1[8 * (s4 - 2) + 2 * e], b1[8 * (s4 - 2) + 2 * e + 1]);
#pragma unroll
        for (int v = 0; v < 4; ++v) PN_VRD(v, 3);
        PN_PV(0); PN_PV(1); PN_PV(2); PN_PV(3); PN_PV(4); PN_PV(5); PN_PV(6); PN_PV(7);
    }
    asm volatile("s_waitcnt vmcnt(0)" ::: "memory");
    PN_BAR;
#undef PN_KDMA
#undef PN_VDMA
#undef PN_KRD
#undef PN_VRD
#undef PN_SB
#undef PN_PIN
#undef PN_BAR
#undef PN_BAR8
#undef PN_PF
#undef PN_GAPA
#undef PN_EXP4
#undef PN_E1
#undef PN_GAPB
#undef PN_PV
#undef PN_PAIR
#undef PN_PWV
#undef PN_STEP
    l0 += shflx(l0, 32, lane); l1 += shflx(l1, 32, lane);
    float* mg = (float*)lds;
    float* mgw = mg + (size_t)((w & 3) * 66) * 64 + lane;
    if (kg == 1) {
#pragma unroll
        for (int j = 0; j < 4; ++j)
#pragma unroll
            for (int i = 0; i < 16; ++i) mgw[(j * 16 + i) * 64] = o[j][i];
        mgw[64 * 64] = l0; mgw[65 * 64] = l1;
    }
    __syncthreads();
    if (kg == 0) {
#pragma unroll
        for (int j = 0; j < 4; ++j)
#pragma unroll
            for (int i = 0; i < 16; ++i) o[j][i] += mgw[(j * 16 + i) * 64];
        l0 += mgw[64 * 64]; l1 += mgw[65 * 64];
#pragma unroll
        for (int cb = 0; cb < 2; ++cb) {
            const float inv = 1.0f / (cb ? l1 : l0);
            hf* dst = (hf*)(P.ws + OFF_MIX) + (size_t)(qbase + r31) * 1024 + J.outcol + cb * 64;
#pragma unroll
            for (int dt = 0; dt < 2; ++dt)
#pragma unroll
                for (int rg = 0; rg < 4; ++rg) { h4 ov;
#pragma unroll
                    for (int e = 0; e < 4; ++e) ov[e] = (hf)(o[cb * 2 + dt][rg * 4 + e] * inv);
                    *(h4*)(dst + dt * 32 + rg * 8 + 4 * h) = ov; }
        }
    }
    __syncthreads();
}

__device__ __forceinline__ void ssd_out_unit(const Params& P, int layer, int cid, int g, int lh0, int lh1, char* lds) {
    const int tid = opaque_tid(), lane = tid & 63, w = tid >> 6, hh = w & 3, lt = w >> 2, r31 = lane & 31, h = lane >> 5;
    const int t0 = cid * 128, head = g * 4 + hh;
    float* tab = (float*)lds;
    float* sstab = (float*)(lds + 8192);
    char* Bm = lds + 16384;
    char* XT = lds + 49152;
    const hf* U = (const hf*)(P.ws + OFF_U); const hf* UT = (const hf*)(P.ws + OFF_UT); const hf* HS = (const hf*)(P.ws + OFF_HS);
    const hf* Z = (const hf*)(P.ws + OFF_Z); const float* DTP = (const float*)(P.ws + OFF_DTP);
    const int lq = lt * 32 + r31;
    stage_rows16<128>(U + (size_t)t0 * 1024 + 512 + g * 128, 1024, Bm, tid);
    stage_rows8<256>(UT + (size_t)(g * 256) * NT + t0, NT, XT, tid);
    if (w < 4) {
        const int hd = g * 4 + w;
        float* tbw = tab + w * 512;
#pragma unroll
        for (int dir = 0; dir < 2; ++dir) {
            const float a = -expf(P.a_log[layer * 16 + dir * 8 + hd]);
            const float dt0 = DTP[(size_t)(t0 + 2 * lane) * 16 + dir * 8 + hd], dt1 = DTP[(size_t)(t0 + 2 * lane + 1) * 16 + dir * 8 + hd];
            const float d0 = dt0 * a, d1 = dt1 * a;
            const float inc1 = wave_incl_scan(d0 + d1, lane), inc0 = inc1 - d1;
            const float total = rdlane(inc1, 63);
            const float c0 = (dir == 0 ? inc0 : total - inc0 + d0) * LOG2E, c1 = (dir == 0 ? inc1 : total - inc1 + d1) * LOG2E;
            tbw[dir * 128 + 2 * lane] = c0; tbw[dir * 128 + 2 * lane + 1] = c1;
            tbw[256 + dir * 128 + 2 * lane] = c0 - __builtin_amdgcn_logf(dt0); tbw[256 + dir * 128 + 2 * lane + 1] = c1 - __builtin_amdgcn_logf(dt1);
        }
    }
    __syncthreads();
    int lh = lh0;
    h8 cfn[8];
    { const int tid = opaque_tid(), lane = tid & 63, w = tid >> 6;
      const size_t row0 = (size_t)(t0 + lh0 * 64 + (w >> 2) * 32 + (lane & 31));
#pragma unroll
      for (int kk = 0; kk < 8; ++kk) cfn[kk] = *(const h8*)(U + row0 * 1024 + 768 + g * 128 + kk * 16 + 8 * (lane >> 5)); }
#pragma unroll 1
    do {
    const int tid = opaque_tid(), lane = tid & 63, w = tid >> 6, hh = w & 3, lt = w >> 2, r31 = lane & 31, h = lane >> 5;
    const int head = g * 4 + hh, lq = lt * 32 + r31;
    const int lloc = lh * 64 + lq;
    const size_t lrow = (size_t)(t0 + lloc);
    h8 cf[8];
#pragma unroll
    for (int kk = 0; kk < 8; ++kk) cf[kk] = cfn[kk];
    h8 hs0[2][8];
    { const hf* hp = HS + (size_t)((cid * 2 + 0) * 8 + head) * 8192 + (size_t)r31 * 128 + 8 * h;
#pragma unroll
      for (int pt = 0; pt < 2; ++pt)
#pragma unroll
          for (int kk = 0; kk < 8; ++kk) hs0[pt][kk] = *(const h8*)(hp + pt * 32 * 128 + kk * 16); }
    const float* tb = tab + hh * 512;
    fx16 Y[2]; Y[0] = zero16(); Y[1] = zero16();
    const float aFl = tb[lloc], aBl = tb[128 + lloc];
    const int sw16 = r31 & 15;
#pragma unroll
    for (int st = 0; st < 4; ++st) {
        h8 bf[8];
#pragma unroll
        for (int kk = 0; kk < 8; ++kk) bf[kk] = *(const h8*)(Bm + (st * 32 + r31) * 256 + (((2 * kk + h) ^ sw16) << 4));
        h8 xf[2][2];
#pragma unroll
        for (int sh = 0; sh < 2; ++sh)
#pragma unroll
            for (int pt = 0; pt < 2; ++pt) {
                const int q0 = 4 * (st * 2 + sh) + h;
                const LAS char* rowp = (const LAS char*)XT + (hh * 64 + pt * 32 + r31) * 256;
                const h4 v0 = *(const volatile LAS h4*)(rowp + ((q0 ^ r31) << 3)), v1 = *(const volatile LAS h4*)(rowp + (((q0 + 2) ^ r31) << 3));
                h8 x; x[0] = v0[0]; x[1] = v0[1]; x[2] = v0[2]; x[3] = v0[3]; x[4] = v1[0]; x[5] = v1[1]; x[6] = v1[2]; x[7] = v1[3];
                xf[sh][pt] = x;
            }
        __builtin_amdgcn_sched_barrier(0);
        fx16 T = zero16();
#pragma unroll
        for (int kk = 0; kk < 8; ++kk) T = mfma16(bf[kk], cf[kk], T);
#pragma unroll
        for (int rg = 0; rg < 4; ++rg) {
            const int s0 = st * 32 + rg * 8 + 4 * h;
            const f4 eFs = *(const f4*)(tb + 256 + s0), eBs = *(const f4*)(tb + 384 + s0);
#pragma unroll
            for (int e = 0; e < 4; ++e) {
                const int s = s0 + e;
                const float xf = s <= lloc ? aFl - eFs[e] : -INFINITY, xb = s >= lloc ? aBl - eBs[e] : -INFINITY;
                T[rg * 4 + e] *= __builtin_amdgcn_exp2f(xf) + __builtin_amdgcn_exp2f(xb);
            }
        }
#pragma unroll
        for (int sh = 0; sh < 2; ++sh) {
            h8 pf;
#pragma unroll
            for (int e = 0; e < 8; ++e) pf[e] = (hf)T[8 * sh + e];
#pragma unroll
            for (int pt = 0; pt < 2; ++pt) Y[pt] = mfma16(xf[sh][pt], pf, Y[pt]);
        }
    }
    h4 zzv[2][4];
    {
        h8 hs1[2][8];
        { const hf* hp = HS + (size_t)((cid * 2 + 1) * 8 + head) * 8192 + (size_t)r31 * 128 + 8 * h;
#pragma unroll
          for (int pt = 0; pt < 2; ++pt)
#pragma unroll
              for (int kk = 0; kk < 8; ++kk) hs1[pt][kk] = *(const h8*)(hp + pt * 32 * 128 + kk * 16); }
        __builtin_amdgcn_sched_barrier(0);
        const float exF = __builtin_amdgcn_exp2f(aFl), exB = __builtin_amdgcn_exp2f(aBl);
#pragma unroll
        for (int pt = 0; pt < 2; ++pt) {
            fx16 tmp = zero16();
#pragma unroll
            for (int kk = 0; kk < 8; ++kk) tmp = mfma16(hs0[pt][kk], cf[kk], tmp);
            Y[pt] += tmp * exF;
        }
        __builtin_amdgcn_sched_barrier(0);
#pragma unroll
        for (int pt = 0; pt < 2; ++pt)
#pragma unroll
            for (int rg = 0; rg < 4; ++rg) {
                const int p = pt * 32 + rg * 8 + 4 * h;
                zzv[pt][rg] = *(const h4*)(Z + lrow * 512 + head * 64 + p);
            }
        __builtin_amdgcn_sched_barrier(0);
#pragma unroll
        for (int pt = 0; pt < 2; ++pt) {
            fx16 tmp = zero16();
#pragma unroll
            for (int kk = 0; kk < 8; ++kk) tmp = mfma16(hs1[pt][kk], cf[kk], tmp);
            Y[pt] += tmp * exB;
        }
    }
    if (lh + 1 < lh1) {
#pragma unroll
        for (int kk = 0; kk < 8; ++kk) cfn[kk] = *(const h8*)(U + (lrow + 64) * 1024 + 768 + g * 128 + kk * 16 + 8 * h);
    }
    const float dsk = P.d_skip[layer * 8 + head];
    float ss = 0.f;
#pragma unroll
    for (int pt = 0; pt < 2; ++pt)
#pragma unroll
        for (int rg = 0; rg < 4; ++rg) {
            const h4 zz = zzv[pt][rg];
            h4 xs;
#pragma unroll
            for (int e = 0; e < 4; ++e) { const int r = hh * 64 + pt * 32 + rg * 8 + 4 * h + e;
                xs[e] = *(const LAS hf*)((const LAS char*)XT + r * 256 + (((lloc >> 2) ^ (r & 31)) << 3) + (lloc & 3) * 2); }
#pragma unroll
            for (int e = 0; e < 4; ++e) { const float y = Y[pt][rg * 4 + e] + (float)xs[e] * dsk; const float gv = y * silu_f((float)zz[e]); Y[pt][rg * 4 + e] = gv; ss += gv * gv; }
        }
    ss += shflx(ss, 32, lane);
    if (h == 0) sstab[hh * 64 + lq] = ss;
    __syncthreads();
    {
        const float tot = (sstab[lq] + sstab[64 + lq]) + (sstab[128 + lq] + sstab[192 + lq]);
        const float rstd = 1.0f / sqrtf(tot * (1.0f / 256.0f) + 1e-6f);
        hf* dst = (hf*)(P.ws + OFF_MIX) + lrow * 1024 + 512 + head * 64;
#pragma unroll
        for (int pt = 0; pt < 2; ++pt)
#pragma unroll
            for (int rg = 0; rg < 4; ++rg) {
                const int p = pt * 32 + rg * 8 + 4 * h;
                const f4 gw = *(const f4*)(P.gnorm_w + layer * 512 + head * 64 + p);
                h4 ov;
#pragma unroll
                for (int e = 0; e < 4; ++e) ov[e] = (hf)(Y[pt][rg * 4 + e] * rstd * gw[e]);
                *(h4*)(dst + p) = ov;
            }
    }
    __syncthreads();
    } while (++lh < lh1);
}

#if defined(DBG_NAIVE_ATTN)
__device__ __forceinline__ void naive_attn(const Params& P, int layer, char* lds) {
    const int tid = opaque_tid(), lane = tid & 63, w = tid >> 6;
    const hf* qkv = (const hf*)(P.ws + OFF_QKV);
    float* qs = (float*)lds + w * 64;
    const int nrows = layer == 0 ? NT : NL;
    for (int item = blockIdx.x * 8 + w; item < nrows * 8; item += gridDim.x * 8) {
        const int row = item >> 3, hd8 = item & 7, isB = hd8 >> 2, head = hd8 & 3, kvh = head >> 1, base = isB ? 8 : 0;
        const hf* Q = qkv + (size_t)(base + head) * HT + (size_t)row * 64;
        const hf* K = qkv + (size_t)(base + 4 + kvh) * HT;
        const hf* VT = qkv + (size_t)(base + 6 + kvh) * HT;
        qs[lane] = (float)Q[lane];
        __builtin_amdgcn_s_waitcnt(0);
        float m = -1e30f, l = 0.f, o = 0.f;
        int r0a, r1a, r0b = 0, r1b = 0;
        if (row >= NL) { r0a = NL; r1a = NT; }
        else if (isB) { r0a = 0; r1a = NT; }
        else { r0a = NL; r1a = NT; r0b = row - 128 < 0 ? 0 : row - 128; r1b = row + 129 > NL ? NL : row + 129; }
        for (int rng = 0; rng < 2; ++rng) {
            const int k0 = rng ? r0b : r0a, k1 = rng ? r1b : r1a;
            for (int kb = k0; kb < k1; kb += 64) {
                const int key = kb + lane; const bool ok = key < k1;
                float s = -1e30f;
                if (ok) { s = 0.f; const hf* kp = K + (size_t)key * 64; for (int d = 0; d < 64; ++d) s += qs[d] * (float)kp[d]; }
                float mx = s;
                for (int dd = 32; dd >= 1; dd >>= 1) mx = fmaxf(mx, __shfl_xor(mx, dd));
                const float mn = fmaxf(m, mx), alpha = exp2f(m - mn);
                const float p = ok ? exp2f(s - mn) : 0.f;
                float ps = p;
                for (int dd = 32; dd >= 1; dd >>= 1) ps += __shfl_xor(ps, dd);
                l = l * alpha + ps; o *= alpha; m = mn;
                const int cnt = k1 - kb < 64 ? k1 - kb : 64;
                for (int j = 0; j < cnt; ++j) { const float pj = __shfl(p, j); o += pj * (float)VT[(size_t)lane * NT + kb + j]; }
            }
        }
        if (!isB) l += exp2f(P.sink[layer * 4 + head] * LOG2E - m);
        ((hf*)(P.ws + OFF_MIX))[(size_t)row * 1024 + (isB ? 256 : 0) + head * 64 + lane] = (hf)(o / l);
    }
}
#endif
#if defined(DBG_NAIVE_SSD)
__device__ __forceinline__ void naive_ssd_scan(const Params& P, int layer) {
    const int tid = opaque_tid(), lane = tid & 63, w = tid >> 6;
    const hf* U = (const hf*)(P.ws + OFF_U); const float* DTP = (const float*)(P.ws + OFF_DTP);
    float* Y = (float*)(P.ws + OFF_HS);
    for (int item = blockIdx.x * 8 + w; item < 512; item += gridDim.x * 8) {
        const int head = item >> 6, p = item & 63, g = head >> 2;
        for (int dir = 0; dir < 2; ++dir) {
            const float a = -expf(P.a_log[layer * 16 + dir * 8 + head]);
            float s0 = 0.f, s1 = 0.f;
            for (int step = 0; step < NT; ++step) {
                int t;
                if (dir == 0) t = step < NCX ? NL + step : step - NCX;
                else t = step < NCX ? NT - 1 - step : NL - 1 - (step - NCX);
                const float dt = DTP[(size_t)t * 16 + dir * 8 + head];
                const float x = (float)U[(size_t)t * 1024 + head * 64 + p];
                const float b0 = (float)U[(size_t)t * 1024 + 512 + g * 128 + lane], b1 = (float)U[(size_t)t * 1024 + 512 + g * 128 + 64 + lane];
                const float c0 = (float)U[(size_t)t * 1024 + 768 + g * 128 + lane], c1 = (float)U[(size_t)t * 1024 + 768 + g * 128 + 64 + lane];
                const float dec = expf(a * dt);
                s0 = s0 * dec + dt * b0 * x; s1 = s1 * dec + dt * b1 * x;
                float y = c0 * s0 + c1 * s1;
                for (int dd = 32; dd >= 1; dd >>= 1) y += __shfl_xor(y, dd);
                if (lane == 0) { float* yp = Y + (size_t)t * 512 + head * 64 + p; *yp = dir == 0 ? y : *yp + y; }
            }
        }
    }
}
__device__ __forceinline__ void naive_ssd_finish(const Params& P, int layer) {
    const int tid = opaque_tid(), lane = tid & 63, w = tid >> 6;
    const hf* U = (const hf*)(P.ws + OFF_U); const hf* Z = (const hf*)(P.ws + OFF_Z); const float* Y = (const float*)(P.ws + OFF_HS);
    const int nrows = layer == 0 ? NT : NL;
    for (int item = blockIdx.x * 8 + w; item < nrows * 2; item += gridDim.x * 8) {
        const int t = item >> 1, g = item & 1;
        float gv[4]; float ss = 0.f;
        for (int i = 0; i < 4; ++i) { const int ch = g * 256 + i * 64 + lane; const float y = Y[(size_t)t * 512 + ch] + (float)U[(size_t)t * 1024 + ch] * P.d_skip[layer * 8 + (ch >> 6)];
            const float z = (float)Z[(size_t)t * 512 + ch]; gv[i] = y * (z / (1.0f + expf(-z))); ss += gv[i] * gv[i]; }
        for (int dd = 32; dd >= 1; dd >>= 1) ss += __shfl_xor(ss, dd);
        const float rstd = 1.0f / sqrtf(ss / 256.0f + 1e-6f);
        for (int i = 0; i < 4; ++i) { const int ch = g * 256 + i * 64 + lane; ((hf*)(P.ws + OFF_MIX))[(size_t)t * 1024 + 512 + ch] = (hf)(gv[i] * rstd * P.gnorm_w[layer * 512 + ch]); }
    }
}
#endif
#if defined(DBG_NAIVE_INPROJ)
__device__ __forceinline__ void naive_inproj(const Params& P, int layer) {
    const int tid = opaque_tid(), lane = tid & 63, w = tid >> 6;
    const hf* H = (const hf*)(P.ws + OFF_H16); const hf* W = (const hf*)(P.ws + OFF_WIN) + (size_t)layer * INP * D;
    hf* qkv = (hf*)(P.ws + OFF_QKV);
    for (int item = blockIdx.x * 8 + w; item < NT * 16; item += gridDim.x * 8) {
        const int t = item >> 4, fb = item & 15, sub = fb & 7;
        const hf* hp = H + (size_t)t * D; const hf* wp = W + (size_t)(fb * 64 + lane) * D;
        float acc = 0.f;
        for (int k = 0; k < D; k += 8) { const h8 a = *(const h8*)(hp + k), b = *(const h8*)(wp + k); for (int j = 0; j < 8; ++j) acc += (float)a[j] * (float)b[j]; }
        float v = acc;
        if (sub < 6) {
            if (fb >= 8) { float ss = v * v; for (int dd = 32; dd >= 1; dd >>= 1) ss += __shfl_xor(ss, dd); v = v * (1.0f / sqrtf(ss / 64.0f + 1e-6f)) * (sub < 4 ? P.q_gain : P.k_gain)[layer * 64 + lane]; }
            if (t < NL) {
                const int axis = lane >> 5, half = (lane >> 4) & 1, f = lane & 15;
                const float pos = (float)(axis == 0 ? (t >> 6) : (t & 63));
                const float inv = powf(10000.0f, -(float)f / 16.0f); const float ang = pos * inv;
                const float other = __shfl_xor(v, 16);
                const float cs = cosf(ang), sn = sinf(ang);
                v = half == 0 ? v * cs - other * sn : other * sn + v * cs;
            }
            if (sub < 4) v *= 0.125f * LOG2E;
            qkv[(size_t)fb * HT + (size_t)t * 64 + lane] = (hf)v;
        } else qkv[(size_t)fb * HT + (size_t)lane * NT + t] = (hf)v;
    }
}
#endif


#if defined(DBG_NAIVE_INPROJ2)
__device__ __forceinline__ void naive_inproj2(const Params& P, int layer) {
    const int tid = opaque_tid(), lane = tid & 63, w = tid >> 6;
    const hf* H = (const hf*)(P.ws + OFF_H16); const hf* W = (const hf*)(P.ws + OFF_WIN) + (size_t)layer * INP * D;
    for (int item = blockIdx.x * 8 + w; item < NT * 25; item += gridDim.x * 8) {
        const int t = item / 25, fb = 16 + item % 25;
        const hf* hp = H + (size_t)t * D; const hf* wp = W + (size_t)(fb * 64 + lane) * D;
        float acc = 0.f;
        for (int k = 0; k < D; k += 8) { const h8 a = *(const h8*)(hp + k), b = *(const h8*)(wp + k); for (int j = 0; j < 8; ++j) acc += (float)a[j] * (float)b[j]; }
        if (fb < 24) ((hf*)(P.ws + OFF_Z))[(size_t)t * 512 + (fb - 16) * 64 + lane] = (hf)acc;
        else if (fb < 40) ((hf*)(P.ws + OFF_XBC))[(size_t)t * 1024 + (fb - 24) * 64 + lane] = (hf)acc;
        else if (lane < 16) ((float*)(P.ws + OFF_DTR))[(size_t)t * 16 + lane] = acc;
    }
}
#endif
#if defined(DBG_NAIVE_PREP)
__device__ __forceinline__ void naive_prep(const Params& P, int layer) {
    const hf* XBC = (const hf*)(P.ws + OFF_XBC); hf* U = (hf*)(P.ws + OFF_U); hf* UT = (hf*)(P.ws + OFF_UT);
    for (size_t e = (size_t)blockIdx.x * 512 + opaque_tid(); e < (size_t)NT * 1024; e += (size_t)gridDim.x * 512) {
        const int t = (int)(e >> 10), ch = (int)(e & 1023);
        const int seg0 = t < NL ? 0 : NL, seg1 = t < NL ? NL : NT;
        float s = P.conv_b[layer * 1024 + ch];
        for (int k = 0; k < 5; ++k) { const int tt = t + k - 2; if (tt >= seg0 && tt < seg1) s += P.conv_w[(size_t)layer * 5120 + k * 1024 + ch] * (float)XBC[(size_t)tt * 1024 + ch]; }
        const hf o = (hf)(s / (1.0f + expf(-s)));
        U[e] = o; if (ch < 768) UT[(size_t)ch * NT + t] = o;
    }
    const float* dr = (const float*)(P.ws + OFF_DTR); float* dp = (float*)(P.ws + OFF_DTP);
    for (int e = blockIdx.x * 512 + opaque_tid(); e < NT * 16; e += gridDim.x * 512) { const float xv = dr[e] + P.dt_bias[layer * 16 + (e & 15)]; dp[e] = xv > 20.f ? xv : log1pf(expf(xv)); }
}
#endif
#if defined(DBG_NAIVE_GEMM)
__device__ __forceinline__ void naive_res_gemm(const Params& P, const hf* A, const hf* Wt, int K, int nrows, int layer, int which_g, char* lds) {
    const int tid = opaque_tid(); float* ar = (float*)lds;
    for (int t = blockIdx.x; t < nrows; t += gridDim.x) {
        for (int k = tid; k < K; k += 512) ar[k] = (float)A[(size_t)t * K + k];
        __syncthreads();
        float* xr = xr_row(P, t); const float* g = modv(P, layer, t >= NL ? 1 : 0, which_g);
        for (int n = tid; n < D; n += 512) { const hf* wp = Wt + (size_t)n * K; float acc = 0.f;
            for (int k = 0; k < K; k += 8) { const h8 b = *(const h8*)(wp + k); for (int j = 0; j < 8; ++j) acc += ar[k + j] * (float)b[j]; }
            xr[n] = ALPHA * xr[n] + g[n] * acc; }
        __syncthreads();
    }
}
__device__ __forceinline__ void naive_gu_gemm(const Params& P, int layer, int nrows, char* lds) {
    const int tid = opaque_tid(); float* ar = (float*)lds;
    const hf* A = (const hf*)(P.ws + OFF_H16); hf* G = (hf*)(P.ws + OFF_G16);
    for (int t = blockIdx.x; t < nrows; t += gridDim.x) {
        for (int k = tid; k < D; k += 512) ar[k] = (float)A[(size_t)t * D + k];
        __syncthreads();
        for (int j = tid; j < DFF; j += 512) { float ag = 0.f, au = 0.f;
            for (int k = 0; k < D; ++k) { const float a = ar[k]; ag += a * (float)(hf)P.w_gu[(size_t)layer * D * NGU + (size_t)k * NGU + j]; au += a * (float)(hf)P.w_gu[(size_t)layer * D * NGU + (size_t)k * NGU + DFF + j]; }
            G[(size_t)t * DFF + j] = (hf)((ag / (1.0f + expf(-ag))) * au); }
        __syncthreads();
    }
}
#endif

__device__ __forceinline__ void phase_mix(const Params& P, int layer, char* lds) {
    const hf* qkv = (const hf*)(P.ws + OFF_QKV);
    const int ssd_end = 512 + (layer == 0 ? 264 : 256);
    const int nunits = ssd_end + (layer == 0 ? 8 : 0);
    float gq = 0.f, gk = 0.f;
    for (int i = 0; i < 64; ++i) { gq = fmaxf(gq, fabsf(P.q_gain[layer * 64 + i])); gk = fmaxf(gk, fabsf(P.k_gain[layer * 64 + i])); }
    const bool nomax_ok = 0.125f * LOG2E * 64.0f * gq * gk * 1.01f <= 14.0f;
#if defined(DBG_NAIVE_INPROJ)
    naive_inproj(P, layer); cg::this_grid().sync();
#endif
#if defined(DBG_NAIVE_ATTN)
    naive_attn(P, layer, lds); __syncthreads();
#endif
#if defined(DBG_NAIVE_SSD)
    naive_ssd_scan(P, layer); cg::this_grid().sync(); naive_ssd_finish(P, layer);
#endif
    const bool ssd_first = ((blockIdx.x >> 3) & 1) != 0;
#pragma unroll 1
    for (int kq = 0; kq < 4; ++kq) {
        const int k = ssd_first ? (kq == 0 ? 2 : kq <= 2 ? kq - 1 : 3) : kq;
        const int u = (int)blockIdx.x + k * (int)gridDim.x;
        if (u >= nunits) continue;
#if defined(DBG_NAIVE_SSD)
        if (u >= 512 && u < ssd_end) continue;
#endif
#if defined(DBG_NAIVE_ATTN)
        if (u < 512 || u >= ssd_end) continue;
#endif
        if (u >= 512 && u < ssd_end) { const int i = u - 512;
            int cid = i >> 1, g = i & 1, l0 = 0, l1 = 2;
            if (i >= 256) { const int j = i - 256; cid = 128 + (j >> 2); g = (j >> 1) & 1; l0 = j & 1; l1 = l0 + 1; }
            ssd_out_unit(P, layer, cid, g, l0, l1, lds);
            continue; }
        int base, kvh, qrow0, ta0, na, tb0 = 0, nb = 0, use_sink, outcol;
        if (u < 256) {
            kvh = u & 1; base = 8; qrow0 = (u >> 1) * 128; ta0 = 0; na = 260; use_sink = 0; outcol = 256 + kvh * 128;
        } else if (u < 512) {
            const int i = u - 256, qb = i >> 1; kvh = i & 1; base = 0; qrow0 = qb * 128; ta0 = 256; na = 4;
            const int lo = 2 * qb - 2 < 0 ? 0 : 2 * qb - 2, hi = 2 * qb + 4 > 256 ? 256 : 2 * qb + 4;
            tb0 = lo; nb = hi - lo; use_sink = 1; outcol = kvh * 128;
        } else {
            const int i = u - ssd_end, isB = i >> 2, cq = i & 1; kvh = (i >> 1) & 1; base = isB ? 8 : 0;
            qrow0 = NL + cq * 128; ta0 = 256; na = 4; use_sink = isB ? 0 : 1; outcol = (isB ? 256 : 0) + kvh * 128;
        }
        AttnJob J; J.Q0 = qkv + (size_t)(base + 2 * kvh) * HT; J.Q1 = qkv + (size_t)(base + 1 + 2 * kvh) * HT; J.K = qkv + (size_t)(base + 4 + kvh) * HT; J.VT = qkv + (size_t)(base + 6 + kvh) * HT;
        J.qrow0 = qrow0; J.ta0 = ta0; J.na = na; J.tb0 = tb0; J.nb = nb; J.use_sink = use_sink; J.sink0 = P.sink[layer * 4 + 2 * kvh]; J.sink1 = P.sink[layer * 4 + 2 * kvh + 1]; J.outcol = outcol;
        if (u < 256 && nomax_ok) attn_unit_pin(P, J, lds); else attn_unit<false>(P, J, lds);
#if defined(PROBE_MIX_A)
        if (u >= 256) attn_unit<false>(P, J, lds);
#endif
#if defined(PROBE_MIX_B)
        if (u < 256) attn_unit<true>(P, J, lds);
#endif
    }
}

constexpr int PPL = 8;
constexpr int NPHASES = 1 + PPL * 2;

__device__ __forceinline__ void run_phase(const Params& P, int ph, char* lds) {
    if (ph == 0) { phase_p0(P, lds); return; }
    const int layer = (ph - 1) / PPL, sub0 = (ph - 1) % PPL;
    const bool pre_out = layer == 0 && sub0 == 6, pre_dn = layer == 1 && sub0 == 0;
    const int nsteps = (pre_out || pre_dn) ? 2 : 1;
    const int layer_ = layer;
#pragma unroll 1
    for (int step = 0; step < nsteps; ++step) {
        const bool ctxout = pre_out && step == 0, ctxdn = pre_dn && step == 0;
        const int sub = ctxout ? 5 : ctxdn ? 7 : sub0;
        const int layer = ctxdn ? 0 : layer_;
        const int mt = ctxdn ? 65 : (layer == 0 ? (sub == 7 ? 64 : 65) : 64);
        switch (sub) {
            case 0: { EpiIn e{P, layer}; gemm_phase(( const hf*)(P.ws + OFF_H16), (const hf*)(P.ws + OFF_WIN) + (size_t)layer * INP * D, 65, 11, D, e, lds, layer == 1 ? 4 : 0); } break;
            case 1: phase_prep(P, layer, lds); break;
            case 2: phase_ssd_states(P, layer, lds); break;
            case 3: phase_ssd_scan(P); break;
            case 4: phase_mix(P, layer, lds); break;
            case 5: { EpiResLN e{P, layer, 2, layer == 0 ? nullptr : P.ln2_g + (layer - 1) * D, layer == 0 ? nullptr : P.ln2_b + (layer - 1) * D,
                                 P.ln1_g + layer * D, P.ln1_b + layer * D, layer, 3, 4, 0, layer * 2};
                      gemm_phase((const hf*)(P.ws + OFF_MIX), (const hf*)(P.ws + OFF_WOUT) + (size_t)layer * D * D, ctxout ? 1 : 64, 4, D, e, lds, ctxout ? 1 : 0); } break;
            case 6: { EpiGU e{P}; gemm_phase((const hf*)(P.ws + OFF_H16), (const hf*)(P.ws + OFF_WGU) + (size_t)layer * NGU * D, mt, 22, D, e, lds, layer == 0 ? 2 : 0); } break;
            case 7: { EpiResLN e{P, layer, 5, P.ln1_g + layer * D, P.ln1_b + layer * D,
                                 P.ln2_g + layer * D, P.ln2_b + layer * D, layer == 0 ? 1 : 0, 0, 1, layer == 1 ? 1 : 0, layer * 2 + 1};
                      gemm_phase((const hf*)(P.ws + OFF_G16), (const hf*)(P.ws + OFF_WDN) + (size_t)layer * D * DFF, ctxdn ? 1 : mt, 4, DFF, e, lds, ctxdn ? 3 : 0); } break;
        }
    }
}

__global__ void __launch_bounds__(512) fwd_kernel(Params P) {
    extern __shared__ __attribute__((aligned(16))) char lds[];
    P.wv = __builtin_amdgcn_readfirstlane((int)(threadIdx.x >> 6));
    volatile LAS unsigned* st = (volatile LAS unsigned*)(lds + 131072);
    if (threadIdx.x < 4) st[threadIdx.x] = 0u;
    __syncthreads();
    const XcdBarrier xb = xcd_barrier_post((unsigned*)(P.ws + OFF_BAR), st);
#pragma unroll 1
    for (int ph = P.ph_lo; ph < P.ph_hi; ++ph) {
        run_phase(P, ph, lds);
#if defined(PROBE_REPEAT_SUB)
        { const int sub_ = ph >= 1 ? (ph - 1) % PPL : -1 - ph; if ((PROBE_REPEAT_MASK >> (sub_ + 3)) & 1) { xcd_barrier(xb); run_phase(P, ph, lds); } }
#endif
        if (ph + 1 < P.ph_hi) { if (P.ph_hi > 1000) cg::this_grid().sync(); else xcd_barrier(xb); }
    }
}

constexpr int LDS_BYTES = 131072 + 256;

extern "C" void kernel_launch(void* const* d_in, const int* in_sizes, int n_in, void* d_out, int out_size, void* d_ws, size_t ws_size, hipStream_t stream) {
    static int grid = 0;
    if (grid == 0) {
        if (n_in != 23 || out_size != NL * D || ws_size < OFF_END) { fprintf(stderr, "kernel_launch: unexpected shapes (n_in %d out %d ws %zu need %zu)\n", n_in, out_size, ws_size, (size_t)OFF_END); grid = -1; return; }
        int dev = 0, cus = 0, per_cu = 0;
        hipGetDevice(&dev); hipDeviceGetAttribute(&cus, hipDeviceAttributeMultiprocessorCount, dev);
        hipFuncSetAttribute((const void*)fwd_kernel, hipFuncAttributeMaxDynamicSharedMemorySize, LDS_BYTES);
        hipOccupancyMaxActiveBlocksPerMultiprocessor(&per_cu, (const void*)fwd_kernel, 512, LDS_BYTES);
        if (per_cu < 1) { fprintf(stderr, "kernel_launch: occupancy query says %d blocks/CU\n", per_cu); }
        (void)hipGetLastError();
        grid = cus > 0 ? cus : 256;
    }
    if (grid < 0) return;
    Params p{};
    const float** pp = (const float**)&p;
    for (int i = 0; i < 23; ++i) pp[i] = (const float*)d_in[i];
    p.out = (float*)d_out; p.ws = (unsigned char*)d_ws;
#if MULTI_LAUNCH
    for (int ph = 0; ph < NPHASES; ++ph) { p.ph_lo = ph; p.ph_hi = ph + 1; hipLaunchKernelGGL(fwd_kernel, dim3(grid), dim3(512), LDS_BYTES, stream, p); }
#else
    p.ph_lo = 0; p.ph_hi = NPHASES;
    if (hipMemsetAsync((char*)d_ws + OFF_BAR, 0, 16384, stream) != hipSuccess) fprintf(stderr, "memset of barrier words failed\n");
    void* args[] = {&p};
    hipError_t e = hipLaunchCooperativeKernel((const void*)fwd_kernel, dim3(grid), dim3(512), args, LDS_BYTES, stream);
    if (e != hipSuccess) fprintf(stderr, "cooperative launch failed: %s (grid %d)\n", hipGetErrorString(e), grid);
#endif
}
```
